# Optimizing an MI355X kernel written in HIP

```python
import math
import jax
import jax.numpy as jnp
from jax import lax
import numpy as np

D_MODEL = 1024
BATCH = 8
SEQ = 4096
DEPTH = 1

CTX_LEN = 256
GRID_W = 64
EPS = 1e-6

DN_HEADS = 8
DN_DK = 128
DN_DV = 128
DN_QK = DN_HEADS * DN_DK
DN_V = DN_HEADS * DN_DV
DN_CONV = 3
DN_CHUNK = 64

ATTN_HEADS = 8
ATTN_KV_HEADS = 2
ATTN_GROUP = ATTN_HEADS // ATTN_KV_HEADS
ATTN_DH = 128
ATTN_Q = ATTN_HEADS * ATTN_DH
ATTN_KV = ATTN_KV_HEADS * ATTN_DH
Q_BLOCK = 128
ROPE_THETA = 10000.0
ROPE_FREQS = ATTN_DH // 4

FFN_HIDDEN = 2816
FFN_RES_WEIGHT = 0.5

N_MOD = 9

IN_SIZES = (2 * DN_QK + DN_V, DN_V, 4 * DN_HEADS, ATTN_Q, 2 * ATTN_KV, 2 * D_MODEL)
IN_W = 2 * DN_QK + DN_V + DN_V + 4 * DN_HEADS + ATTN_Q + 2 * ATTN_KV + 2 * D_MODEL

kernel_name = 'hybrid_deltanet_gqa_macaron_prefix_block'


def _rmsnorm(x, g):
    xf = x.astype(jnp.float32)
    y = xf * lax.rsqrt(jnp.mean(xf * xf, axis=-1, keepdims=True) + EPS)
    return (y * g.astype(jnp.float32)).astype(x.dtype)


def _l2norm(x):
    xf = x.astype(jnp.float32)
    return xf * lax.rsqrt(jnp.sum(xf * xf, axis=-1, keepdims=True) + EPS)


def _modulate(h, shift, scale):
    return h * (1.0 + scale) + shift


def _ffn_sublayer(x, shift, scale, gate, pre_g, post_g, w_gu, w_down):
    h = _modulate(_rmsnorm(x, pre_g), shift, scale)
    a, b = jnp.split(h @ w_gu, 2, axis=-1)
    y = (jax.nn.silu(a) * b) @ w_down
    return x + FFN_RES_WEIGHT * gate * _rmsnorm(y, post_g)


def _short_conv(u, w):
    l = u.shape[1]
    pad = DN_CONV // 2
    up = jnp.pad(u, ((0, 0), (pad, pad), (0, 0)))
    out = up[:, 0:l] * w[0]
    for j in range(1, DN_CONV):
        out = out + up[:, j:j + l] * w[j]
    return out


def _rope_tables(l, dtype):
    rows = l // GRID_W
    row = jnp.repeat(jnp.arange(rows, dtype=jnp.int32), GRID_W)
    col = jnp.tile(jnp.arange(GRID_W, dtype=jnp.int32), rows)
    pos = jnp.stack([row, col], axis=-1).astype(jnp.float32)
    inv_freq = ROPE_THETA ** (-jnp.arange(ROPE_FREQS, dtype=jnp.float32) / ROPE_FREQS)
    ang = pos[:, :, None] * inv_freq
    return jnp.cos(ang).astype(dtype), jnp.sin(ang).astype(dtype)


def _rope(x, cos, sin):
    xr = x.reshape(*x.shape[:-1], 2, 2, ROPE_FREQS)
    x1, x2 = xr[..., 0, :], xr[..., 1, :]
    c, s = cos[:, None], sin[:, None]
    out = jnp.stack([x1 * c - x2 * s, x2 * c + x1 * s], axis=-2)
    return out.reshape(x.shape)


def _delta_rule(q, k, v, beta, g, s0):
    b, h, l, _ = q.shape
    dv = v.shape[-1]
    n = l // DN_CHUNK

    def chunk(t):
        return jnp.moveaxis(t.reshape(b, h, n, DN_CHUNK, *t.shape[3:]), 2, 0)

    qc, kc, vc, bc, gc = chunk(q), chunk(k), chunk(v), chunk(beta), chunk(g)
    gcum = jnp.cumsum(gc, axis=-1)
    idx = jnp.arange(DN_CHUNK)
    lower_incl = idx[:, None] >= idx[None, :]
    strict = idx[:, None] > idx[None, :]
    decay = jnp.exp(jnp.where(lower_incl, gcum[..., :, None] - gcum[..., None, :], -jnp.inf))
    kb = kc * bc[..., None]
    l_mat = jnp.where(strict, jnp.einsum('nbhid,nbhjd->nbhij', kb, kc) * decay, 0.0)
    rhs = jnp.concatenate([vc * bc[..., None], kb * jnp.exp(gcum)[..., None]], axis=-1)
    sol = lax.linalg.triangular_solve(l_mat, rhs, left_side=True, lower=True, unit_diagonal=True)
    u, w = sol[..., :dv], sol[..., dv:]
    intra = jnp.where(lower_incl, jnp.einsum('nbhid,nbhjd->nbhij', qc, kc) * decay, 0.0)
    q_dec = qc * jnp.exp(gcum)[..., None]
    k_dec = kc * jnp.exp(gcum[..., -1:] - gcum)[..., None]
    chunk_decay = jnp.exp(gcum[..., -1])

    def step(s, xs):
        q_d, k_d, u_c, w_c, a_c, d_c = xs
        v_new = u_c - jnp.einsum('bhcd,bhde->bhce', w_c, s)
        o = jnp.einsum('bhcd,bhde->bhce', q_d, s) + jnp.einsum('bhij,bhje->bhie', a_c, v_new)
        s = s * d_c[..., None, None] + jnp.einsum('bhcd,bhce->bhde', k_d, v_new)
        return s, o

    s_final, o = lax.scan(step, s0, (q_dec, k_dec, u, w, intra, chunk_decay))
    return jnp.moveaxis(o, 0, 2).reshape(b, h, l, dv), s_final


def _flip(t):
    return jnp.flip(t, axis=2)


def _attend(q, k, v):
    b, lq = q.shape[:2]
    qg = q.reshape(b, lq, ATTN_KV_HEADS, ATTN_GROUP, ATTN_DH)
    s = jnp.einsum('bqkgd,bskd->bkgqs', qg, k).astype(jnp.float32) * (ATTN_DH ** -0.5)
    p = jax.nn.softmax(s, axis=-1).astype(v.dtype)
    o = jnp.einsum('bkgqs,bskd->bqkgd', p, v)
    return o.reshape(b, lq, ATTN_Q)


def _block_attention(q, k, v):
    b, l = q.shape[:2]
    nb = l // Q_BLOCK
    qb = jnp.moveaxis(q.reshape(b, nb, Q_BLOCK, ATTN_HEADS, ATTN_DH), 1, 0)
    o = lax.map(lambda blk: _attend(blk, k, v), qb)
    return jnp.moveaxis(o, 0, 1).reshape(b, l, ATTN_Q)


def _mixer_inputs(h, w_in, conv_w, a_log, dt_bias, q_norm, k_norm, rope):
    b, l, _ = h.shape
    split_at = np.cumsum(IN_SIZES)[:-1].tolist()
    qkv, z, ba, q_a, kv_a, gates = jnp.split(h @ w_in, split_at, axis=-1)
    qkv = jax.nn.silu(_short_conv(qkv, conv_w))
    q_d, k_d, v_d = jnp.split(qkv, [DN_QK, 2 * DN_QK], axis=-1)
    q_d = _l2norm(q_d.reshape(b, l, DN_HEADS, DN_DK)) * (DN_DK ** -0.5)
    k_d = _l2norm(k_d.reshape(b, l, DN_HEADS, DN_DK))
    v_d = v_d.reshape(b, l, DN_HEADS, DN_DV).astype(jnp.float32)
    ba = ba.astype(jnp.float32).reshape(b, l, 2, 2, DN_HEADS)
    beta = jax.nn.sigmoid(ba[:, :, 0])
    g = -jnp.exp(a_log.astype(jnp.float32)) * jax.nn.softplus(ba[:, :, 1] + dt_bias.astype(jnp.float32))
    dn = (jnp.swapaxes(q_d, 1, 2), jnp.swapaxes(k_d, 1, 2), jnp.swapaxes(v_d, 1, 2),
          jnp.moveaxis(beta, 1, 3), jnp.moveaxis(g, 1, 3))
    q_a = _rmsnorm(q_a.reshape(b, l, ATTN_HEADS, ATTN_DH), q_norm)
    k_a, v_a = jnp.split(kv_a, 2, axis=-1)
    k_a = _rmsnorm(k_a.reshape(b, l, ATTN_KV_HEADS, ATTN_DH), k_norm)
    v_a = v_a.reshape(b, l, ATTN_KV_HEADS, ATTN_DH)
    if rope is not None:
        q_a = _rope(q_a, *rope)
        k_a = _rope(k_a, *rope)
    return dn, (q_a, k_a, v_a), z, gates


def _merge(o_dn, z, o_at, gates, dn_norm, w_dn_out, w_attn_out, w_out):
    b, l, _ = z.shape
    o = _rmsnorm(jnp.swapaxes(o_dn, 1, 2), dn_norm).astype(z.dtype)
    o = o * jax.nn.silu(z.reshape(b, l, DN_HEADS, DN_DV))
    y_dn = o.reshape(b, l, DN_V) @ w_dn_out
    y_at = o_at @ w_attn_out
    g_dn, g_at = jnp.split(gates, 2, axis=-1)
    return (jax.nn.sigmoid(g_dn) * y_dn + jax.nn.sigmoid(g_at) * y_at) @ w_out


def _mixer(h, hc, w_in, conv_w, a_log, dt_bias, dn_norm, w_dn_out, q_norm, k_norm, w_attn_out, w_out, ctx_out):
    b = h.shape[0]
    rope = _rope_tables(h.shape[1], h.dtype)
    (q_d, k_d, v_d, beta, g), (q_a, k_a, v_a), z, gates = _mixer_inputs(
        h, w_in, conv_w, a_log, dt_bias, q_norm, k_norm, rope)
    (qc_d, kc_d, vc_d, betac, gc), (qc_a, kc_a, vc_a), zc, gatesc = _mixer_inputs(
        hc, w_in, conv_w, a_log, dt_bias, q_norm, k_norm, None)
    s0 = jnp.zeros((b, DN_HEADS, DN_DK, DN_DV), jnp.float32)
    oc_f, s_f = _delta_rule(qc_d, kc_d, vc_d, betac[:, 0], gc[:, 0], s0)
    oc_b, s_b = _delta_rule(_flip(qc_d), _flip(kc_d), _flip(vc_d), _flip(betac[:, 1]), _flip(gc[:, 1]), s0)
    o_f, _ = _delta_rule(q_d, k_d, v_d, beta[:, 0], g[:, 0], s_f)
    o_b, _ = _delta_rule(_flip(q_d), _flip(k_d), _flip(v_d), _flip(beta[:, 1]), _flip(g[:, 1]), s_b)
    o_dn = o_f + _flip(o_b)
    k_all = jnp.concatenate([kc_a, k_a], axis=1)
    v_all = jnp.concatenate([vc_a, v_a], axis=1)
    o_at = _block_attention(q_a, k_all, v_all)
    y = _merge(o_dn, z, o_at, gates, dn_norm, w_dn_out, w_attn_out, w_out)
    if not ctx_out:
        return y, None
    yc = _merge(oc_f + _flip(oc_b), zc, _attend(qc_a, kc_a, vc_a), gatesc, dn_norm, w_dn_out, w_attn_out, w_out)
    return y, yc


def setup_inputs(seed: int = 0) -> dict:
    key = jax.random.key(seed)
    ks = jax.random.split(key, 28)
    f32 = jnp.float32

    def nrm(i, shape, std):
        return std * jax.random.normal(ks[i], shape, f32)

    def gain(i, shape):
        return 1.0 + 0.1 * jax.random.normal(ks[i], shape, f32)

    dt = jnp.exp(jax.random.uniform(ks[15], (DEPTH, 2, DN_HEADS), f32, math.log(1e-3), math.log(1e-1)))
    return {
        'x': nrm(0, (BATCH, SEQ, D_MODEL), 1.0),
        'c': nrm(1, (BATCH, D_MODEL), 1.0),
        'ctx': nrm(2, (BATCH, CTX_LEN, D_MODEL), 1.0),
        'c_ctx': nrm(3, (D_MODEL,), 1.0),
        'w_mod': nrm(4, (DEPTH, D_MODEL, N_MOD * D_MODEL), 0.5 * D_MODEL ** -0.5),
        'b_mod': nrm(5, (DEPTH, N_MOD * D_MODEL), 0.01),
        'ffn1_pre': gain(6, (DEPTH, D_MODEL)),
        'ffn1_post': gain(7, (DEPTH, D_MODEL)),
        'ffn1_w_gu': nrm(8, (DEPTH, D_MODEL, 2 * FFN_HIDDEN), D_MODEL ** -0.5),
        'ffn1_w_down': nrm(9, (DEPTH, FFN_HIDDEN, D_MODEL), FFN_HIDDEN ** -0.5),
        'mix_pre': gain(10, (DEPTH, D_MODEL)),
        'mix_post': gain(11, (DEPTH, D_MODEL)),
        'w_in': nrm(12, (DEPTH, D_MODEL, IN_W), D_MODEL ** -0.5),
        'dn_conv': nrm(13, (DEPTH, DN_CONV, 2 * DN_QK + DN_V), DN_CONV ** -0.5),
        'dn_a_log': jnp.log(jax.random.uniform(ks[14], (DEPTH, 2, DN_HEADS), f32, 1.0, 16.0)),
        'dn_dt_bias': dt + jnp.log(-jnp.expm1(-dt)),
        'dn_out_norm': gain(16, (DEPTH, DN_DV)),
        'w_dn_out': nrm(17, (DEPTH, DN_V, D_MODEL), DN_V ** -0.5),
        'attn_q_norm': gain(18, (DEPTH, ATTN_DH)),
        'attn_k_norm': gain(19, (DEPTH, ATTN_DH)),
        'w_attn_out': nrm(20, (DEPTH, ATTN_Q, D_MODEL), ATTN_Q ** -0.5),
        'w_out': nrm(21, (DEPTH, D_MODEL, D_MODEL), D_MODEL ** -0.5),
        'ffn2_pre': gain(22, (DEPTH, D_MODEL)),
        'ffn2_post': gain(23, (DEPTH, D_MODEL)),
        'ffn2_w_gu': nrm(24, (DEPTH, D_MODEL, 2 * FFN_HIDDEN), D_MODEL ** -0.5),
        'ffn2_w_down': nrm(25, (DEPTH, FFN_HIDDEN, D_MODEL), FFN_HIDDEN ** -0.5),
    }


def reference(x, c, ctx, c_ctx, w_mod, b_mod, ffn1_pre, ffn1_post, ffn1_w_gu, ffn1_w_down,
              mix_pre, mix_post, w_in, dn_conv, dn_a_log, dn_dt_bias, dn_out_norm, w_dn_out,
              attn_q_norm, attn_k_norm, w_attn_out, w_out, ffn2_pre, ffn2_post, ffn2_w_gu, ffn2_w_down):
    cx = ctx
    for i in range(DEPTH):
        last = i == DEPTH - 1
        mod = jnp.split((jax.nn.silu(c) @ w_mod[i] + b_mod[i])[:, None, :], N_MOD, axis=-1)
        mod_c = jnp.split((jax.nn.silu(c_ctx) @ w_mod[i] + b_mod[i])[None, None, :], N_MOD, axis=-1)
        x = _ffn_sublayer(x, mod[0], mod[1], mod[2], ffn1_pre[i], ffn1_post[i], ffn1_w_gu[i], ffn1_w_down[i])
        cx = _ffn_sublayer(cx, mod_c[0], mod_c[1], mod_c[2], ffn1_pre[i], ffn1_post[i], ffn1_w_gu[i], ffn1_w_down[i])
        h = _modulate(_rmsnorm(x, mix_pre[i]), mod[3], mod[4])
        hc = _modulate(_rmsnorm(cx, mix_pre[i]), mod_c[3], mod_c[4])
        y, yc = _mixer(h, hc, w_in[i], dn_conv[i], dn_a_log[i], dn_dt_bias[i], dn_out_norm[i], w_dn_out[i],
                       attn_q_norm[i], attn_k_norm[i], w_attn_out[i], w_out[i], not last)
        x = x + mod[5] * _rmsnorm(y, mix_post[i])
        x = _ffn_sublayer(x, mod[6], mod[7], mod[8], ffn2_pre[i], ffn2_post[i], ffn2_w_gu[i], ffn2_w_down[i])
        if not last:
            cx = cx + mod_c[5] * _rmsnorm(yc, mix_post[i])
            cx = _ffn_sublayer(cx, mod_c[6], mod_c[7], mod_c[8], ffn2_pre[i], ffn2_post[i], ffn2_w_gu[i], ffn2_w_down[i])
    return x
```

```cpp
#define EXP_NAIVE_DN 1
#include <hip/hip_runtime.h>
#include <hip/hip_bf16.h>
#include <hip/hip_cooperative_groups.h>
#include <cstdio>
#include <cstdint>
namespace cg = cooperative_groups;
__device__ __forceinline__ int tid_opaque() { int t = threadIdx.x; asm volatile("" : "+v"(t)); return t; }
namespace pg8 {
#define PG8_LAS __attribute__((address_space(3)))
typedef unsigned short bf16_t;
typedef short bf16x8 __attribute__((ext_vector_type(8)));
typedef float f32x4 __attribute__((ext_vector_type(4)));
typedef unsigned u32x4 __attribute__((ext_vector_type(4)));
constexpr int BM = 256, BK = 64, HALF = 128, HTB = HALF * BK * 2  , STAGE_BYTES = 8 * HTB, NXCD = 8, WGM = 8;

__host__ __device__ __forceinline__ int lds_byte(int r, int c) { const int st = (r >> 4) * 2 + (c >> 5), rr = r & 15, cc = c & 31, ob = rr * 64 + cc * 2; return st * 1024 + (ob ^ (((ob >> 9) & 1) << 5)); }
__host__ __device__ __forceinline__ void stage_rc(int b, int& R, int& C) { const int st = b / 1024, sb = b % 1024, swz = sb ^ (((sb >> 9) & 1) << 5); R = (st >> 1) * 16 + swz / 64; C = (st & 1) * 32 + (swz % 64) / 2; }
__host__ __device__ __forceinline__ int perm32(int rho) { const int n = rho >> 4, i = rho & 15; return 8 * (i >> 2) + 4 * n + (i & 3); }

struct Unit { int pm, pn; };
struct Gemm { const bf16_t* A; const bf16_t* Bt; int M, N, K; };

struct StaticOrder {
    int nM, nN, nwg, G, c;
    __host__ __device__ void init(int M, int N, int G_, int c_) { nM = M / BM; nN = N / BM; nwg = nM * nN; G = G_; c = c_; }
    __host__ __device__ bool next(int i, Unit& u) const {
        const long L = (long)i * G + c; if (L >= nwg) return false;
        int wgid = (int)L; { const int q = nwg / NXCD, r = nwg % NXCD, xcd = wgid % NXCD, off = wgid / NXCD; wgid = (xcd < r ? xcd * (q + 1) : r * (q + 1) + (xcd - r) * q) + off; }
        const int nig = WGM * nN, gid = wgid / nig, fm = gid * WGM, gsz = (nM - fm) < WGM ? (nM - fm) : WGM;
        u.pm = fm + ((wgid % nig) % gsz); u.pn = (wgid % nig) / gsz; return true;
    }
    __device__ __forceinline__ void a_ready(const Unit&) const {}
    __device__ __forceinline__ void done(const Unit&) const {}
};
__device__ __forceinline__ unsigned cvt_pk_bf16(float lo, float hi) { unsigned r; asm volatile("v_cvt_pk_bf16_f32 %0, %1, %2" : "=v"(r) : "v"(lo), "v"(hi)); return r; }

template <class Epi, class Sched, bool STAMP = false>
__device__ __forceinline__ void gemm_phase(PG8_LAS unsigned char* lds, const Gemm g, const Sched& S, const Epi& E, unsigned long long* stamps) {
    const int tid = tid_opaque(), wid = __builtin_amdgcn_readfirstlane(tid >> 6), lane = tid & 63, wr = wid >> 2, wc = wid & 3, fr = lane & 15, fq = lane >> 4;
    const int K = g.K, nt = K / BK;
    int ts_lo = 0, ts_hi = 0, nts = 0; const unsigned long long rt_entry = STAMP ? (unsigned long long)wall_clock64() : 0ull;
#define PG8_STAMP() do { if (STAMP && wid == 0 && nts < 64) { const unsigned long long _c = (unsigned long long)clock64(); \
        ts_lo = (lane == nts) ? (int)(unsigned)_c : ts_lo; ts_hi = (lane == nts) ? (int)(unsigned)(_c >> 32) : ts_hi; ++nts; } } while (0)
    PG8_STAMP();
    unsigned voffA[2], voffB[2];
#pragma unroll
    for (int i = 0; i < 2; ++i) { int R, C; stage_rc(tid * 16 + i * 8192, R, C); const int Rb = Epi::PERM ? ((R & ~31) + perm32(R & 31)) : R;
        voffA[i] = (unsigned)(R * K + C) * 2u; voffB[i] = (unsigned)(Rb * K + C) * 2u; }
    const size_t kstep = (size_t)(BK * 2);
    const size_t hstep = (size_t)HALF * K * 2;
    const size_t tstep = 2 * hstep;
    const unsigned ldsw = (unsigned)wid * 1024u;
    const int aoff = lds_byte(wr * 64 + fr, fq * 8), boff = lds_byte(wc * 32 + fr, fq * 8);
#define PG8_SA(b, h) (((b) * 2 + (h)) * HTB)
#define PG8_SB(b, h) ((4 + (b) * 2 + (h)) * HTB)
#define PG8_STAGE(bufoff, gbase, voff) do { _Pragma("unroll") for (int _i = 0; _i < 2; ++_i) \
        __builtin_amdgcn_global_load_lds((const unsigned*)((const char*)(gbase) + (voff)[_i]), (PG8_LAS unsigned*)(lds + (bufoff) + ldsw + _i * 8192), 16, 0, 0); } while (0)
#define PG8_LDA(dst, b, h) do { _Pragma("unroll") for (int m = 0; m < 4; ++m) _Pragma("unroll") for (int k = 0; k < 2; ++k) dst[m][k] = *(const PG8_LAS bf16x8*)(lds + PG8_SA(b, h) + aoff + m * 2048 + k * 1024); } while (0)
#define PG8_LDB(dst, b, h) do { _Pragma("unroll") for (int n = 0; n < 2; ++n) _Pragma("unroll") for (int k = 0; k < 2; ++k) dst[n][k] = *(const PG8_LAS bf16x8*)(lds + PG8_SB(b, h) + boff + n * 2048 + k * 1024); } while (0)
#define PG8_MMA(ai, bj, At, Bt) do { __builtin_amdgcn_s_setprio(1); _Pragma("unroll") for (int m = 0; m < 4; ++m) _Pragma("unroll") for (int n = 0; n < 2; ++n) _Pragma("unroll") for (int k = 0; k < 2; ++k) \
        acc[ai][bj][m][n] = __builtin_amdgcn_mfma_f32_16x16x32_bf16(Bt[n][k], At[m][k], acc[ai][bj][m][n], 0, 0, 0); __builtin_amdgcn_s_setprio(0); } while (0)
#define PG8_WAIT_V(n) asm volatile("s_waitcnt vmcnt(" #n ")" ::: "memory")
#define PG8_WAIT_L(n) asm volatile("s_waitcnt lgkmcnt(" #n ")" ::: "memory")
#define PG8_BAR __builtin_amdgcn_s_barrier()
#define PG8_SCHED __builtin_amdgcn_sched_barrier(0)
    Unit cur, nxt; int ui = 0;
    if (!S.next(0, cur)) return;
    f32x4 acc[2][2][4][2];
#pragma unroll
    for (int a = 0; a < 2; ++a)
#pragma unroll
        for (int b = 0; b < 2; ++b)
#pragma unroll
            for (int m = 0; m < 4; ++m)
#pragma unroll
                for (int n = 0; n < 2; ++n) acc[a][b][m][n] = (f32x4){0.f, 0.f, 0.f, 0.f};
    bf16x8 At[4][2], B0[2][2], B1[2][2];
    const char* cA = (const char*)g.A + (size_t)cur.pm * tstep; const char* cB = (const char*)g.Bt + (size_t)cur.pn * tstep;
    S.a_ready(cur);
    PG8_STAGE(PG8_SB(0, 0), cB, voffB); PG8_STAGE(PG8_SA(0, 0), cA, voffA); PG8_STAGE(PG8_SB(0, 1), cB + hstep, voffB); PG8_STAGE(PG8_SA(0, 1), cA + hstep, voffA);
    if (wr == 1) PG8_BAR;
    PG8_WAIT_V(4); PG8_BAR;
    PG8_STAGE(PG8_SB(1, 0), cB + kstep, voffB); PG8_STAGE(PG8_SA(1, 0), cA + kstep, voffA); PG8_STAGE(PG8_SB(1, 1), cB + hstep + kstep, voffB);
    PG8_WAIT_V(6); PG8_BAR;
    PG8_STAMP();
    for (;;) {
        const bool has_next = S.next(ui + 1, nxt);
        const char* nA = has_next ? (const char*)g.A + (size_t)nxt.pm * tstep : cA; const char* nB = has_next ? (const char*)g.Bt + (size_t)nxt.pn * tstep : cB;
        for (int t = 0; t < nt; t += 2) {
            const bool last = (t == nt - 2);
            const char* a1 = cA + (size_t)(t + 1) * kstep;
            const char* a2 = last ? nA : cA + (size_t)(t + 2) * kstep; const char* b2 = last ? nB : cB + (size_t)(t + 2) * kstep;
            const char* a3 = a2 + kstep; const char* b3 = b2 + kstep;
            if (last && has_next) S.a_ready(nxt);
            PG8_LDB(B0, 0, 0); PG8_SCHED; PG8_LDA(At, 0, 0); PG8_STAGE(PG8_SA(1, 1), a1 + hstep, voffA);
            PG8_WAIT_L(8); PG8_BAR; PG8_WAIT_L(0); PG8_MMA(0, 0, At, B0); PG8_BAR; PG8_SCHED;
            PG8_LDB(B1, 0, 1); PG8_STAGE(PG8_SB(0, 0), b2, voffB);
            PG8_BAR; PG8_WAIT_L(0); PG8_MMA(0, 1, At, B1); PG8_BAR;
            PG8_LDA(At, 0, 1); PG8_STAGE(PG8_SA(0, 0), a2, voffA);
            PG8_BAR; PG8_WAIT_L(0); PG8_MMA(1, 0, At, B0); PG8_BAR; PG8_SCHED;
            PG8_STAGE(PG8_SB(0, 1), b2 + hstep, voffB);
            PG8_WAIT_V(6); PG8_BAR; PG8_MMA(1, 1, At, B1); PG8_BAR;
            PG8_LDB(B0, 1, 0); PG8_SCHED; PG8_LDA(At, 1, 0); PG8_STAGE(PG8_SA(0, 1), a2 + hstep, voffA);
            PG8_WAIT_L(8); PG8_BAR; PG8_WAIT_L(0); PG8_MMA(0, 0, At, B0); PG8_BAR; PG8_SCHED;
            PG8_LDB(B1, 1, 1); PG8_STAGE(PG8_SB(1, 0), b3, voffB);
            PG8_BAR; PG8_WAIT_L(0); PG8_MMA(0, 1, At, B1); PG8_BAR;
            PG8_LDA(At, 1, 1); PG8_STAGE(PG8_SA(1, 0), a3, voffA);
            PG8_BAR; PG8_WAIT_L(0); PG8_MMA(1, 0, At, B0); PG8_BAR; PG8_SCHED;
            PG8_STAGE(PG8_SB(1, 1), b3 + hstep, voffB);
            PG8_WAIT_V(6); PG8_BAR; PG8_MMA(1, 1, At, B1); PG8_BAR;
        }
        PG8_STAMP();
        if constexpr (!Epi::AFTER_DRAIN) { E(acc, cur, wr, wc, fr, fq); S.done(cur); }
        PG8_STAMP();
        if (!has_next) break;
#pragma unroll
        for (int a = 0; a < 2; ++a)
#pragma unroll
            for (int b = 0; b < 2; ++b)
#pragma unroll
                for (int m = 0; m < 4; ++m)
#pragma unroll
                    for (int n = 0; n < 2; ++n) acc[a][b][m][n] = (f32x4){0.f, 0.f, 0.f, 0.f};
        cur = nxt; cA = nA; cB = nB; ++ui;
    }
    PG8_WAIT_V(0);
    if (wr == 0) PG8_BAR;
    PG8_BAR;
    if constexpr (Epi::AFTER_DRAIN) { E.fused(acc, cur, wr, wc, fr, fq, lds, wid, lane); S.done(cur); }
    PG8_STAMP();
    if (STAMP && wid == 0) { stamps[lane] = lane < nts ? (((unsigned long long)(unsigned)ts_hi << 32) | (unsigned)ts_lo) : 0ull;
        if (lane == 62) stamps[62] = rt_entry; if (lane == 63) stamps[63] = (unsigned long long)wall_clock64(); }
#undef PG8_STAMP
#undef PG8_SA
#undef PG8_SB
#undef PG8_STAGE
#undef PG8_LDA
#undef PG8_LDB
#undef PG8_MMA
#undef PG8_WAIT_V
#undef PG8_WAIT_L
#undef PG8_BAR
#undef PG8_SCHED
}
}
namespace at {
using bf16 = __hip_bfloat16;
constexpr int   D = 128, NW = 8, QBLK = 32, KVBLK = 64;
constexpr float SCALE = 0.088388347648318440f;
constexpr float THR = 8.f;
constexpr int SDEPTH = 1;
constexpr int LDQ = 1024, LDK = 256, LDO = 1024;
constexpr size_t SHM_V = KVBLK * D * 2, SHM_K = KVBLK * D * 2, SHM_ATTN = 2 * SHM_V + 2 * SHM_K + NW * 64 * 4;
__device__ __forceinline__ unsigned short f2bf_rne(float f) { unsigned u = __float_as_uint(f); u += 0x7FFFu + ((u >> 16) & 1u); return (unsigned short)(u >> 16); }
using bf16x8 = __attribute__((ext_vector_type(8))) short;
using s16x4  = __attribute__((ext_vector_type(4))) short;
using f32x16 = __attribute__((ext_vector_type(16))) float;
using f32x8  = __attribute__((ext_vector_type(8))) float;
using u32x4  = __attribute__((ext_vector_type(4))) unsigned;
#define KSWZ(row, colB) ((row) * 256 + ((colB) ^ (((row) & 7) << 4)))
#define SBAR() __builtin_amdgcn_sched_barrier(0)
__device__ __forceinline__ int crow(int r, int hi) { return (r & 3) + 8 * (r >> 2) + 4 * hi; }
__device__ __forceinline__ unsigned cvtpk(float lo, float hi) {
  unsigned r; asm volatile("v_cvt_pk_bf16_f32 %0, %1, %2" : "=v"(r) : "v"(lo), "v"(hi)); return r;
}
template <typename TIn> struct Stage;
template <> struct Stage<bf16>  { using T = bf16x8;
  __device__ static __forceinline__ T ld8(const bf16* p) { return *reinterpret_cast<const bf16x8*>(p); }
  __device__ static __forceinline__ bf16x8 tobf(T x) { return x; } };
template <> struct Stage<float> { using T = f32x8;
  __device__ static __forceinline__ T ld8(const float* p) { return *reinterpret_cast<const f32x8*>(p); }
  __device__ static __forceinline__ bf16x8 tobf(T x) {
    u32x4 w = {cvtpk(x[0], x[1]), cvtpk(x[2], x[3]), cvtpk(x[4], x[5]), cvtpk(x[6], x[7])}; return *reinterpret_cast<bf16x8*>(&w); } };

__device__ __forceinline__ void partialSM(f32x16& p0, f32x16& p1, float& m_reg, float& mn, float& alpha) {
  constexpr float C = SCALE * 1.4426950408889634f;
  float pmax = p0[0]; for (int r = 1; r < 16; ++r) pmax = fmaxf(pmax, p0[r]); for (int r = 0; r < 16; ++r) pmax = fmaxf(pmax, p1[r]);
  { auto rr = __builtin_amdgcn_permlane32_swap(__float_as_uint(pmax), __float_as_uint(pmax), false, false);
    pmax = fmaxf(__uint_as_float(rr[0]), __uint_as_float(rr[1])); }
  if (__builtin_expect(__all(pmax - m_reg <= THR / SCALE), 1)) { mn = m_reg; alpha = 1.f; }
  else { mn = fmaxf(m_reg, pmax); alpha = __builtin_amdgcn_exp2f((m_reg - mn) * C); m_reg = mn; }
  float mnC = -mn * C;
  for (int r = 0; r < 16; ++r) p0[r] = fmaf(p0[r], C, mnC); for (int r = 0; r < 16; ++r) p1[r] = fmaf(p1[r], C, mnC);
  for (int r = 0; r < 16; ++r) p0[r] = __builtin_amdgcn_exp2f(p0[r]);
}
__device__ __forceinline__ void finishSM(f32x16& p0, f32x16& p1, float alpha, float& l_reg, bf16x8& pa0, bf16x8& pa1, bf16x8& pa2, bf16x8& pa3) {
  for (int r = 0; r < 16; ++r) p1[r] = __builtin_amdgcn_exp2f(p1[r]);
  float ps = 0; for (int r = 0; r < 16; ++r) ps += p0[r]; for (int r = 0; r < 16; ++r) ps += p1[r];
  { auto rr = __builtin_amdgcn_permlane32_swap(__float_as_uint(ps), __float_as_uint(ps), false, false);
    ps = __uint_as_float(rr[0]) + __uint_as_float(rr[1]); }
  l_reg = l_reg * alpha + ps;
#define PK4(P, BASE, OUT) do { unsigned a0 = cvtpk(P[BASE + 0], P[BASE + 1]), a1 = cvtpk(P[BASE + 2], P[BASE + 3]);   \
    unsigned b0 = cvtpk(P[BASE + 4], P[BASE + 5]), b1 = cvtpk(P[BASE + 6], P[BASE + 7]);                              \
    auto r0 = __builtin_amdgcn_permlane32_swap(a0, b0, false, false); auto r1 = __builtin_amdgcn_permlane32_swap(a1, b1, false, false); \
    u32x4 w = {r0[0], r1[0], r0[1], r1[1]}; OUT = *reinterpret_cast<bf16x8*>(&w); } while (0)
  PK4(p0, 0, pa0); PK4(p0, 8, pa1); PK4(p1, 0, pa2); PK4(p1, 8, pa3);
#undef PK4
}
__device__ __forceinline__ void qkt(f32x16& p0, f32x16& p1, const bf16* Ks, const bf16x8* qr, int r32, int hi) {
  p0 = f32x16{}; p1 = f32x16{};
  for (int d0 = 0; d0 < 8; ++d0) { int cb = (d0 * 16 + hi * 8) * 2;
    bf16x8 b0 = *reinterpret_cast<const bf16x8*>((const char*)Ks + KSWZ(r32, cb));
    bf16x8 b1 = *reinterpret_cast<const bf16x8*>((const char*)Ks + KSWZ(32 + r32, cb));
    p0 = __builtin_amdgcn_mfma_f32_32x32x16_bf16(b0, qr[d0], p0, 0, 0, 0);
    p1 = __builtin_amdgcn_mfma_f32_32x32x16_bf16(b1, qr[d0], p1, 0, 0, 0); }
}
__device__ __forceinline__ int v_st(int k, int c) { const int kk = (k & ~0xC) | ((k & 4) << 1) | ((k & 8) >> 1); return ((kk >> 3) * 4 + (c >> 5)) * 512 + ((kk & 7) * 32 + (c & 31)) * 2; }
__device__ __forceinline__ int v_rd_base(int lane) { return ((lane & 3) << 3) | (((lane >> 2) & 3) << 6) | (((lane >> 4) & 1) << 5) | (((lane >> 5) & 1) << 8); }
constexpr int v_rd_off(int d0, int ks, int half) { return d0 * 512 + ks * 4096 + half * 2048; }
template <int OFF> __device__ __forceinline__ s16x4 tr_read(int vb) {
  s16x4 r; asm volatile("ds_read_b64_tr_b16 %0, %1 offset:%2" : "=&v"(r) : "v"(vb), "i"(OFF) : "memory"); return r;
}
template <int D0> __device__ __forceinline__ void pv_one(f32x16& od, int vb, bf16x8 pa0, bf16x8 pa1, bf16x8 pa2, bf16x8 pa3) {
  const s16x4 l0 = tr_read<v_rd_off(D0, 0, 0)>(vb), h0 = tr_read<v_rd_off(D0, 0, 1)>(vb), l1 = tr_read<v_rd_off(D0, 1, 0)>(vb), h1 = tr_read<v_rd_off(D0, 1, 1)>(vb);
  const s16x4 l2 = tr_read<v_rd_off(D0, 2, 0)>(vb), h2 = tr_read<v_rd_off(D0, 2, 1)>(vb), l3 = tr_read<v_rd_off(D0, 3, 0)>(vb), h3 = tr_read<v_rd_off(D0, 3, 1)>(vb);
  asm volatile("s_waitcnt lgkmcnt(0)" ::: "memory"); SBAR();
#define PK(L, H) (bf16x8){L[0], L[1], L[2], L[3], H[0], H[1], H[2], H[3]}
  od = __builtin_amdgcn_mfma_f32_32x32x16_bf16(pa0, PK(l0, h0), od, 0, 0, 0);
  od = __builtin_amdgcn_mfma_f32_32x32x16_bf16(pa1, PK(l1, h1), od, 0, 0, 0);
  od = __builtin_amdgcn_mfma_f32_32x32x16_bf16(pa2, PK(l2, h2), od, 0, 0, 0);
  od = __builtin_amdgcn_mfma_f32_32x32x16_bf16(pa3, PK(l3, h3), od, 0, 0, 0);
#undef PK
}
__device__ __forceinline__ void pv_d0(f32x16* o, int vb, bf16x8 pa0, bf16x8 pa1, bf16x8 pa2, bf16x8 pa3) {
  pv_one<0>(o[0], vb, pa0, pa1, pa2, pa3); pv_one<1>(o[1], vb, pa0, pa1, pa2, pa3); pv_one<2>(o[2], vb, pa0, pa1, pa2, pa3); pv_one<3>(o[3], vb, pa0, pa1, pa2, pa3);
}

template <typename TQ>
__device__ __forceinline__ void attn_dense_body(const TQ* __restrict__ Qb, const bf16* __restrict__ Kh, const bf16* __restrict__ Vh,
                                                unsigned short* Ob, int seq, char* lds) {
  using St = Stage<bf16>; using SQ = Stage<TQ>;
  const int tid = tid_opaque(), wid = tid >> 6, lane = tid & 63, r32 = lane & 31, hi = lane >> 5;
  bf16* V_lds = (bf16*)lds; bf16* K_lds = (bf16*)(lds + 2 * SHM_V);
  float* ws = (float*)(lds + 2 * SHM_V + 2 * SHM_K) + wid * 64; float* li_l = ws; float* al_l = ws + 32;
  float m_reg = -1e30f, l_reg = 0; f32x16 o[4] = {}; bf16x8 qr[8];
  const TQ* Qw = Qb + (long)(wid * QBLK + r32) * LDQ + hi * 8;
#pragma unroll
  for (int d0 = 0; d0 < 8; ++d0) qr[d0] = SQ::tobf(SQ::ld8(Qw + d0 * 16));
  const int sr = tid >> 4, sc = (tid & 15) * 8, vst0 = v_st(sr, sc), vst1 = v_st(32 + sr, sc);
  const int vb0 = (int)(uintptr_t)V_lds + v_rd_base(lane);
  struct { typename St::T vs0, vs1, ks0, ks1; } sr_[SDEPTH];
#define SLOAD(i, k0) do { sr_[i].vs0 = St::ld8(&Vh[(long)((k0) + sr) * LDK + sc]); sr_[i].vs1 = St::ld8(&Vh[(long)((k0) + 32 + sr) * LDK + sc]); \
    sr_[i].ks0 = St::ld8(&Kh[(long)((k0) + sr) * LDK + sc]); sr_[i].ks1 = St::ld8(&Kh[(long)((k0) + 32 + sr) * LDK + sc]); } while (0)
#define SWRITE(b, i) do { *(bf16x8*)((char*)V_lds + (b) * SHM_V + vst0) = St::tobf(sr_[i].vs0);          \
    *(bf16x8*)((char*)V_lds + (b) * SHM_V + vst1) = St::tobf(sr_[i].vs1); int kc = sc * 2;               \
    *(bf16x8*)((char*)K_lds + (b) * SHM_K + KSWZ(sr, kc)) = St::tobf(sr_[i].ks0);                       \
    *(bf16x8*)((char*)K_lds + (b) * SHM_K + KSWZ(32 + sr, kc)) = St::tobf(sr_[i].ks1); } while (0)
#define SWAIT() do { if constexpr (SDEPTH == 2) asm volatile("s_waitcnt vmcnt(4)" ::: "memory"); else asm volatile("s_waitcnt vmcnt(0)" ::: "memory"); } while (0)
#define RESC(a) do { if (__any((a) < 1.f)) { if (hi == 0) al_l[r32] = (a); asm volatile("s_waitcnt lgkmcnt(0)" ::: "memory"); \
    for (int d = 0; d < 4; ++d) for (int r = 0; r < 16; ++r) o[d][r] *= al_l[crow(r, hi)]; } } while (0)
  f32x16 pA0, pA1, pB0, pB1; float mnA, mnB, alA, alB; bf16x8 pa0, pa1, pa2, pa3; const int NT = seq / KVBLK;
  constexpr int SE = 0, SO = SDEPTH - 1;
  SLOAD(SE, 0); asm volatile("s_waitcnt vmcnt(0)" ::: "memory"); SWRITE(0, SE); __syncthreads();
  qkt(pA0, pA1, K_lds, qr, r32, hi); partialSM(pA0, pA1, m_reg, mnA, alA);
  SLOAD(SO, KVBLK); if constexpr (SDEPTH == 2) { if (2 < NT) SLOAD(SE, 2 * KVBLK); }
  SWAIT(); SWRITE(1, SO); __syncthreads();
  for (int j = 1; j + 1 < NT; j += 2) {
    SBAR(); qkt(pB0, pB1, (bf16*)((char*)K_lds + SHM_K), qr, r32, hi);
    finishSM(pA0, pA1, alA, l_reg, pa0, pa1, pa2, pa3); SBAR();
    SLOAD(SO, (j + SDEPTH) * KVBLK); SBAR();
    pv_d0(o, vb0, pa0, pa1, pa2, pa3); partialSM(pB0, pB1, m_reg, mnB, alB);
    __syncthreads(); SWAIT(); SWRITE(0, SE);
    RESC(alB); __syncthreads();
    SBAR(); qkt(pA0, pA1, K_lds, qr, r32, hi);
    finishSM(pB0, pB1, alB, l_reg, pa0, pa1, pa2, pa3); SBAR();
    if (SDEPTH == 1 || j + 3 < NT) SLOAD(SE, (j + 1 + SDEPTH) * KVBLK); SBAR();
    pv_d0(o, vb0 + (int)SHM_V, pa0, pa1, pa2, pa3); partialSM(pA0, pA1, m_reg, mnA, alA);
    __syncthreads(); SWAIT(); SWRITE(1, SO);
    RESC(alA); __syncthreads();
  }
  SBAR(); qkt(pB0, pB1, (bf16*)((char*)K_lds + SHM_K), qr, r32, hi);
  finishSM(pA0, pA1, alA, l_reg, pa0, pa1, pa2, pa3); SBAR();
  pv_d0(o, vb0, pa0, pa1, pa2, pa3); partialSM(pB0, pB1, m_reg, mnB, alB);
  __syncthreads(); RESC(alB);
  finishSM(pB0, pB1, alB, l_reg, pa0, pa1, pa2, pa3); SBAR();
  pv_d0(o, vb0 + (int)SHM_V, pa0, pa1, pa2, pa3);
  if (hi == 0) li_l[r32] = l_reg; asm volatile("s_waitcnt lgkmcnt(0)" ::: "memory");
  float rli[16];
#pragma unroll
  for (int r = 0; r < 16; ++r) rli[r] = __builtin_amdgcn_rcpf(li_l[crow(r, hi)]);
  unsigned short* Ow = Ob + (long)(wid * QBLK) * LDO;
#pragma unroll
  for (int r = 0; r < 16; ++r) { int orow = crow(r, hi);
    for (int d0 = 0; d0 < 4; ++d0) Ow[(long)orow * LDO + d0 * 32 + r32] = f2bf_rne(o[d0][r] * rli[r]); }
#undef SLOAD
#undef SWRITE
#undef SWAIT
#undef RESC
}

}

typedef unsigned short u16;
typedef float f32x4 __attribute__((ext_vector_type(4)));
typedef unsigned u32x4 __attribute__((ext_vector_type(4)));
typedef unsigned u32x2 __attribute__((ext_vector_type(2)));
typedef short s16x8 __attribute__((ext_vector_type(8)));

constexpr int MLAT = 32768, MCTX = 2048, MALL = 34816, FH = 2816, INW = 7712, NMODC = 9216;
constexpr int LDS_BYTES = 147456;
constexpr size_t MiB = 1048576;
constexpr size_t O_WGU1 = 0;
constexpr size_t O_WD1  = O_WGU1 + (size_t)5632 * 1024 * 2;
constexpr size_t O_WGU2 = O_WD1 + (size_t)1024 * 2816 * 2;
constexpr size_t O_WD2  = O_WGU2 + (size_t)5632 * 1024 * 2;
constexpr size_t O_WIN1 = O_WD2 + (size_t)1024 * 2816 * 2;
constexpr size_t O_WIN2 = O_WIN1 + (size_t)3328 * 1024 * 2;
constexpr size_t O_WDN  = O_WIN2 + (size_t)4608 * 1024 * 2;
constexpr size_t O_WAT  = O_WDN + (size_t)1024 * 1024 * 2;
constexpr size_t O_WOUT = O_WAT + (size_t)1024 * 1024 * 2;
constexpr size_t O_MOD  = O_WOUT + (size_t)1024 * 1024 * 2;
static_assert(O_MOD + 9 * 9216 * 4 <= 56 * MiB, "persistent region");
constexpr size_t O_Y1 = 56 * MiB;
constexpr size_t O_A = 124 * MiB;
constexpr size_t O_ACT = 192 * MiB;
constexpr size_t O_QRAW = 192 * MiB, O_KRAW = 260 * MiB, O_REC = 192 * MiB, O_QD = 340 * MiB, O_KD = 408 * MiB, O_BA = 476 * MiB, O_VD = O_A;
constexpr size_t O_QA = 192 * MiB, O_KVA = 256 * MiB, O_GATES = 290 * MiB, O_Z = 418 * MiB;
constexpr size_t O_KALL = 124 * MiB, O_VALL = 141 * MiB;
constexpr size_t O_A3 = O_A, O_T = O_Z, O_Y = O_A, O_A5 = O_QA, O_ACT2 = 256 * MiB, O_Y2 = O_A;
constexpr size_t WS_NEED = 512 * MiB;
constexpr int REC_BYTES = 17408;

struct Args { const float* in[26]; float* out; unsigned char* ws; };

__device__ __forceinline__ float bf_lo(unsigned w) { return __uint_as_float(w << 16); }
__device__ __forceinline__ float bf_hi(unsigned w) { return __uint_as_float(w & 0xffff0000u); }
__device__ __forceinline__ float bf2f(u16 v) { return __uint_as_float(((unsigned)v) << 16); }
__device__ __forceinline__ u16 f2bf(float f) { unsigned u = __float_as_uint(f); u += 0x7FFFu + ((u >> 16) & 1u); return (u16)(u >> 16); }
__device__ __forceinline__ unsigned pk(float lo, float hi) { return pg8::cvt_pk_bf16(lo, hi); }
__device__ __forceinline__ float silu_f(float v) { return v / (1.f + __expf(-v)); }
__device__ __forceinline__ float sigm_f(float v) { return 1.f / (1.f + __expf(-v)); }
__device__ __forceinline__ float wave_sum(float v) {
#pragma unroll
    for (int o = 32; o > 0; o >>= 1) v += __shfl_xor(v, o);
    return v; }
__device__ __forceinline__ float grp16_sum(float v) {
#pragma unroll
    for (int o = 8; o > 0; o >>= 1) v += __shfl_xor(v, o);
    return v; }
__device__ __forceinline__ float grp32_sum(float v) {
#pragma unroll
    for (int o = 16; o > 0; o >>= 1) v += __shfl_xor(v, o);
    return v; }
__device__ __forceinline__ f32x4 mfma16(s16x8 a, s16x8 b, f32x4 c) { return __builtin_amdgcn_mfma_f32_16x16x32_bf16(a, b, c, 0, 0, 0); }
__device__ __forceinline__ u32x4 pk8(f32x4 a, f32x4 b) { return (u32x4){pk(a[0], a[1]), pk(a[2], a[3]), pk(b[0], b[1]), pk(b[2], b[3])}; }
__device__ __forceinline__ void unpk8(u32x4 w, f32x4& a, f32x4& b) { a = (f32x4){bf_lo(w.x), bf_hi(w.x), bf_lo(w.y), bf_hi(w.y)}; b = (f32x4){bf_lo(w.z), bf_hi(w.z), bf_lo(w.w), bf_hi(w.w)}; }

__device__ __forceinline__ int map_gu(int n) { const int p = n >> 8, r = n & 255; return r < 128 ? p * 128 + r : 2816 + p * 128 + (r - 128); }
__device__ __forceinline__ int map_in1(int n) { return n < 3072 ? n : (n < 3104 ? 4096 + (n - 3072) : -1); }
__device__ __forceinline__ int map_in2(int n) { return n < 1024 ? 3072 + n : (n < 2048 ? 4128 + (n - 1024) : (n < 2560 ? 5152 + (n - 2048) : 5664 + (n - 2560))); }

template <int MAP> __device__ __forceinline__ void cvt_w(const float* __restrict__ src, int K, int Nsrc, u16* __restrict__ dst, int Np, long gtid, long gthreads) {
    const long total = (long)Np * (K >> 5);
    for (long idx = gtid; idx < total; idx += gthreads) {
        const int np = (int)(idx % Np), kg = (int)(idx / Np);
        const int sc = MAP == 0 ? np : (MAP == 1 ? map_gu(np) : (MAP == 2 ? map_in1(np) : map_in2(np)));
        u32x4 w0 = {0u, 0u, 0u, 0u}, w1 = w0, w2 = w0, w3 = w0;
        if (sc >= 0) {
            const float* p = src + (size_t)(kg * 32) * Nsrc + sc;
            float f[32];
#pragma unroll
            for (int j = 0; j < 32; ++j) f[j] = p[(size_t)j * Nsrc];
            w0 = (u32x4){pk(f[0], f[1]), pk(f[2], f[3]), pk(f[4], f[5]), pk(f[6], f[7])};
            w1 = (u32x4){pk(f[8], f[9]), pk(f[10], f[11]), pk(f[12], f[13]), pk(f[14], f[15])};
            w2 = (u32x4){pk(f[16], f[17]), pk(f[18], f[19]), pk(f[20], f[21]), pk(f[22], f[23])};
            w3 = (u32x4){pk(f[24], f[25]), pk(f[26], f[27]), pk(f[28], f[29]), pk(f[30], f[31])};
        }
        u32x4* d = (u32x4*)(dst + (size_t)np * K + kg * 32);
        d[0] = w0; d[1] = w1; d[2] = w2; d[3] = w3;
    }
}

__device__ __forceinline__ void phase_mod(const Args& a, unsigned char* shm) {
    float* sc = (float*)shm;
    float* red = sc + 9216;
    const float* c = a.in[1]; const float* cc = a.in[3]; const float* wmod = a.in[4]; const float* bmod = a.in[5];
    float* mod = (float*)(a.ws + O_MOD);
    const int tid = tid_opaque();
    for (int i = tid; i < 9216; i += 512) { const int r = i >> 10, k = i & 1023; const float v = r < 8 ? c[r * 1024 + k] : cc[k]; sc[i] = silu_f(v); }
    __syncthreads();
    const int cl = tid & 31, kg = tid >> 5;
    for (int task = blockIdx.x; task < 288; task += gridDim.x) {
        const int col = task * 32 + cl;
        float acc[9];
#pragma unroll
        for (int r = 0; r < 9; ++r) acc[r] = 0.f;
#pragma unroll 8
        for (int kk = 0; kk < 64; ++kk) { const int k = kg * 64 + kk; const float w = wmod[(size_t)k * NMODC + col];
#pragma unroll
            for (int r = 0; r < 9; ++r) acc[r] += sc[r * 1024 + k] * w; }
#pragma unroll
        for (int r = 0; r < 9; ++r) red[(kg * 9 + r) * 32 + cl] = acc[r];
        __syncthreads();
        if (tid < 288) { const int r = tid >> 5; float s = bmod[task * 32 + cl];
            for (int g = 0; g < 16; ++g) s += red[(g * 9 + r) * 32 + cl];
            mod[r * NMODC + task * 32 + cl] = s; }
        __syncthreads();
    }
}

struct Row { f32x4 v[4]; };
__device__ __forceinline__ void ld_row_f32(Row& r, const float* p, int lane) {
#pragma unroll
    for (int i = 0; i < 4; ++i) r.v[i] = *(const f32x4*)(p + 256 * i + 4 * lane); }
__device__ __forceinline__ void st_row_f32(const Row& r, float* p, int lane) {
#pragma unroll
    for (int i = 0; i < 4; ++i) *(f32x4*)(p + 256 * i + 4 * lane) = r.v[i]; }
__device__ __forceinline__ void ld_row_bf(Row& r, const u16* p, int lane) {
#pragma unroll
    for (int i = 0; i < 4; ++i) { const u32x2 u = *(const u32x2*)(p + 256 * i + 4 * lane); r.v[i] = (f32x4){bf_lo(u.x), bf_hi(u.x), bf_lo(u.y), bf_hi(u.y)}; } }
__device__ __forceinline__ void st_row_bf(const Row& r, u16* p, int lane) {
#pragma unroll
    for (int i = 0; i < 4; ++i) { u32x2 u; u.x = pk(r.v[i][0], r.v[i][1]); u.y = pk(r.v[i][2], r.v[i][3]); *(u32x2*)(p + 256 * i + 4 * lane) = u; } }
__device__ __forceinline__ void row_norm(Row& y, const Row& x, const float* g, int lane) {
    float s = 0.f;
#pragma unroll
    for (int i = 0; i < 4; ++i) s += x.v[i][0] * x.v[i][0] + x.v[i][1] * x.v[i][1] + x.v[i][2] * x.v[i][2] + x.v[i][3] * x.v[i][3];
    s = wave_sum(s);
    const float rs = rsqrtf(s * (1.f / 1024.f) + 1e-6f);
#pragma unroll
    for (int i = 0; i < 4; ++i) { const f32x4 gv = *(const f32x4*)(g + 256 * i + 4 * lane); y.v[i] = x.v[i] * rs * gv; } }
__device__ __forceinline__ void row_mod(Row& h, const float* shift, const float* scale, int lane) {
#pragma unroll
    for (int i = 0; i < 4; ++i) { const f32x4 sh = *(const f32x4*)(shift + 256 * i + 4 * lane), sc = *(const f32x4*)(scale + 256 * i + 4 * lane); h.v[i] = h.v[i] * (sc + 1.f) + sh; } }
__device__ __forceinline__ void row_res(Row& x, const Row& t, const float* gate, float w, int lane) {
#pragma unroll
    for (int i = 0; i < 4; ++i) { const f32x4 gv = *(const f32x4*)(gate + 256 * i + 4 * lane); x.v[i] = x.v[i] + gv * t.v[i] * w; } }

__device__ __forceinline__ void phase_h1(const Args& a) {
    const int lane = tid_opaque() & 63, gw = blockIdx.x * 8 + (tid_opaque() >> 6), nw = gridDim.x * 8;
    const float* mod = (const float*)(a.ws + O_MOD); u16* A = (u16*)(a.ws + O_A);
    for (int row = gw; row < MALL; row += nw) {
        const bool lat = row < MLAT; const float* src = lat ? a.in[0] + (size_t)row * 1024 : a.in[2] + (size_t)(row - MLAT) * 1024;
        const float* md = mod + (lat ? (row >> 12) : 8) * NMODC;
        Row xr, h; ld_row_f32(xr, src, lane); row_norm(h, xr, a.in[6], lane); row_mod(h, md, md + 1024, lane); st_row_bf(h, A + (size_t)row * 1024, lane);
    }
}
__device__ __forceinline__ void make_x1(const Args& a, Row& x1, int row, const float* md, int lane) {
    const bool lat = row < MLAT; const float* src = lat ? a.in[0] + (size_t)row * 1024 : a.in[2] + (size_t)(row - MLAT) * 1024;
    Row yr, t; ld_row_f32(x1, src, lane); ld_row_bf(yr, (const u16*)(a.ws + O_Y1) + (size_t)row * 1024, lane);
    row_norm(t, yr, a.in[7], lane); row_res(x1, t, md + 2 * 1024, 0.5f, lane);
}
__device__ __forceinline__ void phase_h2(const Args& a) {
    const int lane = tid_opaque() & 63, gw = blockIdx.x * 8 + (tid_opaque() >> 6), nw = gridDim.x * 8;
    const float* mod = (const float*)(a.ws + O_MOD); u16* A = (u16*)(a.ws + O_A);
    for (int row = gw; row < MALL; row += nw) {
        const float* md = mod + (row < MLAT ? (row >> 12) : 8) * NMODC;
        Row x1, h; make_x1(a, x1, row, md, lane); row_norm(h, x1, a.in[10], lane); row_mod(h, md + 3 * 1024, md + 4 * 1024, lane); st_row_bf(h, A + (size_t)row * 1024, lane);
    }
}
__device__ __forceinline__ void phase_h3(const Args& a) {
    const int lane = tid_opaque() & 63, gw = blockIdx.x * 8 + (tid_opaque() >> 6), nw = gridDim.x * 8;
    const float* mod = (const float*)(a.ws + O_MOD); u16* A5 = (u16*)(a.ws + O_A5); const u16* Y = (const u16*)(a.ws + O_Y);
    for (int row = gw; row < MLAT; row += nw) {
        const float* md = mod + (row >> 12) * NMODC;
        Row x2, yr, t, h; make_x1(a, x2, row, md, lane); ld_row_bf(yr, Y + (size_t)row * 1024, lane); row_norm(t, yr, a.in[11], lane); row_res(x2, t, md + 5 * 1024, 1.0f, lane);
        st_row_f32(x2, a.out + (size_t)row * 1024, lane);
        row_norm(h, x2, a.in[22], lane); row_mod(h, md + 6 * 1024, md + 7 * 1024, lane); st_row_bf(h, A5 + (size_t)row * 1024, lane);
    }
}
__device__ __forceinline__ void phase_out(const Args& a) {
    const int lane = tid_opaque() & 63, gw = blockIdx.x * 8 + (tid_opaque() >> 6), nw = gridDim.x * 8;
    const float* mod = (const float*)(a.ws + O_MOD); const u16* Y2 = (const u16*)(a.ws + O_Y2);
    for (int row = gw; row < MLAT; row += nw) {
        const float* md = mod + (row >> 12) * NMODC;
        Row x2, yr, t; ld_row_f32(x2, a.out + (size_t)row * 1024, lane); ld_row_bf(yr, Y2 + (size_t)row * 1024, lane); row_norm(t, yr, a.in[23], lane); row_res(x2, t, md + 8 * 1024, 0.5f, lane);
        st_row_f32(x2, a.out + (size_t)row * 1024, lane);
    }
}

struct EpiPlain { static constexpr bool PERM = true, AFTER_DRAIN = false; u16* O; int ldc;
    __device__ __forceinline__ void operator()(const pg8::f32x4 (&acc)[2][2][4][2], const pg8::Unit& u, int wr, int wc, int fr, int fq) const {
        const int row0 = u.pm * 256 + wr * 64 + fr, col0 = u.pn * 256 + wc * 32 + 8 * fq;
#pragma unroll
        for (int ai = 0; ai < 2; ++ai)
#pragma unroll
            for (int m = 0; m < 4; ++m) { u16* rp = O + (size_t)(row0 + ai * 128 + m * 16) * ldc + col0;
#pragma unroll
                for (int bj = 0; bj < 2; ++bj) *(u32x4*)(rp + bj * 128) = pk8(acc[ai][bj][m][0], acc[ai][bj][m][1]); } } };

struct EpiSwiglu { static constexpr bool PERM = true, AFTER_DRAIN = false; u16* O;
    __device__ __forceinline__ void operator()(const pg8::f32x4 (&acc)[2][2][4][2], const pg8::Unit& u, int wr, int wc, int fr, int fq) const {
        const int row0 = u.pm * 256 + wr * 64 + fr, col0 = u.pn * 128 + wc * 32 + 8 * fq;
#pragma unroll
        for (int ai = 0; ai < 2; ++ai)
#pragma unroll
            for (int m = 0; m < 4; ++m) { u16* rp = O + (size_t)(row0 + ai * 128 + m * 16) * FH + col0;
                f32x4 o0, o1;
#pragma unroll
                for (int j = 0; j < 4; ++j) { o0[j] = silu_f(acc[ai][0][m][0][j]) * acc[ai][1][m][0][j]; o1[j] = silu_f(acc[ai][0][m][1][j]) * acc[ai][1][m][1][j]; }
                *(u32x4*)rp = pk8(o0, o1); } } };

struct EpiIn1 { static constexpr bool PERM = true, AFTER_DRAIN = false; u16* O; size_t stride;
    __device__ __forceinline__ void operator()(const pg8::f32x4 (&acc)[2][2][4][2], const pg8::Unit& u, int wr, int wc, int fr, int fq) const {
        const int row0 = u.pm * 256 + wr * 64 + fr;
        u16* base = O + (size_t)(u.pn >> 2) * stride; const int col0 = (u.pn & 3) * 256 + wc * 32 + 8 * fq;
#pragma unroll
        for (int ai = 0; ai < 2; ++ai)
#pragma unroll
            for (int m = 0; m < 4; ++m) { u16* rp = base + (size_t)(row0 + ai * 128 + m * 16) * 1024 + col0;
#pragma unroll
                for (int bj = 0; bj < 2; ++bj) *(u32x4*)(rp + bj * 128) = pk8(acc[ai][bj][m][0], acc[ai][bj][m][1]); } } };
struct EpiBa { static constexpr bool PERM = true, AFTER_DRAIN = false; float* ba;
    __device__ __forceinline__ void operator()(const pg8::f32x4 (&acc)[2][2][4][2], const pg8::Unit& u, int wr, int wc, int fr, int fq) const {
        const int row0 = u.pm * 256 + wr * 64 + fr;
        if (wc == 0) {
#pragma unroll
            for (int ai = 0; ai < 2; ++ai)
#pragma unroll
                for (int m = 0; m < 4; ++m) { float* rp = ba + (size_t)(row0 + ai * 128 + m * 16) * 32 + 8 * fq;
                    *(f32x4*)rp = acc[ai][0][m][0]; *(f32x4*)(rp + 4) = acc[ai][0][m][1]; } } } };

struct EpiIn2 { static constexpr bool PERM = true, AFTER_DRAIN = false; u16* z; u16* qa; u16* kva; u16* gates;
    __device__ __forceinline__ void operator()(const pg8::f32x4 (&acc)[2][2][4][2], const pg8::Unit& u, int wr, int wc, int fr, int fq) const {
        const int row0 = u.pm * 256 + wr * 64 + fr; const bool lat = u.pm < 128;
        u16* base; int ldc, col0; bool sig = false;
        if (u.pn < 4) { if (!lat) return; base = z; ldc = 1024; col0 = u.pn * 256; }
        else if (u.pn < 8) { if (!lat) return; base = qa; ldc = 1024; col0 = (u.pn - 4) * 256; }
        else if (u.pn < 10) { base = kva; ldc = 512; col0 = (u.pn - 8) * 256; }
        else { if (!lat) return; base = gates; ldc = 2048; col0 = (u.pn - 10) * 256; sig = true; }
        col0 += wc * 32 + 8 * fq;
#pragma unroll
        for (int ai = 0; ai < 2; ++ai)
#pragma unroll
            for (int m = 0; m < 4; ++m) { u16* rp = base + (size_t)(row0 + ai * 128 + m * 16) * ldc + col0;
#pragma unroll
                for (int bj = 0; bj < 2; ++bj) { f32x4 v0 = acc[ai][bj][m][0], v1 = acc[ai][bj][m][1];
                    if (sig) {
#pragma unroll
                        for (int j = 0; j < 4; ++j) { v0[j] = sigm_f(v0[j]); v1[j] = sigm_f(v1[j]); } }
                    *(u32x4*)(rp + bj * 128) = pk8(v0, v1); } } } };

template <int SECOND> struct EpiMerge { static constexpr bool PERM = true, AFTER_DRAIN = false; const u16* gates; u16* T;
    __device__ __forceinline__ void operator()(const pg8::f32x4 (&acc)[2][2][4][2], const pg8::Unit& u, int wr, int wc, int fr, int fq) const {
        const int row0 = u.pm * 256 + wr * 64 + fr, col0 = u.pn * 256 + wc * 32 + 8 * fq;
#pragma unroll
        for (int ai = 0; ai < 2; ++ai)
#pragma unroll
            for (int m = 0; m < 4; ++m) { const size_t row = (size_t)(row0 + ai * 128 + m * 16);
#pragma unroll
                for (int bj = 0; bj < 2; ++bj) { const int col = col0 + bj * 128;
                    const u32x4 gw = *(const u32x4*)(gates + row * 2048 + SECOND * 1024 + col); f32x4 g0, g1; unpk8(gw, g0, g1);
                    f32x4 o0 = g0 * acc[ai][bj][m][0], o1 = g1 * acc[ai][bj][m][1];
#if defined(EXP_ZERO_DN)
                    if (!SECOND) { o0 *= 0.f; o1 *= 0.f; }
#endif
#if defined(EXP_ZERO_AT)
                    if (SECOND) { o0 *= 0.f; o1 *= 0.f; }
#endif
                    if (SECOND) { const u32x4 tw = *(const u32x4*)(T + row * 1024 + col); f32x4 t0, t1; unpk8(tw, t0, t1); o0 += t0; o1 += t1; }
                    *(u32x4*)(T + row * 1024 + col) = pk8(o0, o1); } } } };

template <class Epi> __device__ __forceinline__ void run_gemm(unsigned char* shm, const u16* A, const u16* Bt, int M, int N, int K, const Epi& E) {
    pg8::Gemm g; g.A = A; g.Bt = Bt; g.M = M; g.N = N; g.K = K;
    pg8::StaticOrder S; S.init(M, N, (int)gridDim.x, (int)blockIdx.x);
    pg8::gemm_phase<Epi, pg8::StaticOrder, false>((PG8_LAS unsigned char*)shm, g, S, E, nullptr);
}

__device__ __forceinline__ void phase_dn_prep(const Args& a) {
    const int lane = tid_opaque() & 63, gw = blockIdx.x * 8 + (tid_opaque() >> 6), nw = gridDim.x * 8;
    const u16* raw0 = (const u16*)(a.ws + O_QRAW); const u16* raw1 = (const u16*)(a.ws + O_KRAW); const u16* raw2 = (const u16*)a.out;
    u16* out0 = (u16*)(a.ws + O_QD); u16* out1 = (u16*)(a.ws + O_KD); u16* out2 = (u16*)(a.ws + O_VD);
    const float* cw = a.in[13];
    for (int row = gw; row < MALL; row += nw) {
        const int pos = row < MLAT ? (row & 4095) : ((row - MLAT) & 255); const int L = row < MLAT ? 4096 : 256;
        const bool hp = pos > 0, hn = pos < L - 1;
#pragma unroll
        for (int i = 0; i < 6; ++i) {
            const int kind = i >> 1, cc = (i & 1) * 512 + 8 * lane, cg_ = kind * 1024 + cc;
            const u16* rp = (kind == 0 ? raw0 : (kind == 1 ? raw1 : raw2)) + (size_t)row * 1024 + cc;
            u16* op = (kind == 0 ? out0 : (kind == 1 ? out1 : out2)) + (size_t)row * 1024 + cc;
            const u32x4 zc = {0u, 0u, 0u, 0u};
            const u32x4 cu = *(const u32x4*)rp; const u32x4 pu = hp ? *(const u32x4*)(rp - 1024) : zc; const u32x4 nu = hn ? *(const u32x4*)(rp + 1024) : zc;
            f32x4 c0, c1, p0, p1, n0, n1; unpk8(cu, c0, c1); unpk8(pu, p0, p1); unpk8(nu, n0, n1);
            const f32x4 wa0 = *(const f32x4*)(cw + cg_), wa1 = *(const f32x4*)(cw + cg_ + 4);
            const f32x4 wb0 = *(const f32x4*)(cw + 3072 + cg_), wb1 = *(const f32x4*)(cw + 3072 + cg_ + 4);
            const f32x4 wc0 = *(const f32x4*)(cw + 6144 + cg_), wc1 = *(const f32x4*)(cw + 6144 + cg_ + 4);
            f32x4 v0 = wa0 * p0 + wb0 * c0 + wc0 * n0, v1 = wa1 * p1 + wb1 * c1 + wc1 * n1;
            float ss = 0.f;
#pragma unroll
            for (int j = 0; j < 4; ++j) { v0[j] = silu_f(v0[j]); v1[j] = silu_f(v1[j]); ss += v0[j] * v0[j] + v1[j] * v1[j]; }
            if (kind < 2) { ss = grp16_sum(ss); const float sc = rsqrtf(ss + 1e-6f) * (kind == 0 ? 0.08838834764831845f : 1.f); v0 *= sc; v1 *= sc; }
            *(u32x4*)op = pk8(v0, v1);
        }
    }
}

__device__ __forceinline__ void phase_dn_pre(const Args& a, unsigned char* shm) {
    const int tid = tid_opaque(), wid = tid >> 6, lane0 = tid & 63;
    float* Lm = (float*)(shm + wid * 17408); float* gcs = Lm + 4096; float* bts = gcs + 64;
    const u16* qd = (const u16*)(a.ws + O_QD); const u16* kd = (const u16*)(a.ws + O_KD); const float* BA = (const float*)(a.ws + O_BA);
    unsigned char* REC = a.ws + O_REC;
    for (int task = blockIdx.x * 8 + wid; task < 8704; task += gridDim.x * 8) {
        int lane = lane0; asm volatile("" : "+v"(lane));
        const int fr = lane & 15, quad = lane >> 4;
        const int c68 = task % 68; int tt = task / 68; const int dir = tt & 1; tt >>= 1; const int h = tt & 7; const int b = tt >> 3;
        const int base = c68 < 4 ? MLAT + b * 256 + c68 * 64 : b * 4096 + (c68 - 4) * 64;
        const int tok = dir ? 63 - lane : lane;
        const float* bap = BA + (size_t)(base + tok) * 32;
        const float beta = sigm_f(bap[dir * 8 + h]);
        const float xs = bap[16 + dir * 8 + h] + a.in[15][dir * 8 + h];
        const float sp = fmaxf(xs, 0.f) + log1pf(__expf(-fabsf(xs)));
        const float g = -__expf(a.in[14][dir * 8 + h]) * sp;
        float gc = g;
#pragma unroll
        for (int o = 1; o < 64; o <<= 1) { const float nb = __shfl_up(gc, o); if (lane >= o) gc += nb; }
        const float glast = __shfl(gc, 63);
        asm volatile("s_waitcnt lgkmcnt(0)" ::: "memory");
        gcs[lane] = gc; bts[lane] = beta;
        unsigned char* rec = REC + (size_t)task * REC_BYTES;
        float* rf = (float*)(rec + 16384);
        rf[lane] = __expf(gc); rf[64 + lane] = __expf(glast - gc); if (lane == 0) rf[128] = __expf(glast);
        asm volatile("s_waitcnt lgkmcnt(0)" ::: "memory");
        s16x8 kf[4][4];
#pragma unroll
        for (int mt = 0; mt < 4; ++mt) { const int r = 16 * mt + fr, tr = dir ? 63 - r : r; const u16* p = kd + (size_t)(base + tr) * 1024 + h * 128 + quad * 8;
#pragma unroll
            for (int kk = 0; kk < 4; ++kk) kf[mt][kk] = *(const s16x8*)(p + kk * 32); }
#pragma unroll
        for (int mt = 0; mt < 4; ++mt)
#pragma unroll
            for (int nt = 0; nt <= mt; ++nt) { f32x4 acc = {0.f, 0.f, 0.f, 0.f};
#pragma unroll
                for (int kk = 0; kk < 4; ++kk) acc = mfma16(kf[mt][kk], kf[nt][kk], acc);
                const int j = 16 * nt + fr; const float gj = gcs[j];
#pragma unroll
                for (int r = 0; r < 4; ++r) { const int i = 16 * mt + quad * 4 + r; Lm[i * 64 + j] = bts[i] * acc[r] * __expf(fminf(gcs[i] - gj, 0.f)); } }
        asm volatile("s_waitcnt lgkmcnt(0)" ::: "memory");
        float tc[64];
#pragma unroll
        for (int i = 0; i < 64; ++i) {
            float s0 = (lane == i) ? 1.f : 0.f, s1 = 0.f, s2 = 0.f, s3 = 0.f;
#pragma unroll
            for (int j4 = 0; j4 < (i + 3) / 4; ++j4) { const f32x4 l = *(const f32x4*)(Lm + i * 64 + j4 * 4);
                if (4 * j4 + 0 < i) s0 -= l[0] * tc[4 * j4 + 0];
                if (4 * j4 + 1 < i) s1 -= l[1] * tc[4 * j4 + 1];
                if (4 * j4 + 2 < i) s2 -= l[2] * tc[4 * j4 + 2];
                if (4 * j4 + 3 < i) s3 -= l[3] * tc[4 * j4 + 3]; }
            tc[i] = (s0 + s1) + (s2 + s3);
            __builtin_amdgcn_sched_barrier(0);
        }
        { u16* tb = (u16*)rec;
#pragma unroll
            for (int i = 0; i < 64; ++i) tb[i * 64 + lane] = f2bf(tc[i] * beta); }
        { u16* in = (u16*)(rec + 8192);
#pragma unroll
            for (int mt = 0; mt < 4; ++mt) { const int r_ = 16 * mt + fr, tr = dir ? 63 - r_ : r_; const u16* p = qd + (size_t)(base + tr) * 1024 + h * 128 + quad * 8;
                s16x8 qf[4];
#pragma unroll
                for (int kk = 0; kk < 4; ++kk) qf[kk] = *(const s16x8*)(p + kk * 32);
#pragma unroll
                for (int nt = 0; nt < 4; ++nt) { const int j = 16 * nt + fr;
                    if (nt <= mt) { f32x4 acc = {0.f, 0.f, 0.f, 0.f};
                        const int rk = 16 * nt + fr, trk = dir ? 63 - rk : rk; const u16* pk_ = kd + (size_t)(base + trk) * 1024 + h * 128 + quad * 8;
#pragma unroll
                        for (int kk = 0; kk < 4; ++kk) acc = mfma16(qf[kk], *(const s16x8*)(pk_ + kk * 32), acc);
                        const float gj = gcs[j];
#pragma unroll
                        for (int r = 0; r < 4; ++r) { const int i = 16 * mt + quad * 4 + r; const float v = (j <= i) ? acc[r] * __expf(fminf(gcs[i] - gj, 0.f)) : 0.f; in[i * 64 + j] = f2bf(v); }
                    } else {
#pragma unroll
                        for (int r = 0; r < 4; ++r) { const int i = 16 * mt + quad * 4 + r; in[i * 64 + j] = 0; } } } } }
    }
}

__device__ __forceinline__ void phase_dn_scan(const Args& a, unsigned char* shm) {
    const int tid = tid_opaque(), wid = tid >> 6, lane = tid & 63, fr = lane & 15, quad = lane >> 4, r32 = lane & 31, hi = lane >> 5;
    unsigned char* ST = shm; unsigned char* KV = shm + 17408; unsigned char* RT = KV + 16384; unsigned char* VN = RT + 9216; unsigned char* VS = VN + 9216;
    const int mt = wid & 3, ng = wid >> 2, mtS = wid & 1, D0 = wid >> 1;
    const int sr = tid >> 4, sc = (tid & 15) * 8, vst0 = at::v_st(sr, sc), vst1 = at::v_st(32 + sr, sc);
    const int vb0 = (int)(uintptr_t)KV + at::v_rd_base(lane);
    const u16* qd = (const u16*)(a.ws + O_QD); const u16* kd = (const u16*)(a.ws + O_KD); const u16* vd = (const u16*)(a.ws + O_VD);
    const unsigned char* REC = a.ws + O_REC;
    for (int task = blockIdx.x; task < 256; task += gridDim.x) {
        const int half = task & 1, dir = (task >> 1) & 1, h = (task >> 2) & 7, b = task >> 5;
        u16* Od = (u16*)a.out + (dir ? (size_t)MLAT * 1024 : (size_t)0);
        at::f32x16 sT;
#pragma unroll
        for (int r = 0; r < 16; ++r) sT[r] = 0.f;
        const int irow = 16 * mt + fr, i0 = 16 * mt + quad * 4;
        const int dv0 = 32 * ng + fr, dv1 = dv0 + 16;
        for (int n = 0; n < 68; ++n) {
            const int c68 = n < 4 ? (dir ? 3 - n : n) : (dir ? 71 - n : n);
            const int base = c68 < 4 ? MLAT + b * 256 + c68 * 64 : b * 4096 + (c68 - 4) * 64;
            const unsigned char* rec = REC + (size_t)((((b * 8 + h) * 2 + dir) * 68) + c68) * REC_BYTES;
            const float* rf = (const float*)(rec + 16384);
            {
#pragma unroll
                for (int r = 0; r < 16; ++r) *(u16*)(ST + (32 * mtS + at::crow(r, hi)) * 272 + (32 * D0 + r32) * 2) = f2bf(sT[r]);
                const int t0 = dir ? 63 - sr : sr, t1 = dir ? 31 - sr : 32 + sr;
                const s16x8 k0 = *(const s16x8*)(kd + (size_t)(base + t0) * 1024 + h * 128 + sc);
                const s16x8 k1 = *(const s16x8*)(kd + (size_t)(base + t1) * 1024 + h * 128 + sc);
                *(s16x8*)(KV + vst0) = k0; *(s16x8*)(KV + vst1) = k1;
            }
            __syncthreads();
            const int trow = dir ? 63 - irow : irow;
            const u16* kp = kd + (size_t)(base + trow) * 1024 + h * 128 + quad * 8; const u16* qp = qd + (size_t)(base + trow) * 1024 + h * 128 + quad * 8;
            f32x4 KS0 = {0.f, 0.f, 0.f, 0.f}, KS1 = KS0, QS0 = KS0, QS1 = KS0;
#pragma unroll
            for (int kk = 0; kk < 4; ++kk) {
                const s16x8 ak = *(const s16x8*)(kp + kk * 32), aq = *(const s16x8*)(qp + kk * 32);
                const s16x8 b0 = *(const s16x8*)(ST + dv0 * 272 + (kk * 32 + quad * 8) * 2), b1 = *(const s16x8*)(ST + dv1 * 272 + (kk * 32 + quad * 8) * 2);
                KS0 = mfma16(ak, b0, KS0); KS1 = mfma16(ak, b1, KS1); QS0 = mfma16(aq, b0, QS0); QS1 = mfma16(aq, b1, QS1);
            }
            const f32x4 eg = *(const f32x4*)(rf + i0), ek = *(const f32x4*)(rf + 64 + i0); const float dch = rf[128];
            {
                f32x4 r0, r1;
#pragma unroll
                for (int r = 0; r < 4; ++r) { const int ti = dir ? 63 - (i0 + r) : (i0 + r); const u16* vp = vd + (size_t)(base + ti) * 1024 + h * 128 + half * 64 + dv0;
                    r0[r] = bf2f(vp[0]) - eg[r] * KS0[r]; r1[r] = bf2f(vp[16]) - eg[r] * KS1[r]; }
                u32x2 w0, w1; w0.x = pk(r0[0], r0[1]); w0.y = pk(r0[2], r0[3]); w1.x = pk(r1[0], r1[1]); w1.y = pk(r1[2], r1[3]);
                *(u32x2*)(RT + dv0 * 144 + i0 * 2) = w0; *(u32x2*)(RT + dv1 * 144 + i0 * 2) = w1;
            }
            __syncthreads();
            f32x4 N0 = {0.f, 0.f, 0.f, 0.f}, N1 = N0;
            {
                const u16* tbp = (const u16*)rec + irow * 64 + quad * 8;
#pragma unroll
                for (int kk = 0; kk < 2; ++kk) { const s16x8 at_ = *(const s16x8*)(tbp + kk * 32);
                    const s16x8 b0 = *(const s16x8*)(RT + dv0 * 144 + (kk * 32 + quad * 8) * 2), b1 = *(const s16x8*)(RT + dv1 * 144 + (kk * 32 + quad * 8) * 2);
                    N0 = mfma16(at_, b0, N0); N1 = mfma16(at_, b1, N1); }
                u32x2 w0, w1; w0.x = pk(N0[0], N0[1]); w0.y = pk(N0[2], N0[3]); w1.x = pk(N1[0], N1[1]); w1.y = pk(N1[2], N1[3]);
                *(u32x2*)(VN + dv0 * 144 + i0 * 2) = w0; *(u32x2*)(VN + dv1 * 144 + i0 * 2) = w1;
                const f32x4 s0 = N0 * ek, s1 = N1 * ek;
                w0.x = pk(s0[0], s0[1]); w0.y = pk(s0[2], s0[3]); w1.x = pk(s1[0], s1[1]); w1.y = pk(s1[2], s1[3]);
                *(u32x2*)(VS + dv0 * 144 + i0 * 2) = w0; *(u32x2*)(VS + dv1 * 144 + i0 * 2) = w1;
            }
            __syncthreads();
            {
                f32x4 O0 = QS0 * eg, O1 = QS1 * eg;
                const u16* inp = (const u16*)(rec + 8192) + irow * 64 + quad * 8;
#pragma unroll
                for (int kk = 0; kk < 2; ++kk) { const s16x8 ai = *(const s16x8*)(inp + kk * 32);
                    const s16x8 b0 = *(const s16x8*)(VN + dv0 * 144 + (kk * 32 + quad * 8) * 2), b1 = *(const s16x8*)(VN + dv1 * 144 + (kk * 32 + quad * 8) * 2);
                    O0 = mfma16(ai, b0, O0); O1 = mfma16(ai, b1, O1); }
                if (n >= 4) {
#pragma unroll
                    for (int r = 0; r < 4; ++r) { const int ti = dir ? 63 - (i0 + r) : (i0 + r); u16* op = Od + (size_t)(base + ti) * 1024 + h * 128 + half * 64 + dv0;
                        op[0] = f2bf(O0[r]); op[16] = f2bf(O1[r]); } }
            }
            {
#pragma unroll
                for (int r = 0; r < 16; ++r) sT[r] *= dch;
                const unsigned char* vsp = VS + (32 * mtS + r32) * 144 + (8 * hi) * 2;
                const at::bf16x8 pa0 = *(const at::bf16x8*)(vsp), pa1 = *(const at::bf16x8*)(vsp + 32), pa2 = *(const at::bf16x8*)(vsp + 64), pa3 = *(const at::bf16x8*)(vsp + 96);
                if (D0 == 0) at::pv_one<0>(sT, vb0, pa0, pa1, pa2, pa3);
                else if (D0 == 1) at::pv_one<1>(sT, vb0, pa0, pa1, pa2, pa3);
                else if (D0 == 2) at::pv_one<2>(sT, vb0, pa0, pa1, pa2, pa3);
                else at::pv_one<3>(sT, vb0, pa0, pa1, pa2, pa3);
            }
            __syncthreads();
        }
    }
}


#if defined(EXP_NAIVE_DN)
__device__ __forceinline__ void phase_dn_naive(const Args& a, unsigned char* shm) {
    const int tid = tid_opaque(), dvl = tid & 63, kg = tid >> 6;
    float* red = (float*)shm;
    const u16* qd = (const u16*)(a.ws + O_QD); const u16* kd = (const u16*)(a.ws + O_KD); const u16* vd = (const u16*)(a.ws + O_VD); const float* BA = (const float*)(a.ws + O_BA);
    for (int task = blockIdx.x; task < 256; task += gridDim.x) {
        const int half = task & 1, dir = (task >> 1) & 1, h = (task >> 2) & 7, b = task >> 5;
        u16* Od = (u16*)a.out + (dir ? (size_t)MLAT * 1024 : (size_t)0);
        float S[16];
#pragma unroll
        for (int e = 0; e < 16; ++e) S[e] = 0.f;
        const float alog = a.in[14][dir * 8 + h], dtb = a.in[15][dir * 8 + h];
        for (int n = 0; n < 4352; ++n) {
            int row; if (n < 256) { const int t = dir ? 255 - n : n; row = MLAT + b * 256 + t; } else { const int t = dir ? 4095 - (n - 256) : (n - 256); row = b * 4096 + t; }
            const float* bap = BA + (size_t)row * 32;
            const float beta = sigm_f(bap[dir * 8 + h]);
            const float xs = bap[16 + dir * 8 + h] + dtb;
            const float g = -__expf(alog) * (fmaxf(xs, 0.f) + log1pf(__expf(-fabsf(xs))));
            const float eg = __expf(g);
            const u16* kp = kd + (size_t)row * 1024 + h * 128 + kg * 16; const u16* qp = qd + (size_t)row * 1024 + h * 128 + kg * 16;
            float kk[16], qq[16];
#pragma unroll
            for (int e = 0; e < 16; ++e) { kk[e] = bf2f(kp[e]); qq[e] = bf2f(qp[e]); }
            const float v = bf2f(vd[(size_t)row * 1024 + h * 128 + half * 64 + dvl]);
            float ps = 0.f;
#pragma unroll
            for (int e = 0; e < 16; ++e) { S[e] *= eg; ps += kk[e] * S[e]; }
            red[kg * 64 + dvl] = ps;
            __syncthreads();
            float ks = 0.f;
#pragma unroll
            for (int g8 = 0; g8 < 8; ++g8) ks += red[g8 * 64 + dvl];
            __syncthreads();
            const float delta = beta * (v - ks);
            float po = 0.f;
#pragma unroll
            for (int e = 0; e < 16; ++e) { S[e] += kk[e] * delta; po += qq[e] * S[e]; }
            red[kg * 64 + dvl] = po;
            __syncthreads();
            if (n >= 256 && kg == 0) { float o = 0.f;
#pragma unroll
                for (int g8 = 0; g8 < 8; ++g8) o += red[g8 * 64 + dvl];
                Od[(size_t)row * 1024 + h * 128 + half * 64 + dvl] = f2bf(o); }
            __syncthreads();
        }
    }
}
#endif

__device__ __forceinline__ void rope8(f32x4& v0, f32x4& v1, const f32x4 p0, const f32x4 p1, bool second, float pos, int f0) {
#pragma unroll
    for (int j = 0; j < 8; ++j) {
        const float invf = exp2f(-(float)(f0 + j) * (13.287712379549449f / 32.f));
        const float ang = pos * invf; const float c = __cosf(ang), s = __sinf(ang);
        const float mine = j < 4 ? v0[j & 3] : v1[j & 3], other = j < 4 ? p0[j & 3] : p1[j & 3];
        const float o = second ? (mine * c + other * s) : (mine * c - other * s);
        if (j < 4) v0[j & 3] = o; else v1[j & 3] = o;
    }
}
__device__ __forceinline__ void phase_attn_prep(const Args& a) {
    const int lane = tid_opaque() & 63, gw = blockIdx.x * 8 + (tid_opaque() >> 6), nw = gridDim.x * 8;
    u16* QA = (u16*)(a.ws + O_QA); const u16* KVA = (const u16*)(a.ws + O_KVA); u16* KALL = (u16*)(a.ws + O_KALL); u16* VALL = (u16*)(a.ws + O_VALL);
    const float* qn = a.in[18]; const float* kn = a.in[19];
    for (int row = gw; row < MALL; row += nw) {
        const bool lat = row < MLAT;
        const int t = lat ? (row & 4095) : ((row - MLAT) & 255); const int b = lat ? (row >> 12) : ((row - MLAT) >> 8);
        if (lat) {
            const int d = 8 * (lane & 15); const bool second = (lane >> 2) & 1; const int axis = (lane >> 3) & 1; const float pos = axis ? (float)(t & 63) : (float)(t >> 6);
            const f32x4 g0 = *(const f32x4*)(qn + d), g1 = *(const f32x4*)(qn + d + 4);
#pragma unroll
            for (int i = 0; i < 2; ++i) { u16* p = QA + (size_t)row * 1024 + 512 * i + 8 * lane;
                f32x4 v0, v1; unpk8(*(const u32x4*)p, v0, v1);
                float ss = 0.f;
#pragma unroll
                for (int j = 0; j < 4; ++j) ss += v0[j] * v0[j] + v1[j] * v1[j];
                ss = grp16_sum(ss); const float rs = rsqrtf(ss * (1.f / 128.f) + 1e-6f);
                v0 = v0 * rs * g0; v1 = v1 * rs * g1;
                f32x4 p0, p1;
#pragma unroll
                for (int j = 0; j < 4; ++j) { p0[j] = __shfl_xor(v0[j], 4); p1[j] = __shfl_xor(v1[j], 4); }
                rope8(v0, v1, p0, p1, second, pos, d & 31);
                *(u32x4*)p = pk8(v0, v1); }
        }
        {
            const u16* kp = KVA + (size_t)row * 512 + 4 * lane;
            const u32x2 ku = *(const u32x2*)kp; const u32x2 vu = *(const u32x2*)(kp + 256);
            f32x4 kv = (f32x4){bf_lo(ku.x), bf_hi(ku.x), bf_lo(ku.y), bf_hi(ku.y)};
            const int d = 4 * (lane & 31);
            float ss = kv[0] * kv[0] + kv[1] * kv[1] + kv[2] * kv[2] + kv[3] * kv[3];
            ss = grp32_sum(ss); const float rs = rsqrtf(ss * (1.f / 128.f) + 1e-6f);
            kv = kv * rs * *(const f32x4*)(kn + d);
            f32x4 pp;
#pragma unroll
            for (int j = 0; j < 4; ++j) pp[j] = __shfl_xor(kv[j], 8);
            if (lat) { const bool second = (lane >> 3) & 1; const int axis = (lane >> 4) & 1; const float pos = axis ? (float)(t & 63) : (float)(t >> 6);
#pragma unroll
                for (int j = 0; j < 4; ++j) { const float invf = exp2f(-(float)((d & 31) + j) * (13.287712379549449f / 32.f)); const float ang = pos * invf; const float c = __cosf(ang), s = __sinf(ang);
                    kv[j] = second ? (kv[j] * c + pp[j] * s) : (kv[j] * c - pp[j] * s); } }
            const size_t orow = (size_t)b * 4352 + (lat ? 256 + t : t);
            u32x2 ko; ko.x = pk(kv[0], kv[1]); ko.y = pk(kv[2], kv[3]);
            *(u32x2*)(KALL + orow * 256 + 4 * lane) = ko; *(u32x2*)(VALL + orow * 256 + 4 * lane) = vu;
        }
    }
}

__device__ __forceinline__ void phase_attn(const Args& a, unsigned char* shm) {
    u16* QA = (u16*)(a.ws + O_QA); const u16* KALL = (const u16*)(a.ws + O_KALL); const u16* VALL = (const u16*)(a.ws + O_VALL);
    const int nblk = gridDim.x;
    for (int it = 0;; ++it) {
        int task;
        if (nblk == 256) { if (it >= 4) break; const int xcd = blockIdx.x & 7, slot = blockIdx.x >> 3; const int tix = it * 32 + slot; task = (xcd * 2 + (tix >> 6)) * 64 + (tix & 63); }
        else { task = blockIdx.x + it * nblk; if (task >= 1024) break; }
        const int grp = task >> 6, within = task & 63, b = grp >> 1, kvh = grp & 1, qb = within >> 2, g = within & 3, head = kvh * 4 + g;
        u16* Qb = QA + ((size_t)b * 4096 + qb * 256) * 1024 + head * 128;
        const u16* Kh = KALL + (size_t)b * 4352 * 256 + kvh * 128; const u16* Vh = VALL + (size_t)b * 4352 * 256 + kvh * 128;
        at::attn_dense_body<at::bf16>((const at::bf16*)Qb, (const at::bf16*)Kh, (const at::bf16*)Vh, Qb, 4352, (char*)shm);
        __syncthreads();
    }
}

__device__ __forceinline__ void phase_merge_prep(const Args& a) {
    const int lane = tid_opaque() & 63, gw = blockIdx.x * 8 + (tid_opaque() >> 6), nw = gridDim.x * 8;
    const u16* OF = (const u16*)a.out; const u16* OB = OF + (size_t)MLAT * 1024; const u16* Z = (const u16*)(a.ws + O_Z); u16* A3 = (u16*)(a.ws + O_A3);
    const float* dnn = a.in[16];
    const int d = 8 * (lane & 15); const f32x4 g0 = *(const f32x4*)(dnn + d), g1 = *(const f32x4*)(dnn + d + 4);
    for (int row = gw; row < MLAT; row += nw) {
#pragma unroll
        for (int i = 0; i < 2; ++i) { const size_t off = (size_t)row * 1024 + 512 * i + 8 * lane;
            f32x4 f0, f1, b0, b1, z0, z1; unpk8(*(const u32x4*)(OF + off), f0, f1); unpk8(*(const u32x4*)(OB + off), b0, b1); unpk8(*(const u32x4*)(Z + off), z0, z1);
            f0 += b0; f1 += b1;
            float ss = 0.f;
#pragma unroll
            for (int j = 0; j < 4; ++j) ss += f0[j] * f0[j] + f1[j] * f1[j];
            ss = grp16_sum(ss); const float rs = rsqrtf(ss * (1.f / 128.f) + 1e-6f);
#pragma unroll
            for (int j = 0; j < 4; ++j) { f0[j] = f0[j] * rs * g0[j] * silu_f(z0[j]); f1[j] = f1[j] * rs * g1[j] * silu_f(z1[j]); }
            *(u32x4*)(A3 + off) = pk8(f0, f1); }
    }
}

__global__ void __launch_bounds__(512, 2) fwd_megakernel(Args a) {
    extern __shared__ __attribute__((aligned(16))) unsigned char shm[];
    cg::grid_group grid = cg::this_grid();
    unsigned char* ws = a.ws;
    const long gtid = (long)blockIdx.x * 512 + threadIdx.x, gth = (long)gridDim.x * 512;
    cvt_w<1>(a.in[8], 1024, 5632, (u16*)(ws + O_WGU1), 5632, gtid, gth);
    cvt_w<0>(a.in[9], 2816, 1024, (u16*)(ws + O_WD1), 1024, gtid, gth);
    cvt_w<1>(a.in[24], 1024, 5632, (u16*)(ws + O_WGU2), 5632, gtid, gth);
    cvt_w<0>(a.in[25], 2816, 1024, (u16*)(ws + O_WD2), 1024, gtid, gth);
    cvt_w<2>(a.in[12], 1024, INW, (u16*)(ws + O_WIN1), 3328, gtid, gth);
    cvt_w<3>(a.in[12], 1024, INW, (u16*)(ws + O_WIN2), 4608, gtid, gth);
    cvt_w<0>(a.in[17], 1024, 1024, (u16*)(ws + O_WDN), 1024, gtid, gth);
    cvt_w<0>(a.in[20], 1024, 1024, (u16*)(ws + O_WAT), 1024, gtid, gth);
    cvt_w<0>(a.in[21], 1024, 1024, (u16*)(ws + O_WOUT), 1024, gtid, gth);
    phase_mod(a, shm);
    grid.sync();
    phase_h1(a);
    grid.sync();
    { EpiSwiglu E; E.O = (u16*)(ws + O_ACT); run_gemm(shm, (const u16*)(ws + O_A), (const u16*)(ws + O_WGU1), MALL, 5632, 1024, E); }
    grid.sync();
    { EpiPlain E; E.O = (u16*)(ws + O_Y1); E.ldc = 1024; run_gemm(shm, (const u16*)(ws + O_ACT), (const u16*)(ws + O_WD1), MALL, 1024, 2816, E); }
    grid.sync();
    phase_h2(a);
    grid.sync();
    { EpiIn1 E; E.O = (u16*)(ws + O_QRAW); E.stride = (O_KRAW - O_QRAW) / 2; run_gemm(shm, (const u16*)(ws + O_A), (const u16*)(ws + O_WIN1), MALL, 2048, 1024, E); }
    { EpiPlain E; E.O = (u16*)a.out; E.ldc = 1024; run_gemm(shm, (const u16*)(ws + O_A), (const u16*)(ws + O_WIN1) + (size_t)2048 * 1024, MALL, 1024, 1024, E); }
    { EpiBa E; E.ba = (float*)(ws + O_BA); run_gemm(shm, (const u16*)(ws + O_A), (const u16*)(ws + O_WIN1) + (size_t)3072 * 1024, MALL, 256, 1024, E); }
    grid.sync();
    phase_dn_prep(a);
    grid.sync();
#if defined(EXP_NAIVE_DN)
    phase_dn_naive(a, shm);
#else
    phase_dn_pre(a, shm);
    grid.sync();
    phase_dn_scan(a, shm);
#endif
    grid.sync();
    phase_h2(a);
    grid.sync();
    { EpiIn2 E; E.z = (u16*)(ws + O_Z); E.qa = (u16*)(ws + O_QA); E.kva = (u16*)(ws + O_KVA); E.gates = (u16*)(ws + O_GATES); run_gemm(shm, (const u16*)(ws + O_A), (const u16*)(ws + O_WIN2), MALL, 4608, 1024, E); }
    grid.sync();
    phase_attn_prep(a);
    grid.sync();
    phase_attn(a, shm);
    grid.sync();
    phase_merge_prep(a);
    grid.sync();
    { EpiMerge<0> E; E.gates = (const u16*)(ws + O_GATES); E.T = (u16*)(ws + O_T); run_gemm(shm, (const u16*)(ws + O_A3), (const u16*)(ws + O_WDN), MLAT, 1024, 1024, E); }
    { EpiMerge<1> E; E.gates = (const u16*)(ws + O_GATES); E.T = (u16*)(ws + O_T); run_gemm(shm, (const u16*)(ws + O_QA), (const u16*)(ws + O_WAT), MLAT, 1024, 1024, E); }
    grid.sync();
    { EpiPlain E; E.O = (u16*)(ws + O_Y); E.ldc = 1024; run_gemm(shm, (const u16*)(ws + O_T), (const u16*)(ws + O_WOUT), MLAT, 1024, 1024, E); }
    grid.sync();
    phase_h3(a);
    grid.sync();
    { EpiSwiglu E; E.O = (u16*)(ws + O_ACT2); run_gemm(shm, (const u16*)(ws + O_A5), (const u16*)(ws + O_WGU2), MLAT, 5632, 1024, E); }
    grid.sync();
    { EpiPlain E; E.O = (u16*)(ws + O_Y2); E.ldc = 1024; run_gemm(shm, (const u16*)(ws + O_ACT2), (const u16*)(ws + O_WD2), MLAT, 1024, 2816, E); }
    grid.sync();
    phase_out(a);
}

extern "C" void kernel_launch(void* const* d_in, const int* in_sizes, int n_in, void* d_out, int out_size, void* d_ws, size_t ws_size, hipStream_t stream) {
    static int grid_blocks = 0;
    if (grid_blocks == 0) {
        if (n_in != 26 || out_size != MLAT * 1024 || ws_size < WS_NEED) { fprintf(stderr, "kernel_launch: unexpected shapes: n_in %d out %d ws %zu (need %zu)\n", n_in, out_size, ws_size, (size_t)WS_NEED); grid_blocks = -1; return; }
        int dev = 0, cus = 0, per_cu = 0;
        hipGetDevice(&dev);
        hipDeviceGetAttribute(&cus, hipDeviceAttributeMultiprocessorCount, dev);
        if (hipFuncSetAttribute((const void*)fwd_megakernel, hipFuncAttributeMaxDynamicSharedMemorySize, LDS_BYTES) != hipSuccess) { fprintf(stderr, "kernel_launch: hipFuncSetAttribute failed\n"); grid_blocks = -1; return; }
        if (hipOccupancyMaxActiveBlocksPerMultiprocessor(&per_cu, (const void*)fwd_megakernel, 512, LDS_BYTES) != hipSuccess || per_cu < 1) { fprintf(stderr, "kernel_launch: occupancy query failed (%d)\n", per_cu); (void)hipGetLastError(); per_cu = 1; }
        grid_blocks = cus * per_cu;
    }
    if (grid_blocks < 0) return;
    Args a{};
    for (int i = 0; i < 26; ++i) a.in[i] = (const float*)d_in[i];
    a.out = (float*)d_out; a.ws = (unsigned char*)d_ws;
    void* args[] = {&a};
    hipError_t e = hipLaunchCooperativeKernel((const void*)fwd_megakernel, dim3(grid_blocks), dim3(512), args, LDS_BYTES, stream);
    if (e != hipSuccess) fprintf(stderr, "cooperative launch failed: %s (grid %d)\n", hipGetErrorString(e), grid_blocks);
}
```

```cpp
#include <hip/hip_runtime.h>
#include <hip/hip_bf16.h>
#include <hip/hip_cooperative_groups.h>
#include <cstdio>
#include <cstdint>
namespace cg = cooperative_groups;
__device__ __forceinline__ int tid_opaque() { int t = threadIdx.x; asm volatile("" : "+v"(t)); return t; }
namespace pg8 {
#define PG8_LAS __attribute__((address_space(3)))
typedef unsigned short bf16_t;
typedef short bf16x8 __attribute__((ext_vector_type(8)));
typedef float f32x4 __attribute__((ext_vector_type(4)));
typedef unsigned u32x4 __attribute__((ext_vector_type(4)));
constexpr int BM = 256, BK = 64, HALF = 128, HTB = HALF * BK * 2  , STAGE_BYTES = 8 * HTB, NXCD = 8, WGM = 8;

__host__ __device__ __forceinline__ int lds_byte(int r, int c) { const int st = (r >> 4) * 2 + (c >> 5), rr = r & 15, cc = c & 31, ob = rr * 64 + cc * 2; return st * 1024 + (ob ^ (((ob >> 9) & 1) << 5)); }
__host__ __device__ __forceinline__ void stage_rc(int b, int& R, int& C) { const int st = b / 1024, sb = b % 1024, swz = sb ^ (((sb >> 9) & 1) << 5); R = (st >> 1) * 16 + swz / 64; C = (st & 1) * 32 + (swz % 64) / 2; }
__host__ __device__ __forceinline__ int perm32(int rho) { const int n = rho >> 4, i = rho & 15; return 8 * (i >> 2) + 4 * n + (i & 3); }

struct Unit { int pm, pn; };
struct Gemm { const bf16_t* A; const bf16_t* Bt; int M, N, K; };

struct StaticOrder {
    int nM, nN, nwg, G, c;
    __host__ __device__ void init(int M, int N, int G_, int c_) { nM = M / BM; nN = N / BM; nwg = nM * nN; G = G_; c = c_; }
    __host__ __device__ bool next(int i, Unit& u) const {
        const long L = (long)i * G + c; if (L >= nwg) return false;
        int wgid = (int)L; { const int q = nwg / NXCD, r = nwg % NXCD, xcd = wgid % NXCD, off = wgid / NXCD; wgid = (xcd < r ? xcd * (q + 1) : r * (q + 1) + (xcd - r) * q) + off; }
        const int nig = WGM * nN, gid = wgid / nig, fm = gid * WGM, gsz = (nM - fm) < WGM ? (nM - fm) : WGM;
        u.pm = fm + ((wgid % nig) % gsz); u.pn = (wgid % nig) / gsz; return true;
    }
    __device__ __forceinline__ void a_ready(const Unit&) const {}
    __device__ __forceinline__ void done(const Unit&) const {}
};
__device__ __forceinline__ unsigned cvt_pk_bf16(float lo, float hi) { unsigned r; asm volatile("v_cvt_pk_bf16_f32 %0, %1, %2" : "=v"(r) : "v"(lo), "v"(hi)); return r; }

template <class Epi, class Sched, bool STAMP = false>
__device__ __forceinline__ void gemm_phase(PG8_LAS unsigned char* lds, const Gemm g, const Sched& S, const Epi& E, unsigned long long* stamps) {
    const int tid = tid_opaque(), wid = __builtin_amdgcn_readfirstlane(tid >> 6), lane = tid & 63, wr = wid >> 2, wc = wid & 3, fr = lane & 15, fq = lane >> 4;
    const int K = g.K, nt = K / BK;
    int ts_lo = 0, ts_hi = 0, nts = 0; const unsigned long long rt_entry = STAMP ? (unsigned long long)wall_clock64() : 0ull;
#define PG8_STAMP() do { if (STAMP && wid == 0 && nts < 64) { const unsigned long long _c = (unsigned long long)clock64(); \
        ts_lo = (lane == nts) ? (int)(unsigned)_c : ts_lo; ts_hi = (lane == nts) ? (int)(unsigned)(_c >> 32) : ts_hi; ++nts; } } while (0)
    PG8_STAMP();
    unsigned voffA[2], voffB[2];
#pragma unroll
    for (int i = 0; i < 2; ++i) { int R, C; stage_rc(tid * 16 + i * 8192, R, C); const int Rb = Epi::PERM ? ((R & ~31) + perm32(R & 31)) : R;
        voffA[i] = (unsigned)(R * K + C) * 2u; voffB[i] = (unsigned)(Rb * K + C) * 2u; }
    const size_t kstep = (size_t)(BK * 2);
    const size_t hstep = (size_t)HALF * K * 2;
    const size_t tstep = 2 * hstep;
    const unsigned ldsw = (unsigned)wid * 1024u;
    const int aoff = lds_byte(wr * 64 + fr, fq * 8), boff = lds_byte(wc * 32 + fr, fq * 8);
#define PG8_SA(b, h) (((b) * 2 + (h)) * HTB)
#define PG8_SB(b, h) ((4 + (b) * 2 + (h)) * HTB)
#define PG8_STAGE(bufoff, gbase, voff) do { _Pragma("unroll") for (int _i = 0; _i < 2; ++_i) \
        __builtin_amdgcn_global_load_lds((const unsigned*)((const char*)(gbase) + (voff)[_i]), (PG8_LAS unsigned*)(lds + (bufoff) + ldsw + _i * 8192), 16, 0, 0); } while (0)
#define PG8_LDA(dst, b, h) do { _Pragma("unroll") for (int m = 0; m < 4; ++m) _Pragma("unroll") for (int k = 0; k < 2; ++k) dst[m][k] = *(const PG8_LAS bf16x8*)(lds + PG8_SA(b, h) + aoff + m * 2048 + k * 1024); } while (0)
#define PG8_LDB(dst, b, h) do { _Pragma("unroll") for (int n = 0; n < 2; ++n) _Pragma("unroll") for (int k = 0; k < 2; ++k) dst[n][k] = *(const PG8_LAS bf16x8*)(lds + PG8_SB(b, h) + boff + n * 2048 + k * 1024); } while (0)
#define PG8_MMA(ai, bj, At, Bt) do { __builtin_amdgcn_s_setprio(1); _Pragma("unroll") for (int m = 0; m < 4; ++m) _Pragma("unroll") for (int n = 0; n < 2; ++n) _Pragma("unroll") for (int k = 0; k < 2; ++k) \
        acc[ai][bj][m][n] = __builtin_amdgcn_mfma_f32_16x16x32_bf16(Bt[n][k], At[m][k], acc[ai][bj][m][n], 0, 0, 0); __builtin_amdgcn_s_setprio(0); } while (0)
#define PG8_WAIT_V(n) asm volatile("s_waitcnt vmcnt(" #n ")" ::: "memory")
#define PG8_WAIT_L(n) asm volatile("s_waitcnt lgkmcnt(" #n ")" ::: "memory")
#define PG8_BAR __builtin_amdgcn_s_barrier()
#define PG8_SCHED __builtin_amdgcn_sched_barrier(0)
    Unit cur, nxt; int ui = 0;
    if (!S.next(0, cur)) return;
    f32x4 acc[2][2][4][2];
#pragma unroll
    for (int a = 0; a < 2; ++a)
#pragma unroll
        for (int b = 0; b < 2; ++b)
#pragma unroll
            for (int m = 0; m < 4; ++m)
#pragma unroll
                for (int n = 0; n < 2; ++n) acc[a][b][m][n] = (f32x4){0.f, 0.f, 0.f, 0.f};
    bf16x8 At[4][2], B0[2][2], B1[2][2];
    const char* cA = (const char*)g.A + (size_t)cur.pm * tstep; const char* cB = (const char*)g.Bt + (size_t)cur.pn * tstep;
    S.a_ready(cur);
    PG8_STAGE(PG8_SB(0, 0), cB, voffB); PG8_STAGE(PG8_SA(0, 0), cA, voffA); PG8_STAGE(PG8_SB(0, 1), cB + hstep, voffB); PG8_STAGE(PG8_SA(0, 1), cA + hstep, voffA);
    if (wr == 1) PG8_BAR;
    PG8_WAIT_V(4); PG8_BAR;
    PG8_STAGE(PG8_SB(1, 0), cB + kstep, voffB); PG8_STAGE(PG8_SA(1, 0), cA + kstep, voffA); PG8_STAGE(PG8_SB(1, 1), cB + hstep + kstep, voffB);
    PG8_WAIT_V(6); PG8_BAR;
    PG8_STAMP();
    for (;;) {
        const bool has_next = S.next(ui + 1, nxt);
        const char* nA = has_next ? (const char*)g.A + (size_t)nxt.pm * tstep : cA; const char* nB = has_next ? (const char*)g.Bt + (size_t)nxt.pn * tstep : cB;
        for (int t = 0; t < nt; t += 2) {
            const bool last = (t == nt - 2);
            const char* a1 = cA + (size_t)(t + 1) * kstep;
            const char* a2 = last ? nA : cA + (size_t)(t + 2) * kstep; const char* b2 = last ? nB : cB + (size_t)(t + 2) * kstep;
            const char* a3 = a2 + kstep; const char* b3 = b2 + kstep;
            if (last && has_next) S.a_ready(nxt);
            PG8_LDB(B0, 0, 0); PG8_SCHED; PG8_LDA(At, 0, 0); PG8_STAGE(PG8_SA(1, 1), a1 + hstep, voffA);
            PG8_WAIT_L(8); PG8_BAR; PG8_WAIT_L(0); PG8_MMA(0, 0, At, B0); PG8_BAR; PG8_SCHED;
            PG8_LDB(B1, 0, 1); PG8_STAGE(PG8_SB(0, 0), b2, voffB);
            PG8_BAR; PG8_WAIT_L(0); PG8_MMA(0, 1, At, B1); PG8_BAR;
            PG8_LDA(At, 0, 1); PG8_STAGE(PG8_SA(0, 0), a2, voffA);
            PG8_BAR; PG8_WAIT_L(0); PG8_MMA(1, 0, At, B0); PG8_BAR; PG8_SCHED;
            PG8_STAGE(PG8_SB(0, 1), b2 + hstep, voffB);
            PG8_WAIT_V(6); PG8_BAR; PG8_MMA(1, 1, At, B1); PG8_BAR;
            PG8_LDB(B0, 1, 0); PG8_SCHED; PG8_LDA(At, 1, 0); PG8_STAGE(PG8_SA(0, 1), a2 + hstep, voffA);
            PG8_WAIT_L(8); PG8_BAR; PG8_WAIT_L(0); PG8_MMA(0, 0, At, B0); PG8_BAR; PG8_SCHED;
            PG8_LDB(B1, 1, 1); PG8_STAGE(PG8_SB(1, 0), b3, voffB);
            PG8_BAR; PG8_WAIT_L(0); PG8_MMA(0, 1, At, B1); PG8_BAR;
            PG8_LDA(At, 1, 1); PG8_STAGE(PG8_SA(1, 0), a3, voffA);
            PG8_BAR; PG8_WAIT_L(0); PG8_MMA(1, 0, At, B0); PG8_BAR; PG8_SCHED;
            PG8_STAGE(PG8_SB(1, 1), b3 + hstep, voffB);
            PG8_WAIT_V(6); PG8_BAR; PG8_MMA(1, 1, At, B1); PG8_BAR;
        }
        PG8_STAMP();
        if constexpr (!Epi::AFTER_DRAIN) { E(acc, cur, wr, wc, fr, fq); S.done(cur); }
        PG8_STAMP();
        if (!has_next) break;
#pragma unroll
        for (int a = 0; a < 2; ++a)
#pragma unroll
            for (int b = 0; b < 2; ++b)
#pragma unroll
                for (int m = 0; m < 4; ++m)
#pragma unroll
                    for (int n = 0; n < 2; ++n) acc[a][b][m][n] = (f32x4){0.f, 0.f, 0.f, 0.f};
        cur = nxt; cA = nA; cB = nB; ++ui;
    }
    PG8_WAIT_V(0);
    if (wr == 0) PG8_BAR;
    PG8_BAR;
    if constexpr (Epi::AFTER_DRAIN) { E.fused(acc, cur, wr, wc, fr, fq, lds, wid, lane); S.done(cur); }
    PG8_STAMP();
    if (STAMP && wid == 0) { stamps[lane] = lane < nts ? (((unsigned long long)(unsigned)ts_hi << 32) | (unsigned)ts_lo) : 0ull;
        if (lane == 62) stamps[62] = rt_entry; if (lane == 63) stamps[63] = (unsigned long long)wall_clock64(); }
#undef PG8_STAMP
#undef PG8_SA
#undef PG8_SB
#undef PG8_STAGE
#undef PG8_LDA
#undef PG8_LDB
#undef PG8_MMA
#undef PG8_WAIT_V
#undef PG8_WAIT_L
#undef PG8_BAR
#undef PG8_SCHED
}
}
namespace xb {

#define XB_TMO      128
#define XB_XCNT(j)  (256  + 64 * (j))
#define XB_XSUB(j)  (1280 + 64 * (j))
#define XB_XGEN(j)  (2304 + 64 * (j))
#define XB_TOP      3328
#define XB_TOPGEN   3392
#define XCD_BAR_WORDS 3456
#define XB_SPIN_CAP (1u << 18)
#define LAS __attribute__((address_space(3)))

__device__ __forceinline__ unsigned xb_ld(unsigned* p)              { return __hip_atomic_load(p, __ATOMIC_RELAXED, __HIP_MEMORY_SCOPE_AGENT); }
__device__ __forceinline__ unsigned xb_add(unsigned* p, unsigned v) { return __hip_atomic_fetch_add(p, v, __ATOMIC_RELAXED, __HIP_MEMORY_SCOPE_AGENT); }
__device__ __forceinline__ unsigned xb_xcc_id() { return (unsigned)__builtin_amdgcn_s_getreg((3 << 11) | 20) & 0xFu; }
#define XB_SPIN(cond, bar) do { unsigned _sp = 0; while (cond) { __builtin_amdgcn_s_sleep(1); \
    if ((++_sp & 255u) == 0u) { if (xb_ld(&(bar)[XB_TMO])) break; if (_sp > XB_SPIN_CAP) { atomicAdd(&(bar)[XB_TMO], 1u); break; } } } } while (0)

struct XcdBarrier {
    unsigned* bar; unsigned x;
    volatile LAS unsigned* st;
};

__device__ __forceinline__ XcdBarrier xcd_barrier_post(unsigned* bar, volatile LAS unsigned* st) {
    XcdBarrier b; b.bar = bar; b.x = xb_xcc_id(); b.st = st;
    if (threadIdx.x == 0) (void)xb_add(&bar[XB_XCNT(b.x)], 1u);
    return b;
}
__device__ __forceinline__ void xcd_barrier_complete(unsigned* bar, unsigned x, unsigned& nloc, unsigned& nx) {
    const unsigned G = gridDim.x * gridDim.y * gridDim.z;
    unsigned sum, cnt, mine, sp = 0u;
    for (;;) {
        sum = 0u; cnt = 0u; mine = 0u;
#pragma unroll
        for (unsigned j = 0; j < 16; ++j) { const unsigned c = xb_ld(&bar[XB_XCNT(j)]); sum += c; cnt += (c > 0u) ? 1u : 0u; mine = (j == x) ? c : mine; }
        if (sum == G) break;
        __builtin_amdgcn_s_sleep(1);
        if ((++sp & 255u) == 0u) { if (xb_ld(&bar[XB_TMO])) break; if (sp > XB_SPIN_CAP) { atomicAdd(&bar[XB_TMO], 1u); break; } }
    }
    nloc = mine > 0u ? mine : 1u; nx = cnt > 0u ? cnt : 1u;
}

__device__ __forceinline__ void xcd_barrier(const XcdBarrier& b) {
    asm volatile("s_waitcnt vmcnt(0)" ::: "memory");
    __syncthreads();
    if (threadIdx.x == 0) {
        unsigned* bar = b.bar;
        __builtin_amdgcn_s_waitcnt(0);
        unsigned nloc = b.st[0], nx = b.st[1];
        if (nloc == 0u) { xcd_barrier_complete(bar, b.x, nloc, nx); b.st[0] = nloc; b.st[1] = nx; }
        const unsigned old = xb_add(&bar[XB_XSUB(b.x)], 1u);
        const unsigned gen = old / nloc;
        if (old + 1u == (gen + 1u) * nloc) {
            __builtin_amdgcn_fence(__ATOMIC_RELEASE, "agent");
            asm volatile("s_waitcnt vmcnt(0)" ::: "memory");
            const unsigned og = xb_add(&bar[XB_TOP], 1u);
            const unsigned tg = og / nx;
            if (og + 1u == (tg + 1u) * nx) xb_add(&bar[XB_TOPGEN], 1u);
            else XB_SPIN(xb_ld(&bar[XB_TOPGEN]) == tg, bar);
            __builtin_amdgcn_fence(__ATOMIC_ACQUIRE, "agent");
            xb_add(&bar[XB_XGEN(b.x)], 1u);
            asm volatile("s_waitcnt vmcnt(0)" ::: "memory");
        } else {
            XB_SPIN(xb_ld(&bar[XB_XGEN(b.x)]) == gen, bar);
            __builtin_amdgcn_fence(__ATOMIC_ACQUIRE, "agent");
            asm volatile("s_waitcnt vmcnt(0)" ::: "memory");
        }
    }
    __syncthreads();
}

}
namespace at {
using bf16 = __hip_bfloat16;
constexpr int   D = 128, NW = 8, QBLK = 32, KVBLK = 64;
constexpr float SCALE = 0.088388347648318440f;
constexpr float THR = 8.f;
constexpr int SDEPTH = 1;
constexpr int LDQ = 1024, LDK = 256, LDO = 1024;
constexpr size_t SHM_V = KVBLK * D * 2, SHM_K = KVBLK * D * 2, SHM_ATTN = 2 * SHM_V + 2 * SHM_K + NW * 64 * 4;
__device__ __forceinline__ unsigned short f2bf_rne(float f) { unsigned u = __float_as_uint(f); u += 0x7FFFu + ((u >> 16) & 1u); return (unsigned short)(u >> 16); }
using bf16x8 = __attribute__((ext_vector_type(8))) short;
using s16x4  = __attribute__((ext_vector_type(4))) short;
using f32x16 = __attribute__((ext_vector_type(16))) float;
using f32x8  = __attribute__((ext_vector_type(8))) float;
using u32x4  = __attribute__((ext_vector_type(4))) unsigned;
#define KSWZ(row, colB) ((row) * 256 + ((colB) ^ (((row) & 7) << 4)))
#define SBAR() __builtin_amdgcn_sched_barrier(0)
__device__ __forceinline__ int crow(int r, int hi) { return (r & 3) + 8 * (r >> 2) + 4 * hi; }
__device__ __forceinline__ unsigned cvtpk(float lo, float hi) {
  unsigned r; asm volatile("v_cvt_pk_bf16_f32 %0, %1, %2" : "=v"(r) : "v"(lo), "v"(hi)); return r;
}
template <typename TIn> struct Stage;
template <> struct Stage<bf16>  { using T = bf16x8;
  __device__ static __forceinline__ T ld8(const bf16* p) { return *reinterpret_cast<const bf16x8*>(p); }
  __device__ static __forceinline__ bf16x8 tobf(T x) { return x; } };
template <> struct Stage<float> { using T = f32x8;
  __device__ static __forceinline__ T ld8(const float* p) { return *reinterpret_cast<const f32x8*>(p); }
  __device__ static __forceinline__ bf16x8 tobf(T x) {
    u32x4 w = {cvtpk(x[0], x[1]), cvtpk(x[2], x[3]), cvtpk(x[4], x[5]), cvtpk(x[6], x[7])}; return *reinterpret_cast<bf16x8*>(&w); } };

__device__ __forceinline__ void partialSM(f32x16& p0, f32x16& p1, float& m_reg, float& mn, float& alpha) {
  constexpr float C = SCALE * 1.4426950408889634f;
  float pmax = p0[0]; for (int r = 1; r < 16; ++r) pmax = fmaxf(pmax, p0[r]); for (int r = 0; r < 16; ++r) pmax = fmaxf(pmax, p1[r]);
  { auto rr = __builtin_amdgcn_permlane32_swap(__float_as_uint(pmax), __float_as_uint(pmax), false, false);
    pmax = fmaxf(__uint_as_float(rr[0]), __uint_as_float(rr[1])); }
  if (__builtin_expect(__all(pmax - m_reg <= THR / SCALE), 1)) { mn = m_reg; alpha = 1.f; }
  else { mn = fmaxf(m_reg, pmax); alpha = __builtin_amdgcn_exp2f((m_reg - mn) * C); m_reg = mn; }
  float mnC = -mn * C;
  for (int r = 0; r < 16; ++r) p0[r] = fmaf(p0[r], C, mnC); for (int r = 0; r < 16; ++r) p1[r] = fmaf(p1[r], C, mnC);
  for (int r = 0; r < 16; ++r) p0[r] = __builtin_amdgcn_exp2f(p0[r]);
}
__device__ __forceinline__ void finishSM(f32x16& p0, f32x16& p1, float alpha, float& l_reg, bf16x8& pa0, bf16x8& pa1, bf16x8& pa2, bf16x8& pa3) {
  for (int r = 0; r < 16; ++r) p1[r] = __builtin_amdgcn_exp2f(p1[r]);
  float ps = 0; for (int r = 0; r < 16; ++r) ps += p0[r]; for (int r = 0; r < 16; ++r) ps += p1[r];
  { auto rr = __builtin_amdgcn_permlane32_swap(__float_as_uint(ps), __float_as_uint(ps), false, false);
    ps = __uint_as_float(rr[0]) + __uint_as_float(rr[1]); }
  l_reg = l_reg * alpha + ps;
#define PK4(P, BASE, OUT) do { unsigned a0 = cvtpk(P[BASE + 0], P[BASE + 1]), a1 = cvtpk(P[BASE + 2], P[BASE + 3]);   \
    unsigned b0 = cvtpk(P[BASE + 4], P[BASE + 5]), b1 = cvtpk(P[BASE + 6], P[BASE + 7]);                              \
    auto r0 = __builtin_amdgcn_permlane32_swap(a0, b0, false, false); auto r1 = __builtin_amdgcn_permlane32_swap(a1, b1, false, false); \
    u32x4 w = {r0[0], r1[0], r0[1], r1[1]}; OUT = *reinterpret_cast<bf16x8*>(&w); } while (0)
  PK4(p0, 0, pa0); PK4(p0, 8, pa1); PK4(p1, 0, pa2); PK4(p1, 8, pa3);
#undef PK4
}
__device__ __forceinline__ void qkt(f32x16& p0, f32x16& p1, const bf16* Ks, const bf16x8* qr, int r32, int hi) {
  p0 = f32x16{}; p1 = f32x16{};
  for (int d0 = 0; d0 < 8; ++d0) { int cb = (d0 * 16 + hi * 8) * 2;
    bf16x8 b0 = *reinterpret_cast<const bf16x8*>((const char*)Ks + KSWZ(r32, cb));
    bf16x8 b1 = *reinterpret_cast<const bf16x8*>((const char*)Ks + KSWZ(32 + r32, cb));
    p0 = __builtin_amdgcn_mfma_f32_32x32x16_bf16(b0, qr[d0], p0, 0, 0, 0);
    p1 = __builtin_amdgcn_mfma_f32_32x32x16_bf16(b1, qr[d0], p1, 0, 0, 0); }
}
__device__ __forceinline__ int v_st(int k, int c) { const int kk = (k & ~0xC) | ((k & 4) << 1) | ((k & 8) >> 1); return ((kk >> 3) * 4 + (c >> 5)) * 512 + ((kk & 7) * 32 + (c & 31)) * 2; }
__device__ __forceinline__ int v_rd_base(int lane) { return ((lane & 3) << 3) | (((lane >> 2) & 3) << 6) | (((lane >> 4) & 1) << 5) | (((lane >> 5) & 1) << 8); }
constexpr int v_rd_off(int d0, int ks, int half) { return d0 * 512 + ks * 4096 + half * 2048; }
template <int OFF> __device__ __forceinline__ s16x4 tr_read(int vb) {
  s16x4 r; asm volatile("ds_read_b64_tr_b16 %0, %1 offset:%2" : "=&v"(r) : "v"(vb), "i"(OFF) : "memory"); return r;
}
template <int D0> __device__ __forceinline__ void pv_one(f32x16& od, int vb, bf16x8 pa0, bf16x8 pa1, bf16x8 pa2, bf16x8 pa3) {
  const s16x4 l0 = tr_read<v_rd_off(D0, 0, 0)>(vb), h0 = tr_read<v_rd_off(D0, 0, 1)>(vb), l1 = tr_read<v_rd_off(D0, 1, 0)>(vb), h1 = tr_read<v_rd_off(D0, 1, 1)>(vb);
  const s16x4 l2 = tr_read<v_rd_off(D0, 2, 0)>(vb), h2 = tr_read<v_rd_off(D0, 2, 1)>(vb), l3 = tr_read<v_rd_off(D0, 3, 0)>(vb), h3 = tr_read<v_rd_off(D0, 3, 1)>(vb);
  asm volatile("s_waitcnt lgkmcnt(0)" ::: "memory"); SBAR();
#define PK(L, H) (bf16x8){L[0], L[1], L[2], L[3], H[0], H[1], H[2], H[3]}
  od = __builtin_amdgcn_mfma_f32_32x32x16_bf16(pa0, PK(l0, h0), od, 0, 0, 0);
  od = __builtin_amdgcn_mfma_f32_32x32x16_bf16(pa1, PK(l1, h1), od, 0, 0, 0);
  od = __builtin_amdgcn_mfma_f32_32x32x16_bf16(pa2, PK(l2, h2), od, 0, 0, 0);
  od = __builtin_amdgcn_mfma_f32_32x32x16_bf16(pa3, PK(l3, h3), od, 0, 0, 0);
#undef PK
}
__device__ __forceinline__ void pv_d0(f32x16* o, int vb, bf16x8 pa0, bf16x8 pa1, bf16x8 pa2, bf16x8 pa3) {
  pv_one<0>(o[0], vb, pa0, pa1, pa2, pa3); pv_one<1>(o[1], vb, pa0, pa1, pa2, pa3); pv_one<2>(o[2], vb, pa0, pa1, pa2, pa3); pv_one<3>(o[3], vb, pa0, pa1, pa2, pa3);
}

template <typename TQ>
__device__ __forceinline__ void attn_dense_body(const TQ* __restrict__ Qb, const bf16* __restrict__ Kh, const bf16* __restrict__ Vh,
                                                unsigned short* Ob, int seq, char* lds, int t_base, const float* __restrict__ qn) {
  using St = Stage<bf16>; using SQ = Stage<TQ>;
  const int tid = tid_opaque(), wid = tid >> 6, lane = tid & 63, r32 = lane & 31, hi = lane >> 5;
  bf16* V_lds = (bf16*)lds; bf16* K_lds = (bf16*)(lds + 2 * SHM_V);
  float* ws = (float*)(lds + 2 * SHM_V + 2 * SHM_K) + wid * 64; float* li_l = ws; float* al_l = ws + 32;
  float m_reg = -1e30f, l_reg = 0; f32x16 o[4] = {}; bf16x8 qr[8];
  const TQ* Qw = Qb + (long)(wid * QBLK + r32) * LDQ + hi * 8;
#pragma unroll
  for (int d0 = 0; d0 < 8; ++d0) qr[d0] = SQ::tobf(SQ::ld8(Qw + d0 * 16));
  {
    const int tq = t_base + wid * QBLK + r32;
    float v[8][8]; float ss = 0.f;
#pragma unroll
    for (int d0 = 0; d0 < 8; ++d0)
#pragma unroll
      for (int j = 0; j < 8; ++j) { v[d0][j] = __uint_as_float(((unsigned)(unsigned short)qr[d0][j]) << 16); ss += v[d0][j] * v[d0][j]; }
    ss += __shfl_xor(ss, 32);
    const float rs = rsqrtf(ss * (1.f / 128.f) + 1e-6f);
#pragma unroll
    for (int d0 = 0; d0 < 8; ++d0) { const float4 g0 = *reinterpret_cast<const float4*>(qn + d0 * 16 + hi * 8), g1 = *reinterpret_cast<const float4*>(qn + d0 * 16 + hi * 8 + 4);
      v[d0][0] *= rs * g0.x; v[d0][1] *= rs * g0.y; v[d0][2] *= rs * g0.z; v[d0][3] *= rs * g0.w; v[d0][4] *= rs * g1.x; v[d0][5] *= rs * g1.y; v[d0][6] *= rs * g1.z; v[d0][7] *= rs * g1.w; }
#pragma unroll
    for (int ax = 0; ax < 2; ++ax) { const float pos = ax ? (float)(tq & 63) : (float)(tq >> 6);
#pragma unroll
      for (int e = 0; e < 2; ++e)
#pragma unroll
        for (int j = 0; j < 8; ++j) { const int f = e * 16 + hi * 8 + j; const float ang = pos * exp2f(-(float)f * (13.287712379549449f / 32.f)); const float c = __cosf(ang), s = __sinf(ang);
          const float x1 = v[ax * 4 + e][j], x2 = v[ax * 4 + 2 + e][j]; v[ax * 4 + e][j] = x1 * c - x2 * s; v[ax * 4 + 2 + e][j] = x2 * c + x1 * s; } }
#pragma unroll
    for (int d0 = 0; d0 < 8; ++d0) { u32x4 w = {cvtpk(v[d0][0], v[d0][1]), cvtpk(v[d0][2], v[d0][3]), cvtpk(v[d0][4], v[d0][5]), cvtpk(v[d0][6], v[d0][7])}; qr[d0] = *reinterpret_cast<bf16x8*>(&w); }
  }
  const int sr = tid >> 4, sc = (tid & 15) * 8, vst0 = v_st(sr, sc), vst1 = v_st(32 + sr, sc);
  const int vb0 = (int)(uintptr_t)V_lds + v_rd_base(lane);
  struct { typename St::T vs0, vs1, ks0, ks1; } sr_[SDEPTH];
#define SLOAD(i, k0) do { sr_[i].vs0 = St::ld8(&Vh[(long)((k0) + sr) * LDK + sc]); sr_[i].vs1 = St::ld8(&Vh[(long)((k0) + 32 + sr) * LDK + sc]); \
    sr_[i].ks0 = St::ld8(&Kh[(long)((k0) + sr) * LDK + sc]); sr_[i].ks1 = St::ld8(&Kh[(long)((k0) + 32 + sr) * LDK + sc]); } while (0)
#define SWRITE(b, i) do { *(bf16x8*)((char*)V_lds + (b) * SHM_V + vst0) = St::tobf(sr_[i].vs0);          \
    *(bf16x8*)((char*)V_lds + (b) * SHM_V + vst1) = St::tobf(sr_[i].vs1); int kc = sc * 2;               \
    *(bf16x8*)((char*)K_lds + (b) * SHM_K + KSWZ(sr, kc)) = St::tobf(sr_[i].ks0);                       \
    *(bf16x8*)((char*)K_lds + (b) * SHM_K + KSWZ(32 + sr, kc)) = St::tobf(sr_[i].ks1); } while (0)
#define SWAIT() do { if constexpr (SDEPTH == 2) asm volatile("s_waitcnt vmcnt(4)" ::: "memory"); else asm volatile("s_waitcnt vmcnt(0)" ::: "memory"); } while (0)
#define RESC(a) do { if (__any((a) < 1.f)) { if (hi == 0) al_l[r32] = (a); asm volatile("s_waitcnt lgkmcnt(0)" ::: "memory"); \
    for (int d = 0; d < 4; ++d) for (int r = 0; r < 16; ++r) o[d][r] *= al_l[crow(r, hi)]; } } while (0)
  f32x16 pA0, pA1, pB0, pB1; float mnA, mnB, alA, alB; bf16x8 pa0, pa1, pa2, pa3; const int NT = seq / KVBLK;
  constexpr int SE = 0, SO = SDEPTH - 1;
  SLOAD(SE, 0); asm volatile("s_waitcnt vmcnt(0)" ::: "memory"); SWRITE(0, SE); __syncthreads();
  qkt(pA0, pA1, K_lds, qr, r32, hi); partialSM(pA0, pA1, m_reg, mnA, alA);
  SLOAD(SO, KVBLK); if constexpr (SDEPTH == 2) { if (2 < NT) SLOAD(SE, 2 * KVBLK); }
  SWAIT(); SWRITE(1, SO); __syncthreads();
  for (int j = 1; j + 1 < NT; j += 2) {
    SBAR(); qkt(pB0, pB1, (bf16*)((char*)K_lds + SHM_K), qr, r32, hi);
    finishSM(pA0, pA1, alA, l_reg, pa0, pa1, pa2, pa3); SBAR();
    SLOAD(SO, (j + SDEPTH) * KVBLK); SBAR();
    pv_d0(o, vb0, pa0, pa1, pa2, pa3); partialSM(pB0, pB1, m_reg, mnB, alB);
    __syncthreads(); SWAIT(); SWRITE(0, SE);
    RESC(alB); __syncthreads();
    SBAR(); qkt(pA0, pA1, K_lds, qr, r32, hi);
    finishSM(pB0, pB1, alB, l_reg, pa0, pa1, pa2, pa3); SBAR();
    if (SDEPTH == 1 || j + 3 < NT) SLOAD(SE, (j + 1 + SDEPTH) * KVBLK); SBAR();
    pv_d0(o, vb0 + (int)SHM_V, pa0, pa1, pa2, pa3); partialSM(pA0, pA1, m_reg, mnA, alA);
    __syncthreads(); SWAIT(); SWRITE(1, SO);
    RESC(alA); __syncthreads();
  }
  SBAR(); qkt(pB0, pB1, (bf16*)((char*)K_lds + SHM_K), qr, r32, hi);
  finishSM(pA0, pA1, alA, l_reg, pa0, pa1, pa2, pa3); SBAR();
  pv_d0(o, vb0, pa0, pa1, pa2, pa3); partialSM(pB0, pB1, m_reg, mnB, alB);
  __syncthreads(); RESC(alB);
  finishSM(pB0, pB1, alB, l_reg, pa0, pa1, pa2, pa3); SBAR();
  pv_d0(o, vb0 + (int)SHM_V, pa0, pa1, pa2, pa3);
  if (hi == 0) li_l[r32] = l_reg; asm volatile("s_waitcnt lgkmcnt(0)" ::: "memory");
  float rli[16];
#pragma unroll
  for (int r = 0; r < 16; ++r) rli[r] = __builtin_amdgcn_rcpf(li_l[crow(r, hi)]);
  unsigned short* Ow = Ob + (long)(wid * QBLK) * LDO;
#pragma unroll
  for (int r = 0; r < 16; ++r) { int orow = crow(r, hi);
    for (int d0 = 0; d0 < 4; ++d0) Ow[(long)orow * LDO + d0 * 32 + r32] = f2bf_rne(o[d0][r] * rli[r]); }
#undef SLOAD
#undef SWRITE
#undef SWAIT
#undef RESC
}

}

typedef unsigned short u16;
typedef float f32x4 __attribute__((ext_vector_type(4)));
typedef unsigned u32x4 __attribute__((ext_vector_type(4)));
typedef unsigned u32x2 __attribute__((ext_vector_type(2)));
typedef short s16x8 __attribute__((ext_vector_type(8)));

constexpr int MLAT = 32768, MCTX = 2048, MALL = 34816, FH = 2816, INW = 7712, NMODC = 9216;
constexpr int LDS_BYTES = 147456;
constexpr size_t MiB = 1048576;
constexpr size_t O_WGU1 = 0;
constexpr size_t O_WD1  = O_WGU1 + (size_t)5632 * 1024 * 2;
constexpr size_t O_WGU2 = O_WD1 + (size_t)1024 * 2816 * 2;
constexpr size_t O_WD2  = O_WGU2 + (size_t)5632 * 1024 * 2;
constexpr size_t O_WIN1 = O_WD2 + (size_t)1024 * 2816 * 2;
constexpr size_t O_WIN2 = O_WIN1 + (size_t)3328 * 1024 * 2;
constexpr size_t O_WDN  = O_WIN2 + (size_t)4608 * 1024 * 2;
constexpr size_t O_WAT  = O_WDN + (size_t)1024 * 1024 * 2;
constexpr size_t O_WOUT = O_WAT + (size_t)1024 * 1024 * 2;
constexpr size_t O_MOD  = O_WOUT + (size_t)1024 * 1024 * 2;
static_assert(O_MOD + 9 * 9216 * 4 + 64 <= 55 * MiB + 512 * 1024, "persistent region");
constexpr size_t O_Y1 = 56 * MiB;
constexpr size_t O_A = 124 * MiB;
constexpr size_t O_ACT = 192 * MiB;
constexpr size_t O_QRAW = 192 * MiB, O_KRAW = 260 * MiB, O_REC = 192 * MiB, O_QD = 340 * MiB, O_KD = 408 * MiB, O_BA = 476 * MiB, O_VD = O_A;
constexpr size_t O_QA = 192 * MiB, O_KVA = 256 * MiB, O_GATES = 290 * MiB, O_Z = 418 * MiB;
constexpr size_t O_KALL = 124 * MiB, O_VALL = 141 * MiB;
constexpr size_t O_A3 = O_A, O_T = O_Z, O_Y = O_A, O_A5 = O_QA, O_ACT2 = 256 * MiB, O_Y2 = O_A;
constexpr size_t O_BAR = 55 * MiB + 512 * 1024;
constexpr size_t WS_NEED = 512 * MiB;
constexpr int REC_BYTES = 17408;

struct Args { const float* in[26]; float* out; unsigned char* ws; };

__device__ __forceinline__ float bf_lo(unsigned w) { return __uint_as_float(w << 16); }
__device__ __forceinline__ float bf_hi(unsigned w) { return __uint_as_float(w & 0xffff0000u); }
__device__ __forceinline__ float bf2f(u16 v) { return __uint_as_float(((unsigned)v) << 16); }
__device__ __forceinline__ u16 f2bf(float f) { unsigned u = __float_as_uint(f); u += 0x7FFFu + ((u >> 16) & 1u); return (u16)(u >> 16); }
typedef __bf16 bf16x2_t __attribute__((ext_vector_type(2)));
__device__ __forceinline__ unsigned pk(float lo, float hi) { bf16x2_t v; v[0] = (__bf16)lo; v[1] = (__bf16)hi; return __builtin_bit_cast(unsigned, v); }
__device__ __forceinline__ float silu_f(float v) { return v * __builtin_amdgcn_rcpf(1.f + __expf(-v)); }
__device__ __forceinline__ float sigm_f(float v) { return __builtin_amdgcn_rcpf(1.f + __expf(-v)); }
__device__ __forceinline__ float wave_sum(float v) {
#pragma unroll
    for (int o = 32; o > 0; o >>= 1) v += __shfl_xor(v, o);
    return v; }
__device__ __forceinline__ float grp16_sum(float v) {
#pragma unroll
    for (int o = 8; o > 0; o >>= 1) v += __shfl_xor(v, o);
    return v; }
__device__ __forceinline__ float grp32_sum(float v) {
#pragma unroll
    for (int o = 16; o > 0; o >>= 1) v += __shfl_xor(v, o);
    return v; }
__device__ __forceinline__ f32x4 mfma16(s16x8 a, s16x8 b, f32x4 c) { return __builtin_amdgcn_mfma_f32_16x16x32_bf16(a, b, c, 0, 0, 0); }
__device__ __forceinline__ u32x4 pk8(f32x4 a, f32x4 b) { return (u32x4){pk(a[0], a[1]), pk(a[2], a[3]), pk(b[0], b[1]), pk(b[2], b[3])}; }
__device__ __forceinline__ void unpk8(u32x4 w, f32x4& a, f32x4& b) { a = (f32x4){bf_lo(w.x), bf_hi(w.x), bf_lo(w.y), bf_hi(w.y)}; b = (f32x4){bf_lo(w.z), bf_hi(w.z), bf_lo(w.w), bf_hi(w.w)}; }

__device__ __forceinline__ int map_gu(int n) { const int p = n >> 8, r = n & 255; return r < 128 ? p * 128 + r : 2816 + p * 128 + (r - 128); }
__device__ __forceinline__ int map_in1(int n) { return n < 3072 ? n : (n < 3104 ? 4096 + (n - 3072) : -1); }
__device__ __forceinline__ int map_in2(int n) { return n < 1024 ? 3072 + n : (n < 2048 ? 4128 + (n - 1024) : (n < 2560 ? 5152 + (n - 2048) : 5664 + (n - 2560))); }

template <int MAP> __device__ __forceinline__ void cvt_w(const float* __restrict__ src, int K, int Nsrc, u16* __restrict__ dst, int Np, long gtid, long gthreads) {
    const long total = (long)Np * (K >> 5);
    for (long idx = gtid; idx < total; idx += gthreads) {
        const int np = (int)(idx % Np), kg = (int)(idx / Np);
        const int sc = MAP == 0 ? np : (MAP == 1 ? map_gu(np) : (MAP == 2 ? map_in1(np) : map_in2(np)));
        u32x4 w0 = {0u, 0u, 0u, 0u}, w1 = w0, w2 = w0, w3 = w0;
        if (sc >= 0) {
            const float* p = src + (size_t)(kg * 32) * Nsrc + sc;
            float f[32];
#pragma unroll
            for (int j = 0; j < 32; ++j) f[j] = p[(size_t)j * Nsrc];
            w0 = (u32x4){pk(f[0], f[1]), pk(f[2], f[3]), pk(f[4], f[5]), pk(f[6], f[7])};
            w1 = (u32x4){pk(f[8], f[9]), pk(f[10], f[11]), pk(f[12], f[13]), pk(f[14], f[15])};
            w2 = (u32x4){pk(f[16], f[17]), pk(f[18], f[19]), pk(f[20], f[21]), pk(f[22], f[23])};
            w3 = (u32x4){pk(f[24], f[25]), pk(f[26], f[27]), pk(f[28], f[29]), pk(f[30], f[31])};
        }
        u32x4* d = (u32x4*)(dst + (size_t)np * K + kg * 32);
        d[0] = w0; d[1] = w1; d[2] = w2; d[3] = w3;
    }
}

__device__ __forceinline__ void phase_mod(const Args& a, unsigned char* shm) {
    float* sc = (float*)shm;
    float* red = sc + 9216;
    const float* c = a.in[1]; const float* cc = a.in[3]; const float* wmod = a.in[4]; const float* bmod = a.in[5];
    float* mod = (float*)(a.ws + O_MOD);
    const int tid = tid_opaque();
    for (int i = tid; i < 9216; i += 512) { const int r = i >> 10, k = i & 1023; const float v = r < 8 ? c[r * 1024 + k] : cc[k]; sc[i] = silu_f(v); }
    __syncthreads();
    const int cl = tid & 31, kg = tid >> 5;
    for (int task = blockIdx.x; task < 288; task += gridDim.x) {
        const int col = task * 32 + cl;
        float acc[9];
#pragma unroll
        for (int r = 0; r < 9; ++r) acc[r] = 0.f;
#pragma unroll 8
        for (int kk = 0; kk < 64; ++kk) { const int k = kg * 64 + kk; const float w = wmod[(size_t)k * NMODC + col];
#pragma unroll
            for (int r = 0; r < 9; ++r) acc[r] += sc[r * 1024 + k] * w; }
#pragma unroll
        for (int r = 0; r < 9; ++r) red[(kg * 9 + r) * 32 + cl] = acc[r];
        __syncthreads();
        if (tid < 288) { const int r = tid >> 5; float s = bmod[task * 32 + cl];
            for (int g = 0; g < 16; ++g) s += red[(g * 9 + r) * 32 + cl];
            mod[r * NMODC + task * 32 + cl] = s; }
        __syncthreads();
    }
}

struct Row { f32x4 v[4]; };
__device__ __forceinline__ void ld_row_f32(Row& r, const float* p, int lane) {
#pragma unroll
    for (int i = 0; i < 4; ++i) r.v[i] = *(const f32x4*)(p + 256 * i + 4 * lane); }
__device__ __forceinline__ void st_row_f32(const Row& r, float* p, int lane) {
#pragma unroll
    for (int i = 0; i < 4; ++i) *(f32x4*)(p + 256 * i + 4 * lane) = r.v[i]; }
__device__ __forceinline__ void ld_row_bf(Row& r, const u16* p, int lane) {
#pragma unroll
    for (int i = 0; i < 4; ++i) { const u32x2 u = *(const u32x2*)(p + 256 * i + 4 * lane); r.v[i] = (f32x4){bf_lo(u.x), bf_hi(u.x), bf_lo(u.y), bf_hi(u.y)}; } }
__device__ __forceinline__ void st_row_bf(const Row& r, u16* p, int lane) {
#pragma unroll
    for (int i = 0; i < 4; ++i) { u32x2 u; u.x = pk(r.v[i][0], r.v[i][1]); u.y = pk(r.v[i][2], r.v[i][3]); *(u32x2*)(p + 256 * i + 4 * lane) = u; } }
__device__ __forceinline__ void row_norm(Row& y, const Row& x, const float* g, int lane) {
    float s = 0.f;
#pragma unroll
    for (int i = 0; i < 4; ++i) s += x.v[i][0] * x.v[i][0] + x.v[i][1] * x.v[i][1] + x.v[i][2] * x.v[i][2] + x.v[i][3] * x.v[i][3];
    s = wave_sum(s);
    const float rs = rsqrtf(s * (1.f / 1024.f) + 1e-6f);
#pragma unroll
    for (int i = 0; i < 4; ++i) { const f32x4 gv = *(const f32x4*)(g + 256 * i + 4 * lane); y.v[i] = x.v[i] * rs * gv; } }
__device__ __forceinline__ void row_mod(Row& h, const float* shift, const float* scale, int lane) {
#pragma unroll
    for (int i = 0; i < 4; ++i) { const f32x4 sh = *(const f32x4*)(shift + 256 * i + 4 * lane), sc = *(const f32x4*)(scale + 256 * i + 4 * lane); h.v[i] = h.v[i] * (sc + 1.f) + sh; } }
__device__ __forceinline__ void row_res(Row& x, const Row& t, const float* gate, float w, int lane) {
#pragma unroll
    for (int i = 0; i < 4; ++i) { const f32x4 gv = *(const f32x4*)(gate + 256 * i + 4 * lane); x.v[i] = x.v[i] + gv * t.v[i] * w; } }

__device__ __forceinline__ Row ld_vec(const float* p, int lane) { Row r; ld_row_f32(r, p, lane); return r; }
__device__ __forceinline__ float row_rs(const Row& x) {
    float s = 0.f;
#pragma unroll
    for (int i = 0; i < 4; ++i) s += x.v[i][0] * x.v[i][0] + x.v[i][1] * x.v[i][1] + x.v[i][2] * x.v[i][2] + x.v[i][3] * x.v[i][3];
    s = wave_sum(s);
    return rsqrtf(s * (1.f / 1024.f) + 1e-6f); }
__device__ __forceinline__ void row_norm_r(Row& y, const Row& x, const Row& g) { const float rs = row_rs(x);
#pragma unroll
    for (int i = 0; i < 4; ++i) y.v[i] = x.v[i] * rs * g.v[i]; }
__device__ __forceinline__ void row_mod_r(Row& h, const Row& sh, const Row& sc) {
#pragma unroll
    for (int i = 0; i < 4; ++i) h.v[i] = h.v[i] * (sc.v[i] + 1.f) + sh.v[i]; }
__device__ __forceinline__ void row_res_r(Row& x, const Row& t, const Row& gate, float w) {
#pragma unroll
    for (int i = 0; i < 4; ++i) x.v[i] = x.v[i] + gate.v[i] * t.v[i] * w; }

__device__ __forceinline__ void phase_h1(const Args& a) {
    const int lane = tid_opaque() & 63, gw = blockIdx.x * 8 + (tid_opaque() >> 6), nw = gridDim.x * 8;
    const float* mod = (const float*)(a.ws + O_MOD); u16* A = (u16*)(a.ws + O_A);
    const Row pre = ld_vec(a.in[6], lane);
    { const int b = gw & 7; const float* md = mod + b * NMODC; const Row sh = ld_vec(md, lane), sc = ld_vec(md + 1024, lane);
      for (int j = gw >> 3; j < 4096; j += nw >> 3) { const int row = b * 4096 + j;
        Row xr, h; ld_row_f32(xr, a.in[0] + (size_t)row * 1024, lane); row_norm_r(h, xr, pre); row_mod_r(h, sh, sc); st_row_bf(h, A + (size_t)row * 1024, lane); } }
    { const float* md = mod + 8 * NMODC; const Row sh = ld_vec(md, lane), sc = ld_vec(md + 1024, lane);
      for (int row = MLAT + gw; row < MALL; row += nw) {
        Row xr, h; ld_row_f32(xr, a.in[2] + (size_t)(row - MLAT) * 1024, lane); row_norm_r(h, xr, pre); row_mod_r(h, sh, sc); st_row_bf(h, A + (size_t)row * 1024, lane); } }
}
__device__ __forceinline__ void phase_h2(const Args& a, int row_lo = 0, int row_hi = MALL, int bfirst = 0, int nblk = -1) {
    if (nblk < 0) nblk = gridDim.x;
    if ((int)blockIdx.x < bfirst || (int)blockIdx.x >= bfirst + nblk) return;
    const int lane = tid_opaque() & 63, gw = ((int)blockIdx.x - bfirst) * 8 + (tid_opaque() >> 6), nw = nblk * 8;
    const float* mod = (const float*)(a.ws + O_MOD); u16* A = (u16*)(a.ws + O_A); const u16* Y1 = (const u16*)(a.ws + O_Y1);
    const Row post1 = ld_vec(a.in[7], lane), mixpre = ld_vec(a.in[10], lane);
    if (row_lo < MLAT) { const int b = gw & 7; const float* md = mod + b * NMODC;
      const Row g2 = ld_vec(md + 2 * 1024, lane), sh = ld_vec(md + 3 * 1024, lane), sc = ld_vec(md + 4 * 1024, lane);
      for (int j = gw >> 3; j < 4096; j += nw >> 3) { const int row = b * 4096 + j;
        Row x1, yr, t, h; ld_row_f32(x1, a.in[0] + (size_t)row * 1024, lane); ld_row_bf(yr, Y1 + (size_t)row * 1024, lane);
        row_norm_r(t, yr, post1); row_res_r(x1, t, g2, 0.5f); row_norm_r(h, x1, mixpre); row_mod_r(h, sh, sc); st_row_bf(h, A + (size_t)row * 1024, lane); } }
    if (row_hi > MLAT) { const float* md = mod + 8 * NMODC;
      const Row g2 = ld_vec(md + 2 * 1024, lane), sh = ld_vec(md + 3 * 1024, lane), sc = ld_vec(md + 4 * 1024, lane);
      for (int row = MLAT + gw; row < MALL; row += nw) {
        Row x1, yr, t, h; ld_row_f32(x1, a.in[2] + (size_t)(row - MLAT) * 1024, lane); ld_row_bf(yr, Y1 + (size_t)row * 1024, lane);
        row_norm_r(t, yr, post1); row_res_r(x1, t, g2, 0.5f); row_norm_r(h, x1, mixpre); row_mod_r(h, sh, sc); st_row_bf(h, A + (size_t)row * 1024, lane); } }
}
__device__ __forceinline__ void phase_h3(const Args& a) {
    const int lane = tid_opaque() & 63, gw = blockIdx.x * 8 + (tid_opaque() >> 6), nw = gridDim.x * 8;
    const float* mod = (const float*)(a.ws + O_MOD); u16* A5 = (u16*)(a.ws + O_A5); const u16* Y = (const u16*)(a.ws + O_Y); const u16* Y1 = (const u16*)(a.ws + O_Y1);
    const int b = gw & 7; const float* md = mod + b * NMODC;
    const Row post1 = ld_vec(a.in[7], lane), mixpost = ld_vec(a.in[11], lane), pre2 = ld_vec(a.in[22], lane);
    const Row g2 = ld_vec(md + 2 * 1024, lane), g5 = ld_vec(md + 5 * 1024, lane), sh = ld_vec(md + 6 * 1024, lane), sc = ld_vec(md + 7 * 1024, lane);
    for (int j = gw >> 3; j < 4096; j += nw >> 3) { const int row = b * 4096 + j;
        Row x2, yr, t, h; ld_row_f32(x2, a.in[0] + (size_t)row * 1024, lane); ld_row_bf(yr, Y1 + (size_t)row * 1024, lane);
        row_norm_r(t, yr, post1); row_res_r(x2, t, g2, 0.5f);
        ld_row_bf(yr, Y + (size_t)row * 1024, lane); row_norm_r(t, yr, mixpost); row_res_r(x2, t, g5, 1.0f);
        st_row_f32(x2, a.out + (size_t)row * 1024, lane);
        row_norm_r(h, x2, pre2); row_mod_r(h, sh, sc); st_row_bf(h, A5 + (size_t)row * 1024, lane);
    }
}
__device__ __forceinline__ void phase_out(const Args& a) {
    const int lane = tid_opaque() & 63, gw = blockIdx.x * 8 + (tid_opaque() >> 6), nw = gridDim.x * 8;
    const float* mod = (const float*)(a.ws + O_MOD); const u16* Y2 = (const u16*)(a.ws + O_Y2);
    const int b = gw & 7; const Row post2 = ld_vec(a.in[23], lane), g8 = ld_vec(mod + b * NMODC + 8 * 1024, lane);
    for (int j = gw >> 3; j < 4096; j += nw >> 3) { const int row = b * 4096 + j;
        Row x2, yr, t; ld_row_f32(x2, a.out + (size_t)row * 1024, lane); ld_row_bf(yr, Y2 + (size_t)row * 1024, lane); row_norm_r(t, yr, post2); row_res_r(x2, t, g8, 0.5f);
        st_row_f32(x2, a.out + (size_t)row * 1024, lane);
    }
}

struct EpiPlain { static constexpr bool PERM = true, AFTER_DRAIN = false; u16* O; int ldc;
    __device__ __forceinline__ void operator()(const pg8::f32x4 (&acc)[2][2][4][2], const pg8::Unit& u, int wr, int wc, int fr, int fq) const {
        const int row0 = u.pm * 256 + wr * 64 + fr, col0 = u.pn * 256 + wc * 32 + 8 * fq;
#pragma unroll
        for (int ai = 0; ai < 2; ++ai)
#pragma unroll
            for (int m = 0; m < 4; ++m) { u16* rp = O + (size_t)(row0 + ai * 128 + m * 16) * ldc + col0;
#pragma unroll
                for (int bj = 0; bj < 2; ++bj) *(u32x4*)(rp + bj * 128) = pk8(acc[ai][bj][m][0], acc[ai][bj][m][1]); } } };

struct EpiSwiglu { static constexpr bool PERM = true, AFTER_DRAIN = false; u16* O;
    __device__ __forceinline__ void operator()(const pg8::f32x4 (&acc)[2][2][4][2], const pg8::Unit& u, int wr, int wc, int fr, int fq) const {
        const int row0 = u.pm * 256 + wr * 64 + fr, col0 = u.pn * 128 + wc * 32 + 8 * fq;
#pragma unroll
        for (int ai = 0; ai < 2; ++ai)
#pragma unroll
            for (int m = 0; m < 4; ++m) { u16* rp = O + (size_t)(row0 + ai * 128 + m * 16) * FH + col0;
                f32x4 o0, o1;
#pragma unroll
                for (int j = 0; j < 4; ++j) { o0[j] = silu_f(acc[ai][0][m][0][j]) * acc[ai][1][m][0][j]; o1[j] = silu_f(acc[ai][0][m][1][j]) * acc[ai][1][m][1][j]; }
                *(u32x4*)rp = pk8(o0, o1); } } };

struct EpiIn1 { static constexpr bool PERM = true, AFTER_DRAIN = false; u16* q; u16* k; u16* v; float* ba;
    __device__ __forceinline__ void operator()(const pg8::f32x4 (&acc)[2][2][4][2], const pg8::Unit& u, int wr, int wc, int fr, int fq) const {
        const int row0 = u.pm * 256 + wr * 64 + fr;
        if (u.pn < 12) {
            const int t3 = u.pn >> 2;
            u16* base = q + (long)(t3 == 1) * (long)(k - q) + (long)(t3 == 2) * (long)(v - q); const int col0 = (u.pn & 3) * 256 + wc * 32 + 8 * fq;
#pragma unroll
            for (int ai = 0; ai < 2; ++ai)
#pragma unroll
                for (int m = 0; m < 4; ++m) { u16* rp = base + (size_t)(row0 + ai * 128 + m * 16) * 1024 + col0;
#pragma unroll
                    for (int bj = 0; bj < 2; ++bj) *(u32x4*)(rp + bj * 128) = pk8(acc[ai][bj][m][0], acc[ai][bj][m][1]); }
        } else if (wc == 0) {
#pragma unroll
            for (int ai = 0; ai < 2; ++ai)
#pragma unroll
                for (int m = 0; m < 4; ++m) { float* rp = ba + (size_t)(row0 + ai * 128 + m * 16) * 32 + 8 * fq;
                    *(f32x4*)rp = acc[ai][0][m][0]; *(f32x4*)(rp + 4) = acc[ai][0][m][1]; }
        } } };
struct EpiIn2 { static constexpr bool PERM = true, AFTER_DRAIN = false; u16* z; u16* qa; u16* kva; u16* gates;
    __device__ __forceinline__ void operator()(const pg8::f32x4 (&acc)[2][2][4][2], const pg8::Unit& u, int wr, int wc, int fr, int fq) const {
        const int row0 = u.pm * 256 + wr * 64 + fr; const bool lat = u.pm < 128;
        u16* base; int ldc, col0; bool sig = false;
        if (u.pn < 4) { if (!lat) return; base = z; ldc = 1024; col0 = u.pn * 256; }
        else if (u.pn < 8) { if (!lat) return; base = qa; ldc = 1024; col0 = (u.pn - 4) * 256; }
        else if (u.pn < 10) { base = kva; ldc = 512; col0 = (u.pn - 8) * 256; }
        else { if (!lat) return; base = gates; ldc = 2048; col0 = (u.pn - 10) * 256; sig = true; }
        col0 += wc * 32 + 8 * fq;
#pragma unroll
        for (int ai = 0; ai < 2; ++ai)
#pragma unroll
            for (int m = 0; m < 4; ++m) { u16* rp = base + (size_t)(row0 + ai * 128 + m * 16) * ldc + col0;
#pragma unroll
                for (int bj = 0; bj < 2; ++bj) { f32x4 v0 = acc[ai][bj][m][0], v1 = acc[ai][bj][m][1];
                    if (sig) {
#pragma unroll
                        for (int j = 0; j < 4; ++j) { v0[j] = sigm_f(v0[j]); v1[j] = sigm_f(v1[j]); } }
                    *(u32x4*)(rp + bj * 128) = pk8(v0, v1); } } } };

template <int SECOND> struct EpiMerge { static constexpr bool PERM = true, AFTER_DRAIN = false; const u16* gates; u16* T;
    __device__ __forceinline__ void operator()(const pg8::f32x4 (&acc)[2][2][4][2], const pg8::Unit& u, int wr, int wc, int fr, int fq) const {
        const int row0 = u.pm * 256 + wr * 64 + fr, col0 = u.pn * 256 + wc * 32 + 8 * fq;
#pragma unroll
        for (int ai = 0; ai < 2; ++ai)
#pragma unroll
            for (int m = 0; m < 4; ++m) { const size_t row = (size_t)(row0 + ai * 128 + m * 16);
#pragma unroll
                for (int bj = 0; bj < 2; ++bj) { const int col = col0 + bj * 128;
                    const u32x4 gw = *(const u32x4*)(gates + row * 2048 + SECOND * 1024 + col); f32x4 g0, g1; unpk8(gw, g0, g1);
                    f32x4 o0 = g0 * acc[ai][bj][m][0], o1 = g1 * acc[ai][bj][m][1];
#if defined(EXP_ZERO_DN)
                    if (!SECOND) { o0 *= 0.f; o1 *= 0.f; }
#endif
#if defined(EXP_ZERO_AT)
                    if (SECOND) { o0 *= 0.f; o1 *= 0.f; }
#endif
                    if (SECOND) { const u32x4 tw = *(const u32x4*)(T + row * 1024 + col); f32x4 t0, t1; unpk8(tw, t0, t1); o0 += t0; o1 += t1; }
                    *(u32x4*)(T + row * 1024 + col) = pk8(o0, o1); } } } };

template <class Epi> __device__ __forceinline__ void run_gemm(unsigned char* shm, const u16* A, const u16* Bt, int M, int N, int K, const Epi& E) {
    pg8::Gemm g; g.A = A; g.Bt = Bt; g.M = M; g.N = N; g.K = K;
    pg8::StaticOrder S; S.init(M, N, (int)gridDim.x, (int)blockIdx.x);
    pg8::gemm_phase<Epi, pg8::StaticOrder, false>((PG8_LAS unsigned char*)shm, g, S, E, nullptr);
}

__device__ __forceinline__ void phase_dn_prep(const Args& a) {
    const int lane = tid_opaque() & 63, gw = blockIdx.x * 8 + (tid_opaque() >> 6), nw = gridDim.x * 8;
    const u16* raw0 = (const u16*)(a.ws + O_QRAW); const u16* raw1 = (const u16*)(a.ws + O_KRAW); const u16* raw2 = (const u16*)a.out;
    u16* out0 = (u16*)(a.ws + O_QD); u16* out1 = (u16*)(a.ws + O_KD); u16* out2 = (u16*)(a.ws + O_VD);
    const float* cw = a.in[13];
    for (int row = gw; row < MALL; row += nw) {
        const int pos = row < MLAT ? (row & 4095) : ((row - MLAT) & 255); const int L = row < MLAT ? 4096 : 256;
        const bool hp = pos > 0, hn = pos < L - 1;
#pragma unroll
        for (int i = 0; i < 6; ++i) {
            const int kind = i >> 1, cc = (i & 1) * 512 + 8 * lane, cg_ = kind * 1024 + cc;
            const u16* rp = (kind == 0 ? raw0 : (kind == 1 ? raw1 : raw2)) + (size_t)row * 1024 + cc;
            u16* op = (kind == 0 ? out0 : (kind == 1 ? out1 : out2)) + (size_t)row * 1024 + cc;
            const u32x4 zc = {0u, 0u, 0u, 0u};
            const u32x4 cu = *(const u32x4*)rp; const u32x4 pu = hp ? *(const u32x4*)(rp - 1024) : zc; const u32x4 nu = hn ? *(const u32x4*)(rp + 1024) : zc;
            f32x4 c0, c1, p0, p1, n0, n1; unpk8(cu, c0, c1); unpk8(pu, p0, p1); unpk8(nu, n0, n1);
            const f32x4 wa0 = *(const f32x4*)(cw + cg_), wa1 = *(const f32x4*)(cw + cg_ + 4);
            const f32x4 wb0 = *(const f32x4*)(cw + 3072 + cg_), wb1 = *(const f32x4*)(cw + 3072 + cg_ + 4);
            const f32x4 wc0 = *(const f32x4*)(cw + 6144 + cg_), wc1 = *(const f32x4*)(cw + 6144 + cg_ + 4);
            f32x4 v0 = wa0 * p0 + wb0 * c0 + wc0 * n0, v1 = wa1 * p1 + wb1 * c1 + wc1 * n1;
            float ss = 0.f;
#pragma unroll
            for (int j = 0; j < 4; ++j) { v0[j] = silu_f(v0[j]); v1[j] = silu_f(v1[j]); ss += v0[j] * v0[j] + v1[j] * v1[j]; }
            if (kind < 2) { ss = grp16_sum(ss); const float sc = rsqrtf(ss + 1e-6f) * (kind == 0 ? 0.08838834764831845f : 1.f); v0 *= sc; v1 *= sc; }
            *(u32x4*)op = pk8(v0, v1);
        }
    }
}

__device__ __forceinline__ void phase_dn_pre(const Args& a, unsigned char* shm) {
    const int tid = tid_opaque(), wid = tid >> 6, lane0 = tid & 63;
    float* Lm = (float*)(shm + wid * 17408); float* gcs = Lm + 4096; float* bts = gcs + 64;
    const u16* qd = (const u16*)(a.ws + O_QD); const u16* kd = (const u16*)(a.ws + O_KD); const float* BA = (const float*)(a.ws + O_BA);
    unsigned char* REC = a.ws + O_REC;
    for (int task = blockIdx.x * 8 + wid; task < 8704; task += gridDim.x * 8) {
        int lane = lane0; asm volatile("" : "+v"(lane));
        const int fr = lane & 15, quad = lane >> 4;
        const int c68 = task % 68; int tt = task / 68; const int dir = tt & 1; tt >>= 1; const int h = tt & 7; const int b = tt >> 3;
        const int base = c68 < 4 ? MLAT + b * 256 + c68 * 64 : b * 4096 + (c68 - 4) * 64;
        const int tok = dir ? 63 - lane : lane;
        const float* bap = BA + (size_t)(base + tok) * 32;
        const float beta = sigm_f(bap[dir * 8 + h]);
        const float xs = bap[16 + dir * 8 + h] + a.in[15][dir * 8 + h];
        const float sp = fmaxf(xs, 0.f) + log1pf(__expf(-fabsf(xs)));
        const float g = -__expf(a.in[14][dir * 8 + h]) * sp;
        float gc = g;
#pragma unroll
        for (int o = 1; o < 64; o <<= 1) { const float nb = __shfl_up(gc, o); if (lane >= o) gc += nb; }
        const float glast = __shfl(gc, 63);
        asm volatile("s_waitcnt lgkmcnt(0)" ::: "memory");
        gcs[lane] = gc; bts[lane] = beta;
        unsigned char* rec = REC + (size_t)task * REC_BYTES;
        float* rf = (float*)(rec + 16384);
        rf[lane] = __expf(gc); rf[64 + lane] = __expf(glast - gc); if (lane == 0) rf[128] = __expf(glast);
        asm volatile("s_waitcnt lgkmcnt(0)" ::: "memory");
        s16x8 kf[4][4];
#pragma unroll
        for (int mt = 0; mt < 4; ++mt) { const int r = 16 * mt + fr, tr = dir ? 63 - r : r; const u16* p = kd + (size_t)(base + tr) * 1024 + h * 128 + quad * 8;
#pragma unroll
            for (int kk = 0; kk < 4; ++kk) kf[mt][kk] = *(const s16x8*)(p + kk * 32); }
#pragma unroll
        for (int mt = 0; mt < 4; ++mt)
#pragma unroll
            for (int nt = 0; nt <= mt; ++nt) { f32x4 acc = {0.f, 0.f, 0.f, 0.f};
#pragma unroll
                for (int kk = 0; kk < 4; ++kk) acc = mfma16(kf[mt][kk], kf[nt][kk], acc);
                const int j = 16 * nt + fr; const float gj = gcs[j];
#pragma unroll
                for (int r = 0; r < 4; ++r) { const int i = 16 * mt + quad * 4 + r; Lm[i * 64 + j] = bts[i] * acc[r] * __expf(fminf(gcs[i] - gj, 0.f)); } }
        asm volatile("s_waitcnt lgkmcnt(0)" ::: "memory");
        const int hb = lane >> 5, cb = lane & 31;
        float tcol[32];
#pragma unroll
        for (int ii = 0; ii < 32; ++ii) {
            const float* Lrow = Lm + (32 * hb + ii) * 64 + 32 * hb;
            float s0 = (cb == ii) ? 1.f : 0.f, s1 = 0.f, s2 = 0.f, s3 = 0.f;
#pragma unroll
            for (int j4 = 0; j4 < (ii + 3) / 4; ++j4) { const f32x4 l = *(const f32x4*)(Lrow + j4 * 4);
                if (4 * j4 + 0 < ii) s0 -= l[0] * tcol[4 * j4 + 0];
                if (4 * j4 + 1 < ii) s1 -= l[1] * tcol[4 * j4 + 1];
                if (4 * j4 + 2 < ii) s2 -= l[2] * tcol[4 * j4 + 2];
                if (4 * j4 + 3 < ii) s3 -= l[3] * tcol[4 * j4 + 3]; }
            tcol[ii] = (s0 + s1) + (s2 + s3);
            __builtin_amdgcn_sched_barrier(0);
        }
        unsigned char* imgB = (unsigned char*)Lm;
        { const int m = lane >> 1, k0 = (lane & 1) * 16; const float* src = Lm + (32 + m) * 64 + k0;
          const f32x4 c0 = *(const f32x4*)(src), c1 = *(const f32x4*)(src + 4), c2 = *(const f32x4*)(src + 8), c3 = *(const f32x4*)(src + 12);
          *(u32x4*)(imgB + m * 64 + k0 * 2) = pk8(c0, c1); *(u32x4*)(imgB + m * 64 + k0 * 2 + 16) = pk8(c2, c3); }
        if (hb == 0) {
#pragma unroll
            for (int q = 0; q < 4; ++q) { u32x4 w; w.x = pk(tcol[8 * q], tcol[8 * q + 1]); w.y = pk(tcol[8 * q + 2], tcol[8 * q + 3]); w.z = pk(tcol[8 * q + 4], tcol[8 * q + 5]); w.w = pk(tcol[8 * q + 6], tcol[8 * q + 7]);
                *(u32x4*)(imgB + 2048 + cb * 64 + q * 16) = w; }
        } else {
#pragma unroll
            for (int m = 0; m < 32; ++m) *(u16*)(imgB + 4096 + m * 64 + cb * 2) = f2bf(tcol[m]);
        }
        asm volatile("s_waitcnt lgkmcnt(0)" ::: "memory");
        f32x4 Zb[2][2];
#pragma unroll
        for (int m2 = 0; m2 < 2; ++m2)
#pragma unroll
            for (int n2 = 0; n2 < 2; ++n2) { const f32x4 z0 = {0.f, 0.f, 0.f, 0.f};
                Zb[m2][n2] = mfma16(*(const s16x8*)(imgB + (16 * m2 + fr) * 64 + quad * 16), *(const s16x8*)(imgB + 2048 + (16 * n2 + fr) * 64 + quad * 16), z0); }
#pragma unroll
        for (int m2 = 0; m2 < 2; ++m2)
#pragma unroll
            for (int n2 = 0; n2 < 2; ++n2) { u32x2 w; w.x = pk(Zb[m2][n2][0], Zb[m2][n2][1]); w.y = pk(Zb[m2][n2][2], Zb[m2][n2][3]);
                *(u32x2*)(imgB + 6144 + (16 * n2 + fr) * 64 + (16 * m2 + 4 * quad) * 2) = w; }
        asm volatile("s_waitcnt lgkmcnt(0)" ::: "memory");
        f32x4 T21[2][2];
#pragma unroll
        for (int m2 = 0; m2 < 2; ++m2)
#pragma unroll
            for (int n2 = 0; n2 < 2; ++n2) { const f32x4 z0 = {0.f, 0.f, 0.f, 0.f};
                T21[m2][n2] = mfma16(*(const s16x8*)(imgB + 4096 + (16 * m2 + fr) * 64 + quad * 16), *(const s16x8*)(imgB + 6144 + (16 * n2 + fr) * 64 + quad * 16), z0); }
        u16* img = (u16*)Lm;
        asm volatile("s_waitcnt lgkmcnt(0)" ::: "memory");
#pragma unroll
        for (int ii = 0; ii < 32; ++ii) img[4096 + (32 * hb + ii) * 64 + lane] = f2bf(tcol[ii] * beta);
        if (hb == 1) {
#pragma unroll
            for (int ii = 0; ii < 32; ++ii) img[4096 + ii * 64 + lane] = 0; }
#pragma unroll
        for (int m2 = 0; m2 < 2; ++m2)
#pragma unroll
            for (int n2 = 0; n2 < 2; ++n2) { const int col = 16 * n2 + fr; const float bc = bts[col];
#pragma unroll
                for (int r = 0; r < 4; ++r) img[4096 + (32 + 16 * m2 + 4 * quad + r) * 64 + col] = f2bf(-T21[m2][n2][r] * bc); }
#pragma unroll
        for (int mt = 0; mt < 4; ++mt) { const int r_ = 16 * mt + fr, tr = dir ? 63 - r_ : r_; const u16* p = qd + (size_t)(base + tr) * 1024 + h * 128 + quad * 8;
            s16x8 qf[4];
#pragma unroll
            for (int kk = 0; kk < 4; ++kk) qf[kk] = *(const s16x8*)(p + kk * 32);
#pragma unroll
            for (int nt = 0; nt < 4; ++nt) { const int j = 16 * nt + fr;
                if (nt <= mt) { f32x4 acc = {0.f, 0.f, 0.f, 0.f};
#pragma unroll
                    for (int kk = 0; kk < 4; ++kk) acc = mfma16(qf[kk], kf[nt][kk], acc);
                    const float gj = gcs[j];
#pragma unroll
                    for (int r = 0; r < 4; ++r) { const int i = 16 * mt + quad * 4 + r; const float v = (j <= i) ? acc[r] * __expf(fminf(gcs[i] - gj, 0.f)) : 0.f; img[i * 64 + j] = f2bf(v); }
                } else {
#pragma unroll
                    for (int r = 0; r < 4; ++r) { const int i = 16 * mt + quad * 4 + r; img[i * 64 + j] = 0; } } } }
        asm volatile("s_waitcnt lgkmcnt(0)" ::: "memory");
        { const u32x4* src = (const u32x4*)Lm; u32x4* dst = (u32x4*)rec;
#pragma unroll
            for (int q = 0; q < 8; ++q) { dst[q * 64 + lane] = src[512 + q * 64 + lane]; dst[512 + q * 64 + lane] = src[q * 64 + lane]; } }
    }
}

__device__ __forceinline__ void phase_dn_scan(const Args& a, unsigned char* shm) {
    const int tid = tid_opaque(), wid = tid >> 6, lane = tid & 63, fr = lane & 15, quad = lane >> 4, r32 = lane & 31, hi = lane >> 5;
    unsigned char* ST = shm; unsigned char* KV = shm + 17408; unsigned char* RT = KV + 16384; unsigned char* VN = RT + 9216; unsigned char* VS = VN + 9216;
    unsigned char* KR = VS + 9216; unsigned char* QR = KR + 17408;
    const int mt = wid & 3, ng = wid >> 2, mtS = wid & 1, D0 = wid >> 1;
    const int sr = tid >> 4, sc = (tid & 15) * 8, vst0 = at::v_st(sr, sc), vst1 = at::v_st(32 + sr, sc);
    const int vb0 = (int)(uintptr_t)KV + at::v_rd_base(lane);
    const u16* qd = (const u16*)(a.ws + O_QD); const u16* kd = (const u16*)(a.ws + O_KD); const u16* vd = (const u16*)(a.ws + O_VD);
    const unsigned char* REC = a.ws + O_REC;
    for (int task = blockIdx.x; task < 256; task += gridDim.x) {
        const int half = task & 1, dir = (task >> 1) & 1, h = (task >> 2) & 7, b = task >> 5;
        u16* Od = (u16*)a.out + (dir ? (size_t)MLAT * 1024 : (size_t)0);
        at::f32x16 sT;
#pragma unroll
        for (int r = 0; r < 16; ++r) sT[r] = 0.f;
        const int irow = 16 * mt + fr, i0 = 16 * mt + quad * 4;
        const int dv0 = 32 * ng + fr, dv1 = dv0 + 16;
        const int trow = dir ? 63 - irow : irow, t0 = dir ? 63 - sr : sr, t1 = dir ? 31 - sr : 32 + sr;
        const int hoff = h * 128;
#define SCAN_C68(n_) ((n_) < 4 ? (dir ? 3 - (n_) : (n_)) : (dir ? 71 - (n_) : (n_)))
#define SCAN_BASE(c_) ((c_) < 4 ? MLAT + b * 256 + (c_) * 64 : b * 4096 + ((c_) - 4) * 64)
#define SCAN_REC(c_) (REC + (size_t)((((b * 8 + h) * 2 + dir) * 68) + (c_)) * REC_BYTES)
        s16x8 K0, K1, Q0, Q1, TB[2], IN[2]; f32x4 EG, EK, V0, V1; float DCH;
        const unsigned oK0 = (unsigned)(t0 * 1024 + hoff + sc), oK1 = (unsigned)(t1 * 1024 + hoff + sc), oA = (unsigned)(trow * 1024 + hoff + quad * 8), oT = (unsigned)(irow * 64 + quad * 8);
        unsigned oV[4];
#pragma unroll
        for (int r = 0; r < 4; ++r) oV[r] = (unsigned)((dir ? 63 - (i0 + r) : (i0 + r)) * 1024 + hoff + half * 64 + dv0);
#define LD_K(base_)   do { const u16* kb_ = kd + (size_t)(base_) * 1024; const u16* qb_ = qd + (size_t)(base_) * 1024; K0 = *(const s16x8*)(kb_ + oK0); K1 = *(const s16x8*)(kb_ + oK1); Q0 = *(const s16x8*)(qb_ + oK0); Q1 = *(const s16x8*)(qb_ + oK1); } while (0)
#define LD_A(base_)   do { const u16* vb_ = vd + (size_t)(base_) * 1024; \
        _Pragma("unroll") for (int r = 0; r < 4; ++r) { V0[r] = bf2f(vb_[oV[r]]); V1[r] = bf2f(vb_[oV[r] + 16]); } } while (0)
#define LD_TB(rec_)   do { const u16* p_ = (const u16*)(rec_) + oT; TB[0] = *(const s16x8*)p_; TB[1] = *(const s16x8*)(p_ + 32); EK = *(const f32x4*)((const float*)((rec_) + 16384) + 64 + i0); } while (0)
#define LD_IN(rec_)   do { const u16* p_ = (const u16*)((rec_) + 8192) + oT; IN[0] = *(const s16x8*)p_; IN[1] = *(const s16x8*)(p_ + 32); } while (0)
#define LD_EG(rec_)   do { EG = *(const f32x4*)((const float*)((rec_) + 16384) + i0); } while (0)
#define LD_D(rec_)    do { DCH = ((const float*)((rec_) + 16384))[128]; } while (0)
        { const int c0 = SCAN_C68(0); const int bs = SCAN_BASE(c0); const unsigned char* rc = SCAN_REC(c0);
          LD_K(bs); LD_A(bs); LD_TB(rc); LD_IN(rc); LD_EG(rc); LD_D(rc); }
        for (int n = 0; n < 68; ++n) {
            const int c68 = SCAN_C68(n);
            const int base = SCAN_BASE(c68);
            const int nn = n < 67 ? n + 1 : 67; const int c68n = SCAN_C68(nn); const int basen = SCAN_BASE(c68n); const unsigned char* recn = SCAN_REC(c68n);
#pragma unroll
            for (int r = 0; r < 16; ++r) *(u16*)(ST + (32 * mtS + at::crow(r, hi)) * 272 + (32 * D0 + r32) * 2) = f2bf(sT[r]);
            *(s16x8*)(KV + vst0) = K0; *(s16x8*)(KV + vst1) = K1;
            *(s16x8*)(KR + sr * 272 + sc * 2) = K0; *(s16x8*)(KR + (32 + sr) * 272 + sc * 2) = K1;
            *(s16x8*)(QR + sr * 272 + sc * 2) = Q0; *(s16x8*)(QR + (32 + sr) * 272 + sc * 2) = Q1;
            LD_K(basen);
            __syncthreads();
            f32x4 KS0 = {0.f, 0.f, 0.f, 0.f}, KS1 = KS0, QS0 = KS0, QS1 = KS0;
#pragma unroll
            for (int kk = 0; kk < 4; ++kk) {
                const s16x8 b0 = *(const s16x8*)(ST + dv0 * 272 + (kk * 32 + quad * 8) * 2), b1 = *(const s16x8*)(ST + dv1 * 272 + (kk * 32 + quad * 8) * 2);
                const s16x8 ak = *(const s16x8*)(KR + irow * 272 + (kk * 32 + quad * 8) * 2), aq = *(const s16x8*)(QR + irow * 272 + (kk * 32 + quad * 8) * 2);
                KS0 = mfma16(ak, b0, KS0); KS1 = mfma16(ak, b1, KS1); QS0 = mfma16(aq, b0, QS0); QS1 = mfma16(aq, b1, QS1);
            }
            {
                const f32x4 r0 = V0 - EG * KS0, r1 = V1 - EG * KS1;
                u32x2 w0, w1; w0.x = pk(r0[0], r0[1]); w0.y = pk(r0[2], r0[3]); w1.x = pk(r1[0], r1[1]); w1.y = pk(r1[2], r1[3]);
                *(u32x2*)(RT + dv0 * 144 + i0 * 2) = w0; *(u32x2*)(RT + dv1 * 144 + i0 * 2) = w1;
            }
            LD_A(basen);
            __syncthreads();
            f32x4 N0 = {0.f, 0.f, 0.f, 0.f}, N1 = N0;
            {
#pragma unroll
                for (int kk = 0; kk < 2; ++kk) {
                    const s16x8 b0 = *(const s16x8*)(RT + dv0 * 144 + (kk * 32 + quad * 8) * 2), b1 = *(const s16x8*)(RT + dv1 * 144 + (kk * 32 + quad * 8) * 2);
                    N0 = mfma16(TB[kk], b0, N0); N1 = mfma16(TB[kk], b1, N1); }
                u32x2 w0, w1; w0.x = pk(N0[0], N0[1]); w0.y = pk(N0[2], N0[3]); w1.x = pk(N1[0], N1[1]); w1.y = pk(N1[2], N1[3]);
                *(u32x2*)(VN + dv0 * 144 + i0 * 2) = w0; *(u32x2*)(VN + dv1 * 144 + i0 * 2) = w1;
                const f32x4 s0 = N0 * EK, s1 = N1 * EK;
                w0.x = pk(s0[0], s0[1]); w0.y = pk(s0[2], s0[3]); w1.x = pk(s1[0], s1[1]); w1.y = pk(s1[2], s1[3]);
                *(u32x2*)(VS + dv0 * 144 + i0 * 2) = w0; *(u32x2*)(VS + dv1 * 144 + i0 * 2) = w1;
            }
            LD_TB(recn);
            __syncthreads();
            {
                f32x4 O0 = QS0 * EG, O1 = QS1 * EG;
#pragma unroll
                for (int kk = 0; kk < 2; ++kk) {
                    const s16x8 b0 = *(const s16x8*)(VN + dv0 * 144 + (kk * 32 + quad * 8) * 2), b1 = *(const s16x8*)(VN + dv1 * 144 + (kk * 32 + quad * 8) * 2);
                    O0 = mfma16(IN[kk], b0, O0); O1 = mfma16(IN[kk], b1, O1); }
                if (n >= 4) {
#pragma unroll
                    for (int r = 0; r < 4; ++r) { u16* op = Od + (size_t)base * 1024 + oV[r];
                        op[0] = f2bf(O0[r]); op[16] = f2bf(O1[r]); } }
            }
            LD_IN(recn); LD_EG(recn);
            {
#pragma unroll
                for (int r = 0; r < 16; ++r) sT[r] *= DCH;
                LD_D(recn);
                const unsigned char* vsp = VS + (32 * mtS + r32) * 144 + (8 * hi) * 2;
                const at::bf16x8 pa0 = *(const at::bf16x8*)(vsp), pa1 = *(const at::bf16x8*)(vsp + 32), pa2 = *(const at::bf16x8*)(vsp + 64), pa3 = *(const at::bf16x8*)(vsp + 96);
                if (D0 == 0) at::pv_one<0>(sT, vb0, pa0, pa1, pa2, pa3);
                else if (D0 == 1) at::pv_one<1>(sT, vb0, pa0, pa1, pa2, pa3);
                else if (D0 == 2) at::pv_one<2>(sT, vb0, pa0, pa1, pa2, pa3);
                else at::pv_one<3>(sT, vb0, pa0, pa1, pa2, pa3);
            }
            __syncthreads();
        }
#undef LD_K
#undef LD_A
#undef LD_TB
#undef LD_IN
#undef LD_EG
#undef LD_D
#undef SCAN_C68
#undef SCAN_BASE
#undef SCAN_REC
    }
}

#if defined(EXP_NAIVE_DN)
__device__ __forceinline__ void phase_dn_naive(const Args& a, unsigned char* shm) {
    const int tid = tid_opaque(), dvl = tid & 63, kg = tid >> 6;
    float* red = (float*)shm;
    const u16* qd = (const u16*)(a.ws + O_QD); const u16* kd = (const u16*)(a.ws + O_KD); const u16* vd = (const u16*)(a.ws + O_VD); const float* BA = (const float*)(a.ws + O_BA);
    for (int task = blockIdx.x; task < 256; task += gridDim.x) {
        const int half = task & 1, dir = (task >> 1) & 1, h = (task >> 2) & 7, b = task >> 5;
#if defined(EXP_HYBRID)
        if (!(EXP_HYBRID)) continue;
#endif
        u16* Od = (u16*)a.out + (dir ? (size_t)MLAT * 1024 : (size_t)0);
        float S[16];
#pragma unroll
        for (int e = 0; e < 16; ++e) S[e] = 0.f;
        const float alog = a.in[14][dir * 8 + h], dtb = a.in[15][dir * 8 + h];
        for (int n = 0; n < 4352; ++n) {
            int row; if (n < 256) { const int t = dir ? 255 - n : n; row = MLAT + b * 256 + t; } else { const int t = dir ? 4095 - (n - 256) : (n - 256); row = b * 4096 + t; }
            const float* bap = BA + (size_t)row * 32;
            const float beta = sigm_f(bap[dir * 8 + h]);
            const float xs = bap[16 + dir * 8 + h] + dtb;
            const float g = -__expf(alog) * (fmaxf(xs, 0.f) + log1pf(__expf(-fabsf(xs))));
            const float eg = __expf(g);
            const u16* kp = kd + (size_t)row * 1024 + h * 128 + kg * 16; const u16* qp = qd + (size_t)row * 1024 + h * 128 + kg * 16;
            float kk[16], qq[16];
#pragma unroll
            for (int e = 0; e < 16; ++e) { kk[e] = bf2f(kp[e]); qq[e] = bf2f(qp[e]); }
            const float v = bf2f(vd[(size_t)row * 1024 + h * 128 + half * 64 + dvl]);
            float ps = 0.f;
#pragma unroll
            for (int e = 0; e < 16; ++e) { S[e] *= eg; ps += kk[e] * S[e]; }
            red[kg * 64 + dvl] = ps;
            __syncthreads();
            float ks = 0.f;
#pragma unroll
            for (int g8 = 0; g8 < 8; ++g8) ks += red[g8 * 64 + dvl];
            __syncthreads();
            const float delta = beta * (v - ks);
            float po = 0.f;
#pragma unroll
            for (int e = 0; e < 16; ++e) { S[e] += kk[e] * delta; po += qq[e] * S[e]; }
            red[kg * 64 + dvl] = po;
            __syncthreads();
            if (n >= 256 && kg == 0) { float o = 0.f;
#pragma unroll
                for (int g8 = 0; g8 < 8; ++g8) o += red[g8 * 64 + dvl];
                Od[(size_t)row * 1024 + h * 128 + half * 64 + dvl] = f2bf(o); }
            __syncthreads();
        }
    }
}
#endif


#if defined(EXP_VALU_SCAN)
#define BR(x) bf2f(f2bf(x))
__device__ __forceinline__ void phase_dn_scan_valu(const Args& a, unsigned char* shm) {
    const int tid = tid_opaque(), dvl = tid & 63, rg = tid >> 6;
    float* S = (float*)shm; float* kc = S + 8192; float* qc = kc + 8192; float* rr = qc + 8192; float* vn = rr + 4096;
    const u16* qd = (const u16*)(a.ws + O_QD); const u16* kd = (const u16*)(a.ws + O_KD); const u16* vd = (const u16*)(a.ws + O_VD);
    const unsigned char* REC = a.ws + O_REC;
    for (int task = blockIdx.x; task < 256; task += gridDim.x) {
        const int half = task & 1, dir = (task >> 1) & 1, h = (task >> 2) & 7, b = task >> 5;
        u16* Od = (u16*)a.out + (dir ? (size_t)MLAT * 1024 : (size_t)0);
        for (int i = tid; i < 8192; i += 512) S[i] = 0.f;
        __syncthreads();
        for (int n = 0; n < 68; ++n) {
            const int c68 = n < 4 ? (dir ? 3 - n : n) : (dir ? 71 - n : n);
            const int base = c68 < 4 ? MLAT + b * 256 + c68 * 64 : b * 4096 + (c68 - 4) * 64;
            const unsigned char* rec = REC + (size_t)((((b * 8 + h) * 2 + dir) * 68) + c68) * REC_BYTES;
            const u16* Tb = (const u16*)rec; const u16* In = (const u16*)(rec + 8192); const float* rf = (const float*)(rec + 16384);
            for (int i = tid; i < 8192; i += 512) { const int p = i >> 7, dk = i & 127, t = dir ? 63 - p : p;
                kc[i] = bf2f(kd[(size_t)(base + t) * 1024 + h * 128 + dk]); qc[i] = bf2f(qd[(size_t)(base + t) * 1024 + h * 128 + dk]); }
            __syncthreads();
            float QS[8];
#pragma unroll
            for (int m = 0; m < 8; ++m) { const int i = rg + 8 * m, t = dir ? 63 - i : i; float ks = 0.f, qs = 0.f;
                for (int dk = 0; dk < 128; ++dk) { const float sv = BR(S[dk * 64 + dvl]); ks += kc[i * 128 + dk] * sv; qs += qc[i * 128 + dk] * sv; }
                QS[m] = qs; rr[i * 64 + dvl] = BR(bf2f(vd[(size_t)(base + t) * 1024 + h * 128 + half * 64 + dvl]) - rf[i] * ks); }
            __syncthreads();
#pragma unroll
            for (int m = 0; m < 8; ++m) { const int i = rg + 8 * m; float s = 0.f;
                for (int j = 0; j < 64; ++j) s += bf2f(Tb[i * 64 + j]) * rr[j * 64 + dvl];
                vn[i * 64 + dvl] = s; }
            __syncthreads();
#pragma unroll
            for (int m = 0; m < 8; ++m) { const int i = rg + 8 * m, t = dir ? 63 - i : i; float s = rf[i] * QS[m];
                for (int j = 0; j < 64; ++j) s += bf2f(In[i * 64 + j]) * BR(vn[j * 64 + dvl]);
                if (n >= 4) Od[(size_t)(base + t) * 1024 + h * 128 + half * 64 + dvl] = f2bf(s); }
            { const float d = rf[128];
#pragma unroll
                for (int e = 0; e < 16; ++e) { const int dk = rg * 16 + e; float s = d * S[dk * 64 + dvl];
                    for (int t = 0; t < 64; ++t) s += kc[t * 128 + dk] * BR(rf[64 + t] * vn[t * 64 + dvl]);
                    S[dk * 64 + dvl] = s; } }
            __syncthreads();
        }
    }
}
#endif

__device__ __forceinline__ void rope8(f32x4& v0, f32x4& v1, const f32x4 p0, const f32x4 p1, bool second, float pos, int f0) {
#pragma unroll
    for (int j = 0; j < 8; ++j) {
        const float invf = exp2f(-(float)(f0 + j) * (13.287712379549449f / 32.f));
        const float ang = pos * invf; const float c = __cosf(ang), s = __sinf(ang);
        const float mine = j < 4 ? v0[j & 3] : v1[j & 3], other = j < 4 ? p0[j & 3] : p1[j & 3];
        const float o = second ? (mine * c + other * s) : (mine * c - other * s);
        if (j < 4) v0[j & 3] = o; else v1[j & 3] = o;
    }
}
__device__ __forceinline__ void phase_attn_prep(const Args& a) {
    const int lane = tid_opaque() & 63, gw = blockIdx.x * 8 + (tid_opaque() >> 6), nw = gridDim.x * 8;
    u16* QA = (u16*)(a.ws + O_QA); const u16* KVA = (const u16*)(a.ws + O_KVA); u16* KALL = (u16*)(a.ws + O_KALL); u16* VALL = (u16*)(a.ws + O_VALL);
    const float* qn = a.in[18]; const float* kn = a.in[19];
    for (int row = gw; row < MALL; row += nw) {
        const bool lat = row < MLAT;
        const int t = lat ? (row & 4095) : ((row - MLAT) & 255); const int b = lat ? (row >> 12) : ((row - MLAT) >> 8);
        {
            const u16* kp = KVA + (size_t)row * 512 + 4 * lane;
            const u32x2 ku = *(const u32x2*)kp; const u32x2 vu = *(const u32x2*)(kp + 256);
            f32x4 kv = (f32x4){bf_lo(ku.x), bf_hi(ku.x), bf_lo(ku.y), bf_hi(ku.y)};
            const int d = 4 * (lane & 31);
            float ss = kv[0] * kv[0] + kv[1] * kv[1] + kv[2] * kv[2] + kv[3] * kv[3];
            ss = grp32_sum(ss); const float rs = rsqrtf(ss * (1.f / 128.f) + 1e-6f);
            kv = kv * rs * *(const f32x4*)(kn + d);
            f32x4 pp;
#pragma unroll
            for (int j = 0; j < 4; ++j) pp[j] = __shfl_xor(kv[j], 8);
            if (lat) { const bool second = (lane >> 3) & 1; const int axis = (lane >> 4) & 1; const float pos = axis ? (float)(t & 63) : (float)(t >> 6);
#pragma unroll
                for (int j = 0; j < 4; ++j) { const float invf = exp2f(-(float)((d & 31) + j) * (13.287712379549449f / 32.f)); const float ang = pos * invf; const float c = __cosf(ang), s = __sinf(ang);
                    kv[j] = second ? (kv[j] * c + pp[j] * s) : (kv[j] * c - pp[j] * s); } }
            const size_t orow = (size_t)b * 4352 + (lat ? 256 + t : t);
            u32x2 ko; ko.x = pk(kv[0], kv[1]); ko.y = pk(kv[2], kv[3]);
            *(u32x2*)(KALL + orow * 256 + 4 * lane) = ko; *(u32x2*)(VALL + orow * 256 + 4 * lane) = vu;
        }
    }
}

__device__ __forceinline__ void phase_attn(const Args& a, unsigned char* shm) {
    u16* QA = (u16*)(a.ws + O_QA); const u16* KALL = (const u16*)(a.ws + O_KALL); const u16* VALL = (const u16*)(a.ws + O_VALL);
    const int nblk = gridDim.x;
    for (int it = 0;; ++it) {
        int task;
        if (nblk == 256) { if (it >= 4) break; const int xcd = blockIdx.x & 7, slot = blockIdx.x >> 3; const int tix = it * 32 + slot; task = (xcd * 2 + (tix >> 6)) * 64 + (tix & 63); }
        else { task = blockIdx.x + it * nblk; if (task >= 1024) break; }
        const int grp = task >> 6, within = task & 63, b = grp >> 1, kvh = grp & 1, qb = within >> 2, g = within & 3, head = kvh * 4 + g;
        u16* Qb = QA + ((size_t)b * 4096 + qb * 256) * 1024 + head * 128;
        const u16* Kh = KALL + (size_t)b * 4352 * 256 + kvh * 128; const u16* Vh = VALL + (size_t)b * 4352 * 256 + kvh * 128;
        at::attn_dense_body<at::bf16>((const at::bf16*)Qb, (const at::bf16*)Kh, (const at::bf16*)Vh, Qb, 4352, (char*)shm, qb * 256, a.in[18]);
        __syncthreads();
    }
}

__device__ __forceinline__ void phase_merge_prep(const Args& a) {
    const int lane = tid_opaque() & 63, gw = blockIdx.x * 8 + (tid_opaque() >> 6), nw = gridDim.x * 8;
    const u16* OF = (const u16*)a.out; const u16* OB = OF + (size_t)MLAT * 1024; const u16* Z = (const u16*)(a.ws + O_Z); u16* A3 = (u16*)(a.ws + O_A3);
    const float* dnn = a.in[16];
    const int d = 8 * (lane & 15); const f32x4 g0 = *(const f32x4*)(dnn + d), g1 = *(const f32x4*)(dnn + d + 4);
    for (int row = gw; row < MLAT; row += nw) {
#pragma unroll
        for (int i = 0; i < 2; ++i) { const size_t off = (size_t)row * 1024 + 512 * i + 8 * lane;
            f32x4 f0, f1, b0, b1, z0, z1; unpk8(*(const u32x4*)(OF + off), f0, f1); unpk8(*(const u32x4*)(OB + off), b0, b1); unpk8(*(const u32x4*)(Z + off), z0, z1);
            f0 += b0; f1 += b1;
            float ss = 0.f;
#pragma unroll
            for (int j = 0; j < 4; ++j) ss += f0[j] * f0[j] + f1[j] * f1[j];
            ss = grp16_sum(ss); const float rs = rsqrtf(ss * (1.f / 128.f) + 1e-6f);
#pragma unroll
            for (int j = 0; j < 4; ++j) { f0[j] = f0[j] * rs * g0[j] * silu_f(z0[j]); f1[j] = f1[j] * rs * g1[j] * silu_f(z1[j]); }
            *(u32x4*)(A3 + off) = pk8(f0, f1); }
    }
}

__global__ void __launch_bounds__(512, 2) fwd_megakernel(Args a) {
    extern __shared__ __attribute__((aligned(16))) unsigned char shm[];
    cg::grid_group grid = cg::this_grid();
    volatile LAS unsigned* xst = (volatile LAS unsigned*)(shm + LDS_BYTES - 16);
    if (threadIdx.x == 0) { xst[0] = 0u; xst[1] = 0u; }
    __syncthreads();
    const xb::XcdBarrier XB = xb::xcd_barrier_post((unsigned*)(a.ws + O_BAR), xst);
#define GSYNC() xb::xcd_barrier(XB)
    unsigned char* ws = a.ws;
    grid.sync();
    const long gtid = (long)blockIdx.x * 512 + threadIdx.x, gth = (long)gridDim.x * 512;
    cvt_w<1>(a.in[8], 1024, 5632, (u16*)(ws + O_WGU1), 5632, gtid, gth);
    phase_mod(a, shm);
#if defined(EXP_SELFCHK)
    if (blockIdx.x == 0 && threadIdx.x == 0) *(unsigned*)(ws + O_MOD + 9 * 9216 * 4) = 0u;
#endif
    GSYNC();
    phase_h1(a);
    GSYNC();
    { EpiSwiglu E; E.O = (u16*)(ws + O_ACT); run_gemm(shm, (const u16*)(ws + O_A), (const u16*)(ws + O_WGU1), MALL, 5632, 1024, E); }
    { const int G = gridDim.x, rem = ((MALL / 256) * 22) % G;
      if (rem == 0 || (int)blockIdx.x >= rem) { const int f = rem == 0 ? 0 : rem; const long gt = (long)((int)blockIdx.x - f) * 512 + threadIdx.x, gn = (long)(G - f) * 512;
        cvt_w<0>(a.in[9], 2816, 1024, (u16*)(ws + O_WD1), 1024, gt, gn);
        cvt_w<2>(a.in[12], 1024, INW, (u16*)(ws + O_WIN1), 3328, gt, gn); } }
    GSYNC();
    { EpiPlain E; E.O = (u16*)(ws + O_Y1); E.ldc = 1024; run_gemm(shm, (const u16*)(ws + O_ACT), (const u16*)(ws + O_WD1), MLAT, 1024, 2816, E); }
    GSYNC();
    { EpiPlain E; E.O = (u16*)(ws + O_Y1) + (size_t)MLAT * 1024; E.ldc = 1024; run_gemm(shm, (const u16*)(ws + O_ACT) + (size_t)MLAT * FH, (const u16*)(ws + O_WD1), MCTX, 1024, 2816, E); }
    { const int G = gridDim.x, f = G > 32 ? 32 : 0;
      if ((int)blockIdx.x >= f) { const long gt = (long)((int)blockIdx.x - f) * 512 + threadIdx.x, gn = (long)(G - f) * 512;
        cvt_w<3>(a.in[12], 1024, INW, (u16*)(ws + O_WIN2), 4608, gt, gn); }
      phase_h2(a, 0, MLAT, f, G - f); }
    GSYNC();
    phase_h2(a, MLAT, MALL);
    GSYNC();
    { EpiIn1 E; E.q = (u16*)(ws + O_QRAW); E.k = (u16*)(ws + O_KRAW); E.v = (u16*)a.out; E.ba = (float*)(ws + O_BA); run_gemm(shm, (const u16*)(ws + O_A), (const u16*)(ws + O_WIN1), MALL, 3328, 1024, E); }
    GSYNC();
    phase_dn_prep(a);
    GSYNC();
#if defined(EXP_NAIVE_DN) && !defined(EXP_HYBRID)
    phase_dn_naive(a, shm);
#else
    phase_dn_pre(a, shm);
    GSYNC();
#if defined(EXP_VALU_SCAN)
    phase_dn_scan_valu(a, shm);
#else
    phase_dn_scan(a, shm);
#endif
#if defined(EXP_HYBRID)
    GSYNC();
    phase_dn_naive(a, shm);
#endif
#endif
    GSYNC();
    phase_h2(a);
    GSYNC();
    { EpiIn2 E; E.z = (u16*)(ws + O_Z); E.qa = (u16*)(ws + O_QA); E.kva = (u16*)(ws + O_KVA); E.gates = (u16*)(ws + O_GATES); run_gemm(shm, (const u16*)(ws + O_A), (const u16*)(ws + O_WIN2), MALL, 4608, 1024, E); }
    { const int G = gridDim.x, rem = ((MALL / 256) * 18) % G;
      if (rem == 0 || (int)blockIdx.x >= rem) { const int f = rem == 0 ? 0 : rem; const long gt = (long)((int)blockIdx.x - f) * 512 + threadIdx.x, gn = (long)(G - f) * 512;
        cvt_w<0>(a.in[17], 1024, 1024, (u16*)(ws + O_WDN), 1024, gt, gn);
        cvt_w<0>(a.in[20], 1024, 1024, (u16*)(ws + O_WAT), 1024, gt, gn);
        cvt_w<0>(a.in[21], 1024, 1024, (u16*)(ws + O_WOUT), 1024, gt, gn);
        cvt_w<1>(a.in[24], 1024, 5632, (u16*)(ws + O_WGU2), 5632, gt, gn);
        cvt_w<0>(a.in[25], 2816, 1024, (u16*)(ws + O_WD2), 1024, gt, gn); } }
    GSYNC();
    phase_attn_prep(a);
    GSYNC();
    phase_attn(a, shm);
    GSYNC();
    phase_merge_prep(a);
    GSYNC();
    { EpiMerge<0> E; E.gates = (const u16*)(ws + O_GATES); E.T = (u16*)(ws + O_T); run_gemm(shm, (const u16*)(ws + O_A3), (const u16*)(ws + O_WDN), MLAT, 1024, 1024, E); }
    { EpiMerge<1> E; E.gates = (const u16*)(ws + O_GATES); E.T = (u16*)(ws + O_T); run_gemm(shm, (const u16*)(ws + O_QA), (const u16*)(ws + O_WAT), MLAT, 1024, 1024, E); }
    GSYNC();
    { EpiPlain E; E.O = (u16*)(ws + O_Y); E.ldc = 1024; run_gemm(shm, (const u16*)(ws + O_T), (const u16*)(ws + O_WOUT), MLAT, 1024, 1024, E); }
    GSYNC();
    phase_h3(a);
    GSYNC();
    { EpiSwiglu E; E.O = (u16*)(ws + O_ACT2); run_gemm(shm, (const u16*)(ws + O_A5), (const u16*)(ws + O_WGU2), MLAT, 5632, 1024, E); }
    GSYNC();
    { EpiPlain E; E.O = (u16*)(ws + O_Y2); E.ldc = 1024; run_gemm(shm, (const u16*)(ws + O_ACT2), (const u16*)(ws + O_WD2), MLAT, 1024, 2816, E); }
    GSYNC();
    phase_out(a);
#if defined(EXP_SELFCHK)
    GSYNC();
    if (blockIdx.x == 0 && threadIdx.x == 0) { const unsigned f = *(volatile unsigned*)(ws + O_MOD + 9 * 9216 * 4);
        if (f & 8u) a.out[0] += 6.2e6f; if (f & 4u) a.out[1] += 6.2e5f; if (f & 2u) a.out[2] += 6.2e4f; if (f & 1u) a.out[3] += 6.2e3f; }
#endif
}

extern "C" void kernel_launch(void* const* d_in, const int* in_sizes, int n_in, void* d_out, int out_size, void* d_ws, size_t ws_size, hipStream_t stream) {
    static int grid_blocks = 0;
    if (grid_blocks == 0) {
        if (n_in != 26 || out_size != MLAT * 1024 || ws_size < WS_NEED) { fprintf(stderr, "kernel_launch: unexpected shapes: n_in %d out %d ws %zu (need %zu)\n", n_in, out_size, ws_size, (size_t)WS_NEED); grid_blocks = -1; return; }
        int dev = 0, cus = 0, per_cu = 0;
        hipGetDevice(&dev);
        hipDeviceGetAttribute(&cus, hipDeviceAttributeMultiprocessorCount, dev);
        if (hipFuncSetAttribute((const void*)fwd_megakernel, hipFuncAttributeMaxDynamicSharedMemorySize, LDS_BYTES) != hipSuccess) { fprintf(stderr, "kernel_launch: hipFuncSetAttribute failed\n"); grid_blocks = -1; return; }
        if (hipOccupancyMaxActiveBlocksPerMultiprocessor(&per_cu, (const void*)fwd_megakernel, 512, LDS_BYTES) != hipSuccess || per_cu < 1) { fprintf(stderr, "kernel_launch: occupancy query failed (%d)\n", per_cu); (void)hipGetLastError(); per_cu = 1; }
        grid_blocks = cus * per_cu;
    }
    if (grid_blocks < 0) return;
    if (hipMemsetAsync((char*)d_ws + O_BAR, 0, XCD_BAR_WORDS * sizeof(unsigned), stream) != hipSuccess) { fprintf(stderr, "kernel_launch: memset of the barrier words failed\n"); return; }
    Args a{};
    for (int i = 0; i < 26; ++i) a.in[i] = (const float*)d_in[i];
    a.out = (float*)d_out; a.ws = (unsigned char*)d_ws;
    void* args[] = {&a};
    hipError_t e = hipLaunchCooperativeKernel((const void*)fwd_megakernel, dim3(grid_blocks), dim3(512), args, LDS_BYTES, stream);
    if (e != hipSuccess) fprintf(stderr, "cooperative launch failed: %s (grid %d)\n", hipGetErrorString(e), grid_blocks);
}
```

```cpp
#include <hip/hip_runtime.h>
#include <hip/hip_bf16.h>
#include <hip/hip_cooperative_groups.h>
#include <cstdio>
#include <cstdint>
namespace cg = cooperative_groups;
__device__ __forceinline__ int tid_opaque() { int t = threadIdx.x; asm volatile("" : "+v"(t)); return t; }
namespace pg8 {
#define PG8_LAS __attribute__((address_space(3)))
typedef unsigned short bf16_t;
typedef short bf16x8 __attribute__((ext_vector_type(8)));
typedef float f32x4 __attribute__((ext_vector_type(4)));
typedef unsigned u32x4 __attribute__((ext_vector_type(4)));
constexpr int BM = 256, BK = 64, HALF = 128, HTB = HALF * BK * 2  , STAGE_BYTES = 8 * HTB, NXCD = 8, WGM = 8;

__host__ __device__ __forceinline__ int lds_byte(int r, int c) { const int st = (r >> 4) * 2 + (c >> 5), rr = r & 15, cc = c & 31, ob = rr * 64 + cc * 2; return st * 1024 + (ob ^ (((ob >> 9) & 1) << 5)); }
__host__ __device__ __forceinline__ void stage_rc(int b, int& R, int& C) { const int st = b / 1024, sb = b % 1024, swz = sb ^ (((sb >> 9) & 1) << 5); R = (st >> 1) * 16 + swz / 64; C = (st & 1) * 32 + (swz % 64) / 2; }
__host__ __device__ __forceinline__ int perm32(int rho) { const int n = rho >> 4, i = rho & 15; return 8 * (i >> 2) + 4 * n + (i & 3); }

struct Unit { int pm, pn; };
struct Gemm { const bf16_t* A; const bf16_t* Bt; int M, N, K; };

struct StaticOrder {
    int nM, nN, nwg, G, c;
    __host__ __device__ void init(int M, int N, int G_, int c_) { nM = M / BM; nN = N / BM; nwg = nM * nN; G = G_; c = c_; }
    __host__ __device__ bool next(int i, Unit& u) const {
        const long L = (long)i * G + c; if (L >= nwg) return false;
        int wgid = (int)L; { const int q = nwg / NXCD, r = nwg % NXCD, xcd = wgid % NXCD, off = wgid / NXCD; wgid = (xcd < r ? xcd * (q + 1) : r * (q + 1) + (xcd - r) * q) + off; }
        const int nig = WGM * nN, gid = wgid / nig, fm = gid * WGM, gsz = (nM - fm) < WGM ? (nM - fm) : WGM;
        u.pm = fm + ((wgid % nig) % gsz); u.pn = (wgid % nig) / gsz; return true;
    }
    __device__ __forceinline__ void a_ready(const Unit&) const {}
    __device__ __forceinline__ void done(const Unit&) const {}
};
__device__ __forceinline__ unsigned cvt_pk_bf16(float lo, float hi) { unsigned r; asm volatile("v_cvt_pk_bf16_f32 %0, %1, %2" : "=v"(r) : "v"(lo), "v"(hi)); return r; }

template <class Epi, class Sched, bool STAMP = false>
__device__ __forceinline__ void gemm_phase(PG8_LAS unsigned char* lds, const Gemm g, const Sched& S, const Epi& E, unsigned long long* stamps) {
    const int tid = tid_opaque(), wid = __builtin_amdgcn_readfirstlane(tid >> 6), lane = tid & 63, wr = wid >> 2, wc = wid & 3, fr = lane & 15, fq = lane >> 4;
    const int K = g.K, nt = K / BK;
    int ts_lo = 0, ts_hi = 0, nts = 0; const unsigned long long rt_entry = STAMP ? (unsigned long long)wall_clock64() : 0ull;
#define PG8_STAMP() do { if (STAMP && wid == 0 && nts < 64) { const unsigned long long _c = (unsigned long long)clock64(); \
        ts_lo = (lane == nts) ? (int)(unsigned)_c : ts_lo; ts_hi = (lane == nts) ? (int)(unsigned)(_c >> 32) : ts_hi; ++nts; } } while (0)
    PG8_STAMP();
    unsigned voffA[2], voffB[2];
#pragma unroll
    for (int i = 0; i < 2; ++i) { int R, C; stage_rc(tid * 16 + i * 8192, R, C); const int Rb = Epi::PERM ? ((R & ~31) + perm32(R & 31)) : R;
        voffA[i] = (unsigned)(R * K + C) * 2u; voffB[i] = (unsigned)(Rb * K + C) * 2u; }
    const size_t kstep = (size_t)(BK * 2);
    const size_t hstep = (size_t)HALF * K * 2;
    const size_t tstep = 2 * hstep;
    const unsigned ldsw = (unsigned)wid * 1024u;
    const int aoff = lds_byte(wr * 64 + fr, fq * 8), boff = lds_byte(wc * 32 + fr, fq * 8);
#define PG8_SA(b, h) (((b) * 2 + (h)) * HTB)
#define PG8_SB(b, h) ((4 + (b) * 2 + (h)) * HTB)
#define PG8_STAGE(bufoff, gbase, voff) do { _Pragma("unroll") for (int _i = 0; _i < 2; ++_i) \
        __builtin_amdgcn_global_load_lds((const unsigned*)((const char*)(gbase) + (voff)[_i]), (PG8_LAS unsigned*)(lds + (bufoff) + ldsw + _i * 8192), 16, 0, 0); } while (0)
#define PG8_LDA(dst, b, h) do { _Pragma("unroll") for (int m = 0; m < 4; ++m) _Pragma("unroll") for (int k = 0; k < 2; ++k) dst[m][k] = *(const PG8_LAS bf16x8*)(lds + PG8_SA(b, h) + aoff + m * 2048 + k * 1024); } while (0)
#define PG8_LDB(dst, b, h) do { _Pragma("unroll") for (int n = 0; n < 2; ++n) _Pragma("unroll") for (int k = 0; k < 2; ++k) dst[n][k] = *(const PG8_LAS bf16x8*)(lds + PG8_SB(b, h) + boff + n * 2048 + k * 1024); } while (0)
#define PG8_MMA(ai, bj, At, Bt) do { __builtin_amdgcn_s_setprio(1); _Pragma("unroll") for (int m = 0; m < 4; ++m) _Pragma("unroll") for (int n = 0; n < 2; ++n) _Pragma("unroll") for (int k = 0; k < 2; ++k) \
        acc[ai][bj][m][n] = __builtin_amdgcn_mfma_f32_16x16x32_bf16(Bt[n][k], At[m][k], acc[ai][bj][m][n], 0, 0, 0); __builtin_amdgcn_s_setprio(0); } while (0)
#define PG8_WAIT_V(n) asm volatile("s_waitcnt vmcnt(" #n ")" ::: "memory")
#define PG8_WAIT_L(n) asm volatile("s_waitcnt lgkmcnt(" #n ")" ::: "memory")
#define PG8_BAR __builtin_amdgcn_s_barrier()
#define PG8_SCHED __builtin_amdgcn_sched_barrier(0)
    Unit cur, nxt; int ui = 0;
    if (!S.next(0, cur)) return;
    f32x4 acc[2][2][4][2];
#pragma unroll
    for (int a = 0; a < 2; ++a)
#pragma unroll
        for (int b = 0; b < 2; ++b)
#pragma unroll
            for (int m = 0; m < 4; ++m)
#pragma unroll
                for (int n = 0; n < 2; ++n) acc[a][b][m][n] = (f32x4){0.f, 0.f, 0.f, 0.f};
    bf16x8 At[4][2], B0[2][2], B1[2][2];
    const char* cA = (const char*)g.A + (size_t)cur.pm * tstep; const char* cB = (const char*)g.Bt + (size_t)cur.pn * tstep;
    S.a_ready(cur);
    PG8_STAGE(PG8_SB(0, 0), cB, voffB); PG8_STAGE(PG8_SA(0, 0), cA, voffA); PG8_STAGE(PG8_SB(0, 1), cB + hstep, voffB); PG8_STAGE(PG8_SA(0, 1), cA + hstep, voffA);
    if (wr == 1) PG8_BAR;
    PG8_WAIT_V(4); PG8_BAR;
    PG8_STAGE(PG8_SB(1, 0), cB + kstep, voffB); PG8_STAGE(PG8_SA(1, 0), cA + kstep, voffA); PG8_STAGE(PG8_SB(1, 1), cB + hstep + kstep, voffB);
    PG8_WAIT_V(6); PG8_BAR;
    PG8_STAMP();
    for (;;) {
        const bool has_next = S.next(ui + 1, nxt);
        const char* nA = has_next ? (const char*)g.A + (size_t)nxt.pm * tstep : cA; const char* nB = has_next ? (const char*)g.Bt + (size_t)nxt.pn * tstep : cB;
        for (int t = 0; t < nt; t += 2) {
            const bool last = (t == nt - 2);
            const char* a1 = cA + (size_t)(t + 1) * kstep;
            const char* a2 = last ? nA : cA + (size_t)(t + 2) * kstep; const char* b2 = last ? nB : cB + (size_t)(t + 2) * kstep;
            const char* a3 = a2 + kstep; const char* b3 = b2 + kstep;
            if (last && has_next) S.a_ready(nxt);
            PG8_LDB(B0, 0, 0); PG8_SCHED; PG8_LDA(At, 0, 0); PG8_STAGE(PG8_SA(1, 1), a1 + hstep, voffA);
            PG8_WAIT_L(8); PG8_BAR; PG8_WAIT_L(0); PG8_MMA(0, 0, At, B0); PG8_BAR; PG8_SCHED;
            PG8_LDB(B1, 0, 1); PG8_STAGE(PG8_SB(0, 0), b2, voffB);
            PG8_BAR; PG8_WAIT_L(0); PG8_MMA(0, 1, At, B1); PG8_BAR;
            PG8_LDA(At, 0, 1); PG8_STAGE(PG8_SA(0, 0), a2, voffA);
            PG8_BAR; PG8_WAIT_L(0); PG8_MMA(1, 0, At, B0); PG8_BAR; PG8_SCHED;
            PG8_STAGE(PG8_SB(0, 1), b2 + hstep, voffB);
            PG8_WAIT_V(6); PG8_BAR; PG8_MMA(1, 1, At, B1); PG8_BAR;
            PG8_LDB(B0, 1, 0); PG8_SCHED; PG8_LDA(At, 1, 0); PG8_STAGE(PG8_SA(0, 1), a2 + hstep, voffA);
            PG8_WAIT_L(8); PG8_BAR; PG8_WAIT_L(0); PG8_MMA(0, 0, At, B0); PG8_BAR; PG8_SCHED;
            PG8_LDB(B1, 1, 1); PG8_STAGE(PG8_SB(1, 0), b3, voffB);
            PG8_BAR; PG8_WAIT_L(0); PG8_MMA(0, 1, At, B1); PG8_BAR;
            PG8_LDA(At, 1, 1); PG8_STAGE(PG8_SA(1, 0), a3, voffA);
            PG8_BAR; PG8_WAIT_L(0); PG8_MMA(1, 0, At, B0); PG8_BAR; PG8_SCHED;
            PG8_STAGE(PG8_SB(1, 1), b3 + hstep, voffB);
            PG8_WAIT_V(6); PG8_BAR; PG8_MMA(1, 1, At, B1); PG8_BAR;
        }
        PG8_STAMP();
        if constexpr (!Epi::AFTER_DRAIN) { E(acc, cur, wr, wc, fr, fq); S.done(cur); }
        PG8_STAMP();
        if (!has_next) break;
#pragma unroll
        for (int a = 0; a < 2; ++a)
#pragma unroll
            for (int b = 0; b < 2; ++b)
#pragma unroll
                for (int m = 0; m < 4; ++m)
#pragma unroll
                    for (int n = 0; n < 2; ++n) acc[a][b][m][n] = (f32x4){0.f, 0.f, 0.f, 0.f};
        cur = nxt; cA = nA; cB = nB; ++ui;
    }
    PG8_WAIT_V(0);
    if (wr == 0) PG8_BAR;
    PG8_BAR;
    if constexpr (Epi::AFTER_DRAIN) { E.fused(acc, cur, wr, wc, fr, fq, lds, wid, lane); S.done(cur); }
    PG8_STAMP();
    if (STAMP && wid == 0) { stamps[lane] = lane < nts ? (((unsigned long long)(unsigned)ts_hi << 32) | (unsigned)ts_lo) : 0ull;
        if (lane == 62) stamps[62] = rt_entry; if (lane == 63) stamps[63] = (unsigned long long)wall_clock64(); }
#undef PG8_STAMP
#undef PG8_SA
#undef PG8_SB
#undef PG8_STAGE
#undef PG8_LDA
#undef PG8_LDB
#undef PG8_MMA
#undef PG8_WAIT_V
#undef PG8_WAIT_L
#undef PG8_BAR
#undef PG8_SCHED
}
}
namespace xb {

#define XB_TMO      128
#define XB_XCNT(j)  (256  + 64 * (j))
#define XB_XSUB(j)  (1280 + 64 * (j))
#define XB_XGEN(j)  (2304 + 64 * (j))
#define XB_TOP      3328
#define XB_TOPGEN   3392
#define XCD_BAR_WORDS 3456
#define XB_SPIN_CAP (1u << 18)
#define LAS __attribute__((address_space(3)))

__device__ __forceinline__ unsigned xb_ld(unsigned* p)              { return __hip_atomic_load(p, __ATOMIC_RELAXED, __HIP_MEMORY_SCOPE_AGENT); }
__device__ __forceinline__ unsigned xb_add(unsigned* p, unsigned v) { return __hip_atomic_fetch_add(p, v, __ATOMIC_RELAXED, __HIP_MEMORY_SCOPE_AGENT); }
__device__ __forceinline__ unsigned xb_xcc_id() { return (unsigned)__builtin_amdgcn_s_getreg((3 << 11) | 20) & 0xFu; }
#define XB_SPIN(cond, bar) do { unsigned _sp = 0; while (cond) { __builtin_amdgcn_s_sleep(1); \
    if ((++_sp & 255u) == 0u) { if (xb_ld(&(bar)[XB_TMO])) break; if (_sp > XB_SPIN_CAP) { atomicAdd(&(bar)[XB_TMO], 1u); break; } } } } while (0)

struct XcdBarrier {
    unsigned* bar; unsigned x;
    volatile LAS unsigned* st;
};

__device__ __forceinline__ XcdBarrier xcd_barrier_post(unsigned* bar, volatile LAS unsigned* st) {
    XcdBarrier b; b.bar = bar; b.x = xb_xcc_id(); b.st = st;
    if (threadIdx.x == 0) (void)xb_add(&bar[XB_XCNT(b.x)], 1u);
    return b;
}
__device__ __forceinline__ void xcd_barrier_complete(unsigned* bar, unsigned x, unsigned& nloc, unsigned& nx) {
    const unsigned G = gridDim.x * gridDim.y * gridDim.z;
    unsigned sum, cnt, mine, sp = 0u;
    for (;;) {
        sum = 0u; cnt = 0u; mine = 0u;
#pragma unroll
        for (unsigned j = 0; j < 16; ++j) { const unsigned c = xb_ld(&bar[XB_XCNT(j)]); sum += c; cnt += (c > 0u) ? 1u : 0u; mine = (j == x) ? c : mine; }
        if (sum == G) break;
        __builtin_amdgcn_s_sleep(1);
        if ((++sp & 255u) == 0u) { if (xb_ld(&bar[XB_TMO])) break; if (sp > XB_SPIN_CAP) { atomicAdd(&bar[XB_TMO], 1u); break; } }
    }
    nloc = mine > 0u ? mine : 1u; nx = cnt > 0u ? cnt : 1u;
}

__device__ __forceinline__ void xcd_barrier(const XcdBarrier& b) {
    asm volatile("s_waitcnt vmcnt(0)" ::: "memory");
    __syncthreads();
    if (threadIdx.x == 0) {
        unsigned* bar = b.bar;
        __builtin_amdgcn_s_waitcnt(0);
        unsigned nloc = b.st[0], nx = b.st[1];
        if (nloc == 0u) { xcd_barrier_complete(bar, b.x, nloc, nx); b.st[0] = nloc; b.st[1] = nx; }
        const unsigned old = xb_add(&bar[XB_XSUB(b.x)], 1u);
        const unsigned gen = old / nloc;
        if (old + 1u == (gen + 1u) * nloc) {
            __builtin_amdgcn_fence(__ATOMIC_RELEASE, "agent");
            asm volatile("s_waitcnt vmcnt(0)" ::: "memory");
            const unsigned og = xb_add(&bar[XB_TOP], 1u);
            const unsigned tg = og / nx;
            if (og + 1u == (tg + 1u) * nx) xb_add(&bar[XB_TOPGEN], 1u);
            else XB_SPIN(xb_ld(&bar[XB_TOPGEN]) == tg, bar);
            __builtin_amdgcn_fence(__ATOMIC_ACQUIRE, "agent");
            xb_add(&bar[XB_XGEN(b.x)], 1u);
            asm volatile("s_waitcnt vmcnt(0)" ::: "memory");
        } else {
            XB_SPIN(xb_ld(&bar[XB_XGEN(b.x)]) == gen, bar);
            __builtin_amdgcn_fence(__ATOMIC_ACQUIRE, "agent");
            asm volatile("s_waitcnt vmcnt(0)" ::: "memory");
        }
    }
    __syncthreads();
}

}
namespace at {
using bf16 = __hip_bfloat16;
constexpr int   D = 128, NW = 8, QBLK = 32, KVBLK = 64;
constexpr float SCALE = 0.088388347648318440f;
constexpr float THR = 8.f;
constexpr int SDEPTH = 1;
constexpr int LDQ = 1024, LDK = 256, LDO = 1024;
constexpr size_t SHM_V = KVBLK * D * 2, SHM_K = KVBLK * D * 2, SHM_ATTN = 2 * SHM_V + 2 * SHM_K + NW * 64 * 4;
__device__ __forceinline__ unsigned short f2bf_rne(float f) { unsigned u = __float_as_uint(f); u += 0x7FFFu + ((u >> 16) & 1u); return (unsigned short)(u >> 16); }
using bf16x8 = __attribute__((ext_vector_type(8))) short;
using s16x4  = __attribute__((ext_vector_type(4))) short;
using f32x16 = __attribute__((ext_vector_type(16))) float;
using f32x8  = __attribute__((ext_vector_type(8))) float;
using u32x4  = __attribute__((ext_vector_type(4))) unsigned;
#define KSWZ(row, colB) ((row) * 256 + ((colB) ^ (((row) & 7) << 4)))
#define SBAR() __builtin_amdgcn_sched_barrier(0)
__device__ __forceinline__ int crow(int r, int hi) { return (r & 3) + 8 * (r >> 2) + 4 * hi; }
__device__ __forceinline__ unsigned cvtpk(float lo, float hi) {
  unsigned r; asm volatile("v_cvt_pk_bf16_f32 %0, %1, %2" : "=v"(r) : "v"(lo), "v"(hi)); return r;
}
template <typename TIn> struct Stage;
template <> struct Stage<bf16>  { using T = bf16x8;
  __device__ static __forceinline__ T ld8(const bf16* p) { return *reinterpret_cast<const bf16x8*>(p); }
  __device__ static __forceinline__ bf16x8 tobf(T x) { return x; } };
template <> struct Stage<float> { using T = f32x8;
  __device__ static __forceinline__ T ld8(const float* p) { return *reinterpret_cast<const f32x8*>(p); }
  __device__ static __forceinline__ bf16x8 tobf(T x) {
    u32x4 w = {cvtpk(x[0], x[1]), cvtpk(x[2], x[3]), cvtpk(x[4], x[5]), cvtpk(x[6], x[7])}; return *reinterpret_cast<bf16x8*>(&w); } };

__device__ __forceinline__ void partialSM(f32x16& p0, f32x16& p1, float& m_reg, float& mn, float& alpha) {
  constexpr float C = SCALE * 1.4426950408889634f;
  float pmax = p0[0]; for (int r = 1; r < 16; ++r) pmax = fmaxf(pmax, p0[r]); for (int r = 0; r < 16; ++r) pmax = fmaxf(pmax, p1[r]);
  { auto rr = __builtin_amdgcn_permlane32_swap(__float_as_uint(pmax), __float_as_uint(pmax), false, false);
    pmax = fmaxf(__uint_as_float(rr[0]), __uint_as_float(rr[1])); }
  if (__builtin_expect(__all(pmax - m_reg <= THR / SCALE), 1)) { mn = m_reg; alpha = 1.f; }
  else { mn = fmaxf(m_reg, pmax); alpha = __builtin_amdgcn_exp2f((m_reg - mn) * C); m_reg = mn; }
  float mnC = -mn * C;
  for (int r = 0; r < 16; ++r) p0[r] = fmaf(p0[r], C, mnC); for (int r = 0; r < 16; ++r) p1[r] = fmaf(p1[r], C, mnC);
  for (int r = 0; r < 16; ++r) p0[r] = __builtin_amdgcn_exp2f(p0[r]);
}
__device__ __forceinline__ void finishSM(f32x16& p0, f32x16& p1, float alpha, float& l_reg, bf16x8& pa0, bf16x8& pa1, bf16x8& pa2, bf16x8& pa3) {
  for (int r = 0; r < 16; ++r) p1[r] = __builtin_amdgcn_exp2f(p1[r]);
  float ps = 0; for (int r = 0; r < 16; ++r) ps += p0[r]; for (int r = 0; r < 16; ++r) ps += p1[r];
  { auto rr = __builtin_amdgcn_permlane32_swap(__float_as_uint(ps), __float_as_uint(ps), false, false);
    ps = __uint_as_float(rr[0]) + __uint_as_float(rr[1]); }
  l_reg = l_reg * alpha + ps;
#define PK4(P, BASE, OUT) do { unsigned a0 = cvtpk(P[BASE + 0], P[BASE + 1]), a1 = cvtpk(P[BASE + 2], P[BASE + 3]);   \
    unsigned b0 = cvtpk(P[BASE + 4], P[BASE + 5]), b1 = cvtpk(P[BASE + 6], P[BASE + 7]);                              \
    auto r0 = __builtin_amdgcn_permlane32_swap(a0, b0, false, false); auto r1 = __builtin_amdgcn_permlane32_swap(a1, b1, false, false); \
    u32x4 w = {r0[0], r1[0], r0[1], r1[1]}; OUT = *reinterpret_cast<bf16x8*>(&w); } while (0)
  PK4(p0, 0, pa0); PK4(p0, 8, pa1); PK4(p1, 0, pa2); PK4(p1, 8, pa3);
#undef PK4
}
__device__ __forceinline__ void qkt(f32x16& p0, f32x16& p1, const bf16* Ks, const bf16x8* qr, int r32, int hi) {
  p0 = f32x16{}; p1 = f32x16{};
  for (int d0 = 0; d0 < 8; ++d0) { int cb = (d0 * 16 + hi * 8) * 2;
    bf16x8 b0 = *reinterpret_cast<const bf16x8*>((const char*)Ks + KSWZ(r32, cb));
    bf16x8 b1 = *reinterpret_cast<const bf16x8*>((const char*)Ks + KSWZ(32 + r32, cb));
    p0 = __builtin_amdgcn_mfma_f32_32x32x16_bf16(b0, qr[d0], p0, 0, 0, 0);
    p1 = __builtin_amdgcn_mfma_f32_32x32x16_bf16(b1, qr[d0], p1, 0, 0, 0); }
}
__device__ __forceinline__ int v_st(int k, int c) { const int kk = (k & ~0xC) | ((k & 4) << 1) | ((k & 8) >> 1); return ((kk >> 3) * 4 + (c >> 5)) * 512 + ((kk & 7) * 32 + (c & 31)) * 2; }
__device__ __forceinline__ int v_rd_base(int lane) { return ((lane & 3) << 3) | (((lane >> 2) & 3) << 6) | (((lane >> 4) & 1) << 5) | (((lane >> 5) & 1) << 8); }
constexpr int v_rd_off(int d0, int ks, int half) { return d0 * 512 + ks * 4096 + half * 2048; }
template <int OFF> __device__ __forceinline__ s16x4 tr_read(int vb) {
  s16x4 r; asm volatile("ds_read_b64_tr_b16 %0, %1 offset:%2" : "=&v"(r) : "v"(vb), "i"(OFF) : "memory"); return r;
}
template <int D0> __device__ __forceinline__ void pv_one(f32x16& od, int vb, bf16x8 pa0, bf16x8 pa1, bf16x8 pa2, bf16x8 pa3) {
  const s16x4 l0 = tr_read<v_rd_off(D0, 0, 0)>(vb), h0 = tr_read<v_rd_off(D0, 0, 1)>(vb), l1 = tr_read<v_rd_off(D0, 1, 0)>(vb), h1 = tr_read<v_rd_off(D0, 1, 1)>(vb);
  const s16x4 l2 = tr_read<v_rd_off(D0, 2, 0)>(vb), h2 = tr_read<v_rd_off(D0, 2, 1)>(vb), l3 = tr_read<v_rd_off(D0, 3, 0)>(vb), h3 = tr_read<v_rd_off(D0, 3, 1)>(vb);
  asm volatile("s_waitcnt lgkmcnt(0)" ::: "memory"); SBAR();
#define PK(L, H) (bf16x8){L[0], L[1], L[2], L[3], H[0], H[1], H[2], H[3]}
  od = __builtin_amdgcn_mfma_f32_32x32x16_bf16(pa0, PK(l0, h0), od, 0, 0, 0);
  od = __builtin_amdgcn_mfma_f32_32x32x16_bf16(pa1, PK(l1, h1), od, 0, 0, 0);
  od = __builtin_amdgcn_mfma_f32_32x32x16_bf16(pa2, PK(l2, h2), od, 0, 0, 0);
  od = __builtin_amdgcn_mfma_f32_32x32x16_bf16(pa3, PK(l3, h3), od, 0, 0, 0);
#undef PK
}
__device__ __forceinline__ void pv_d0(f32x16* o, int vb, bf16x8 pa0, bf16x8 pa1, bf16x8 pa2, bf16x8 pa3) {
  pv_one<0>(o[0], vb, pa0, pa1, pa2, pa3); pv_one<1>(o[1], vb, pa0, pa1, pa2, pa3); pv_one<2>(o[2], vb, pa0, pa1, pa2, pa3); pv_one<3>(o[3], vb, pa0, pa1, pa2, pa3);
}

template <typename TQ>
__device__ __forceinline__ void attn_dense_body(const TQ* __restrict__ Qb, const bf16* __restrict__ Kh, const bf16* __restrict__ Vh,
                                                unsigned short* Ob, int seq, char* lds, int t_base, const float* __restrict__ qn) {
  using St = Stage<bf16>; using SQ = Stage<TQ>;
  const int tid = tid_opaque(), wid = tid >> 6, lane = tid & 63, r32 = lane & 31, hi = lane >> 5;
  bf16* V_lds = (bf16*)lds; bf16* K_lds = (bf16*)(lds + 2 * SHM_V);
  float* ws = (float*)(lds + 2 * SHM_V + 2 * SHM_K) + wid * 64; float* li_l = ws; float* al_l = ws + 32;
  float m_reg = -1e30f, l_reg = 0; f32x16 o[4] = {}; bf16x8 qr[8];
  const TQ* Qw = Qb + (long)(wid * QBLK + r32) * LDQ + hi * 8;
#pragma unroll
  for (int d0 = 0; d0 < 8; ++d0) qr[d0] = SQ::tobf(SQ::ld8(Qw + d0 * 16));
  {
    const int tq = t_base + wid * QBLK + r32;
    float v[8][8]; float ss = 0.f;
#pragma unroll
    for (int d0 = 0; d0 < 8; ++d0)
#pragma unroll
      for (int j = 0; j < 8; ++j) { v[d0][j] = __uint_as_float(((unsigned)(unsigned short)qr[d0][j]) << 16); ss += v[d0][j] * v[d0][j]; }
    ss += __shfl_xor(ss, 32);
    const float rs = rsqrtf(ss * (1.f / 128.f) + 1e-6f);
#pragma unroll
    for (int d0 = 0; d0 < 8; ++d0) { const float4 g0 = *reinterpret_cast<const float4*>(qn + d0 * 16 + hi * 8), g1 = *reinterpret_cast<const float4*>(qn + d0 * 16 + hi * 8 + 4);
      v[d0][0] *= rs * g0.x; v[d0][1] *= rs * g0.y; v[d0][2] *= rs * g0.z; v[d0][3] *= rs * g0.w; v[d0][4] *= rs * g1.x; v[d0][5] *= rs * g1.y; v[d0][6] *= rs * g1.z; v[d0][7] *= rs * g1.w; }
#pragma unroll
    for (int ax = 0; ax < 2; ++ax) { const float pos = ax ? (float)(tq & 63) : (float)(tq >> 6);
#pragma unroll
      for (int e = 0; e < 2; ++e)
#pragma unroll
        for (int j = 0; j < 8; ++j) { const int f = e * 16 + hi * 8 + j; const float ang = pos * exp2f(-(float)f * (13.287712379549449f / 32.f)); const float c = __cosf(ang), s = __sinf(ang);
          const float x1 = v[ax * 4 + e][j], x2 = v[ax * 4 + 2 + e][j]; v[ax * 4 + e][j] = x1 * c - x2 * s; v[ax * 4 + 2 + e][j] = x2 * c + x1 * s; } }
#pragma unroll
    for (int d0 = 0; d0 < 8; ++d0) { u32x4 w = {cvtpk(v[d0][0], v[d0][1]), cvtpk(v[d0][2], v[d0][3]), cvtpk(v[d0][4], v[d0][5]), cvtpk(v[d0][6], v[d0][7])}; qr[d0] = *reinterpret_cast<bf16x8*>(&w); }
  }
  const int sr = tid >> 4, sc = (tid & 15) * 8, vst0 = v_st(sr, sc), vst1 = v_st(32 + sr, sc);
  const int vb0 = (int)(uintptr_t)V_lds + v_rd_base(lane);
  struct { typename St::T vs0, vs1, ks0, ks1; } sr_[SDEPTH];
#define SLOAD(i, k0) do { sr_[i].vs0 = St::ld8(&Vh[(long)((k0) + sr) * LDK + sc]); sr_[i].vs1 = St::ld8(&Vh[(long)((k0) + 32 + sr) * LDK + sc]); \
    sr_[i].ks0 = St::ld8(&Kh[(long)((k0) + sr) * LDK + sc]); sr_[i].ks1 = St::ld8(&Kh[(long)((k0) + 32 + sr) * LDK + sc]); } while (0)
#define SWRITE(b, i) do { *(bf16x8*)((char*)V_lds + (b) * SHM_V + vst0) = St::tobf(sr_[i].vs0);          \
    *(bf16x8*)((char*)V_lds + (b) * SHM_V + vst1) = St::tobf(sr_[i].vs1); int kc = sc * 2;               \
    *(bf16x8*)((char*)K_lds + (b) * SHM_K + KSWZ(sr, kc)) = St::tobf(sr_[i].ks0);                       \
    *(bf16x8*)((char*)K_lds + (b) * SHM_K + KSWZ(32 + sr, kc)) = St::tobf(sr_[i].ks1); } while (0)
#define SWAIT() do { if constexpr (SDEPTH == 2) asm volatile("s_waitcnt vmcnt(4)" ::: "memory"); else asm volatile("s_waitcnt vmcnt(0)" ::: "memory"); } while (0)
#define RESC(a) do { if (__any((a) < 1.f)) { if (hi == 0) al_l[r32] = (a); asm volatile("s_waitcnt lgkmcnt(0)" ::: "memory"); \
    for (int d = 0; d < 4; ++d) for (int r = 0; r < 16; ++r) o[d][r] *= al_l[crow(r, hi)]; } } while (0)
  f32x16 pA0, pA1, pB0, pB1; float mnA, mnB, alA, alB; bf16x8 pa0, pa1, pa2, pa3; const int NT = seq / KVBLK;
  constexpr int SE = 0, SO = SDEPTH - 1;
  SLOAD(SE, 0); asm volatile("s_waitcnt vmcnt(0)" ::: "memory"); SWRITE(0, SE); __syncthreads();
  qkt(pA0, pA1, K_lds, qr, r32, hi); partialSM(pA0, pA1, m_reg, mnA, alA);
  SLOAD(SO, KVBLK); if constexpr (SDEPTH == 2) { if (2 < NT) SLOAD(SE, 2 * KVBLK); }
  SWAIT(); SWRITE(1, SO); __syncthreads();
  for (int j = 1; j + 1 < NT; j += 2) {
    SBAR(); qkt(pB0, pB1, (bf16*)((char*)K_lds + SHM_K), qr, r32, hi);
    finishSM(pA0, pA1, alA, l_reg, pa0, pa1, pa2, pa3); SBAR();
    SLOAD(SO, (j + SDEPTH) * KVBLK); SBAR();
    pv_d0(o, vb0, pa0, pa1, pa2, pa3); partialSM(pB0, pB1, m_reg, mnB, alB);
    __syncthreads(); SWAIT(); SWRITE(0, SE);
    RESC(alB); __syncthreads();
    SBAR(); qkt(pA0, pA1, K_lds, qr, r32, hi);
    finishSM(pB0, pB1, alB, l_reg, pa0, pa1, pa2, pa3); SBAR();
    if (SDEPTH == 1 || j + 3 < NT) SLOAD(SE, (j + 1 + SDEPTH) * KVBLK); SBAR();
    pv_d0(o, vb0 + (int)SHM_V, pa0, pa1, pa2, pa3); partialSM(pA0, pA1, m_reg, mnA, alA);
    __syncthreads(); SWAIT(); SWRITE(1, SO);
    RESC(alA); __syncthreads();
  }
  SBAR(); qkt(pB0, pB1, (bf16*)((char*)K_lds + SHM_K), qr, r32, hi);
  finishSM(pA0, pA1, alA, l_reg, pa0, pa1, pa2, pa3); SBAR();
  pv_d0(o, vb0, pa0, pa1, pa2, pa3); partialSM(pB0, pB1, m_reg, mnB, alB);
  __syncthreads(); RESC(alB);
  finishSM(pB0, pB1, alB, l_reg, pa0, pa1, pa2, pa3); SBAR();
  pv_d0(o, vb0 + (int)SHM_V, pa0, pa1, pa2, pa3);
  if (hi == 0) li_l[r32] = l_reg; asm volatile("s_waitcnt lgkmcnt(0)" ::: "memory");
  float rli[16];
#pragma unroll
  for (int r = 0; r < 16; ++r) rli[r] = __builtin_amdgcn_rcpf(li_l[crow(r, hi)]);
  unsigned short* Ow = Ob + (long)(wid * QBLK) * LDO;
#pragma unroll
  for (int r = 0; r < 16; ++r) { int orow = crow(r, hi);
    for (int d0 = 0; d0 < 4; ++d0) Ow[(long)orow * LDO + d0 * 32 + r32] = f2bf_rne(o[d0][r] * rli[r]); }
#undef SLOAD
#undef SWRITE
#undef SWAIT
#undef RESC
}

}

typedef unsigned short u16;
typedef float f32x4 __attribute__((ext_vector_type(4)));
typedef unsigned u32x4 __attribute__((ext_vector_type(4)));
typedef unsigned u32x2 __attribute__((ext_vector_type(2)));
typedef short s16x8 __attribute__((ext_vector_type(8)));

constexpr int MLAT = 32768, MCTX = 2048, MALL = 34816, FH = 2816, INW = 7712, NMODC = 9216;
constexpr int LDS_BYTES = 147456;
constexpr size_t MiB = 1048576;
constexpr size_t O_WGU1 = 0;
constexpr size_t O_WD1  = O_WGU1 + (size_t)5632 * 1024 * 2;
constexpr size_t O_WGU2 = O_WD1 + (size_t)1024 * 2816 * 2;
constexpr size_t O_WD2  = O_WGU2 + (size_t)5632 * 1024 * 2;
constexpr size_t O_WIN1 = O_WD2 + (size_t)1024 * 2816 * 2;
constexpr size_t O_WIN2 = O_WIN1 + (size_t)3328 * 1024 * 2;
constexpr size_t O_WDN  = O_WIN2 + (size_t)4608 * 1024 * 2;
constexpr size_t O_WAT  = O_WDN + (size_t)1024 * 1024 * 2;
constexpr size_t O_WOUT = O_WAT + (size_t)1024 * 1024 * 2;
constexpr size_t O_MOD  = O_WOUT + (size_t)1024 * 1024 * 2;
static_assert(O_MOD + 9 * 9216 * 4 + 64 <= 55 * MiB + 512 * 1024, "persistent region");
constexpr size_t O_Y1 = 56 * MiB;
constexpr size_t O_A = 124 * MiB;
constexpr size_t O_ACT = 192 * MiB;
constexpr size_t O_QRAW = 192 * MiB, O_KRAW = 260 * MiB, O_REC = 192 * MiB, O_QD = 340 * MiB, O_KD = 408 * MiB, O_BA = 476 * MiB;
constexpr int VD_SPLIT = 20224;
constexpr size_t O_VD1 = 0, O_VD2 = 480 * MiB + 512 * 1024;
static_assert((size_t)VD_SPLIT * 2048 <= O_WIN2 && O_VD2 + (size_t)(MALL - VD_SPLIT) * 2048 <= 512 * MiB && O_VD2 >= O_BA + (size_t)MALL * 32 * 4, "v_d split regions");

constexpr size_t O_QA = 192 * MiB, O_KVA = 256 * MiB, O_GATES = 290 * MiB, O_Z = 418 * MiB;
constexpr size_t O_KALL = 124 * MiB, O_VALL = 141 * MiB;
constexpr size_t O_A3 = O_A, O_T = O_Z, O_Y = O_A, O_A5 = O_QA, O_ACT2 = 256 * MiB, O_Y2 = O_A;
constexpr size_t O_BAR = 55 * MiB + 512 * 1024;
constexpr size_t WS_NEED = 512 * MiB;
constexpr int REC_BYTES = 17408;

struct Args { const float* in[26]; float* out; unsigned char* ws; };
__device__ __forceinline__ u16* vd_row(unsigned char* ws, int row) { return row < VD_SPLIT ? (u16*)(ws + O_VD1) + (size_t)row * 1024 : (u16*)(ws + O_VD2) + (size_t)(row - VD_SPLIT) * 1024; }

__device__ __forceinline__ float bf_lo(unsigned w) { return __uint_as_float(w << 16); }
__device__ __forceinline__ float bf_hi(unsigned w) { return __uint_as_float(w & 0xffff0000u); }
__device__ __forceinline__ float bf2f(u16 v) { return __uint_as_float(((unsigned)v) << 16); }
__device__ __forceinline__ u16 f2bf(float f) { unsigned u = __float_as_uint(f); u += 0x7FFFu + ((u >> 16) & 1u); return (u16)(u >> 16); }
typedef __bf16 bf16x2_t __attribute__((ext_vector_type(2)));
__device__ __forceinline__ unsigned pk(float lo, float hi) { bf16x2_t v; v[0] = (__bf16)lo; v[1] = (__bf16)hi; return __builtin_bit_cast(unsigned, v); }
__device__ __forceinline__ float silu_f(float v) { return v * __builtin_amdgcn_rcpf(1.f + __expf(-v)); }
__device__ __forceinline__ float sigm_f(float v) { return __builtin_amdgcn_rcpf(1.f + __expf(-v)); }
__device__ __forceinline__ float wave_sum(float v) {
#pragma unroll
    for (int o = 32; o > 0; o >>= 1) v += __shfl_xor(v, o);
    return v; }
__device__ __forceinline__ float grp16_sum(float v) {
#pragma unroll
    for (int o = 8; o > 0; o >>= 1) v += __shfl_xor(v, o);
    return v; }
__device__ __forceinline__ float grp32_sum(float v) {
#pragma unroll
    for (int o = 16; o > 0; o >>= 1) v += __shfl_xor(v, o);
    return v; }
__device__ __forceinline__ f32x4 mfma16(s16x8 a, s16x8 b, f32x4 c) { return __builtin_amdgcn_mfma_f32_16x16x32_bf16(a, b, c, 0, 0, 0); }
__device__ __forceinline__ u32x4 pk8(f32x4 a, f32x4 b) { return (u32x4){pk(a[0], a[1]), pk(a[2], a[3]), pk(b[0], b[1]), pk(b[2], b[3])}; }
__device__ __forceinline__ void unpk8(u32x4 w, f32x4& a, f32x4& b) { a = (f32x4){bf_lo(w.x), bf_hi(w.x), bf_lo(w.y), bf_hi(w.y)}; b = (f32x4){bf_lo(w.z), bf_hi(w.z), bf_lo(w.w), bf_hi(w.w)}; }

__device__ __forceinline__ int map_gu(int n) { const int p = n >> 8, r = n & 255; return r < 128 ? p * 128 + r : 2816 + p * 128 + (r - 128); }
__device__ __forceinline__ int map_in1(int n) { return n < 3072 ? n : (n < 3104 ? 4096 + (n - 3072) : -1); }
__device__ __forceinline__ int map_in2(int n) { return n < 1024 ? 3072 + n : (n < 2048 ? 4128 + (n - 1024) : (n < 2560 ? 5152 + (n - 2048) : 5664 + (n - 2560))); }

template <int MAP> __device__ __forceinline__ void cvt_w(const float* __restrict__ src, int K, int Nsrc, u16* __restrict__ dst, int Np, long gtid, long gthreads) {
    const long total = (long)Np * (K >> 5);
    for (long idx = gtid; idx < total; idx += gthreads) {
        const int np = (int)(idx % Np), kg = (int)(idx / Np);
        const int sc = MAP == 0 ? np : (MAP == 1 ? map_gu(np) : (MAP == 2 ? map_in1(np) : map_in2(np)));
        u32x4 w0 = {0u, 0u, 0u, 0u}, w1 = w0, w2 = w0, w3 = w0;
        if (sc >= 0) {
            const float* p = src + (size_t)(kg * 32) * Nsrc + sc;
            float f[32];
#pragma unroll
            for (int j = 0; j < 32; ++j) f[j] = p[(size_t)j * Nsrc];
            w0 = (u32x4){pk(f[0], f[1]), pk(f[2], f[3]), pk(f[4], f[5]), pk(f[6], f[7])};
            w1 = (u32x4){pk(f[8], f[9]), pk(f[10], f[11]), pk(f[12], f[13]), pk(f[14], f[15])};
            w2 = (u32x4){pk(f[16], f[17]), pk(f[18], f[19]), pk(f[20], f[21]), pk(f[22], f[23])};
            w3 = (u32x4){pk(f[24], f[25]), pk(f[26], f[27]), pk(f[28], f[29]), pk(f[30], f[31])};
        }
        u32x4* d = (u32x4*)(dst + (size_t)np * K + kg * 32);
        d[0] = w0; d[1] = w1; d[2] = w2; d[3] = w3;
    }
}

__device__ __forceinline__ void phase_mod(const Args& a, unsigned char* shm) {
    float* sc = (float*)shm;
    float* red = sc + 9216;
    const float* c = a.in[1]; const float* cc = a.in[3]; const float* wmod = a.in[4]; const float* bmod = a.in[5];
    float* mod = (float*)(a.ws + O_MOD);
    const int tid = tid_opaque();
    for (int i = tid; i < 9216; i += 512) { const int r = i >> 10, k = i & 1023; const float v = r < 8 ? c[r * 1024 + k] : cc[k]; sc[i] = silu_f(v); }
    __syncthreads();
    const int cl = tid & 31, kg = tid >> 5;
    for (int task = blockIdx.x; task < 288; task += gridDim.x) {
        const int col = task * 32 + cl;
        float acc[9];
#pragma unroll
        for (int r = 0; r < 9; ++r) acc[r] = 0.f;
#pragma unroll 8
        for (int kk = 0; kk < 64; ++kk) { const int k = kg * 64 + kk; const float w = wmod[(size_t)k * NMODC + col];
#pragma unroll
            for (int r = 0; r < 9; ++r) acc[r] += sc[r * 1024 + k] * w; }
#pragma unroll
        for (int r = 0; r < 9; ++r) red[(kg * 9 + r) * 32 + cl] = acc[r];
        __syncthreads();
        if (tid < 288) { const int r = tid >> 5; float s = bmod[task * 32 + cl];
            for (int g = 0; g < 16; ++g) s += red[(g * 9 + r) * 32 + cl];
            mod[r * NMODC + task * 32 + cl] = s; }
        __syncthreads();
    }
}

struct Row { f32x4 v[4]; };
__device__ __forceinline__ void ld_row_f32(Row& r, const float* p, int lane) {
#pragma unroll
    for (int i = 0; i < 4; ++i) r.v[i] = *(const f32x4*)(p + 256 * i + 4 * lane); }
__device__ __forceinline__ void st_row_f32(const Row& r, float* p, int lane) {
#pragma unroll
    for (int i = 0; i < 4; ++i) *(f32x4*)(p + 256 * i + 4 * lane) = r.v[i]; }
__device__ __forceinline__ void ld_row_bf(Row& r, const u16* p, int lane) {
#pragma unroll
    for (int i = 0; i < 4; ++i) { const u32x2 u = *(const u32x2*)(p + 256 * i + 4 * lane); r.v[i] = (f32x4){bf_lo(u.x), bf_hi(u.x), bf_lo(u.y), bf_hi(u.y)}; } }
__device__ __forceinline__ void st_row_bf(const Row& r, u16* p, int lane) {
#pragma unroll
    for (int i = 0; i < 4; ++i) { u32x2 u; u.x = pk(r.v[i][0], r.v[i][1]); u.y = pk(r.v[i][2], r.v[i][3]); *(u32x2*)(p + 256 * i + 4 * lane) = u; } }
__device__ __forceinline__ void row_norm(Row& y, const Row& x, const float* g, int lane) {
    float s = 0.f;
#pragma unroll
    for (int i = 0; i < 4; ++i) s += x.v[i][0] * x.v[i][0] + x.v[i][1] * x.v[i][1] + x.v[i][2] * x.v[i][2] + x.v[i][3] * x.v[i][3];
    s = wave_sum(s);
    const float rs = rsqrtf(s * (1.f / 1024.f) + 1e-6f);
#pragma unroll
    for (int i = 0; i < 4; ++i) { const f32x4 gv = *(const f32x4*)(g + 256 * i + 4 * lane); y.v[i] = x.v[i] * rs * gv; } }
__device__ __forceinline__ void row_mod(Row& h, const float* shift, const float* scale, int lane) {
#pragma unroll
    for (int i = 0; i < 4; ++i) { const f32x4 sh = *(const f32x4*)(shift + 256 * i + 4 * lane), sc = *(const f32x4*)(scale + 256 * i + 4 * lane); h.v[i] = h.v[i] * (sc + 1.f) + sh; } }
__device__ __forceinline__ void row_res(Row& x, const Row& t, const float* gate, float w, int lane) {
#pragma unroll
    for (int i = 0; i < 4; ++i) { const f32x4 gv = *(const f32x4*)(gate + 256 * i + 4 * lane); x.v[i] = x.v[i] + gv * t.v[i] * w; } }

__device__ __forceinline__ Row ld_vec(const float* p, int lane) { Row r; ld_row_f32(r, p, lane); return r; }
__device__ __forceinline__ float row_rs(const Row& x) {
    float s = 0.f;
#pragma unroll
    for (int i = 0; i < 4; ++i) s += x.v[i][0] * x.v[i][0] + x.v[i][1] * x.v[i][1] + x.v[i][2] * x.v[i][2] + x.v[i][3] * x.v[i][3];
    s = wave_sum(s);
    return rsqrtf(s * (1.f / 1024.f) + 1e-6f); }
__device__ __forceinline__ void row_norm_r(Row& y, const Row& x, const Row& g) { const float rs = row_rs(x);
#pragma unroll
    for (int i = 0; i < 4; ++i) y.v[i] = x.v[i] * rs * g.v[i]; }
__device__ __forceinline__ void row_mod_r(Row& h, const Row& sh, const Row& sc) {
#pragma unroll
    for (int i = 0; i < 4; ++i) h.v[i] = h.v[i] * (sc.v[i] + 1.f) + sh.v[i]; }
__device__ __forceinline__ void row_res_r(Row& x, const Row& t, const Row& gate, float w) {
#pragma unroll
    for (int i = 0; i < 4; ++i) x.v[i] = x.v[i] + gate.v[i] * t.v[i] * w; }

__device__ __forceinline__ void phase_h1(const Args& a) {
    const int lane = tid_opaque() & 63, gw = blockIdx.x * 8 + (tid_opaque() >> 6), nw = gridDim.x * 8;
    const float* mod = (const float*)(a.ws + O_MOD); u16* A = (u16*)(a.ws + O_A);
    const Row pre = ld_vec(a.in[6], lane);
    { const int b = gw & 7; const float* md = mod + b * NMODC; const Row sh = ld_vec(md, lane), sc = ld_vec(md + 1024, lane);
      for (int j = gw >> 3; j < 4096; j += nw >> 3) { const int row = b * 4096 + j;
        Row xr, h; ld_row_f32(xr, a.in[0] + (size_t)row * 1024, lane); row_norm_r(h, xr, pre); row_mod_r(h, sh, sc); st_row_bf(h, A + (size_t)row * 1024, lane); } }
    { const float* md = mod + 8 * NMODC; const Row sh = ld_vec(md, lane), sc = ld_vec(md + 1024, lane);
      for (int row = MLAT + gw; row < MALL; row += nw) {
        Row xr, h; ld_row_f32(xr, a.in[2] + (size_t)(row - MLAT) * 1024, lane); row_norm_r(h, xr, pre); row_mod_r(h, sh, sc); st_row_bf(h, A + (size_t)row * 1024, lane); } }
}
__device__ __forceinline__ void phase_h2(const Args& a, int row_lo = 0, int row_hi = MALL, int bfirst = 0, int nblk = -1) {
    if (nblk < 0) nblk = gridDim.x;
    if ((int)blockIdx.x < bfirst || (int)blockIdx.x >= bfirst + nblk) return;
    const int lane = tid_opaque() & 63, gw = ((int)blockIdx.x - bfirst) * 8 + (tid_opaque() >> 6), nw = nblk * 8;
    const float* mod = (const float*)(a.ws + O_MOD); u16* A = (u16*)(a.ws + O_A); const u16* Y1 = (const u16*)(a.ws + O_Y1);
    const Row post1 = ld_vec(a.in[7], lane), mixpre = ld_vec(a.in[10], lane);
    if (row_lo < MLAT) { const int b = gw & 7; const float* md = mod + b * NMODC;
      const Row g2 = ld_vec(md + 2 * 1024, lane), sh = ld_vec(md + 3 * 1024, lane), sc = ld_vec(md + 4 * 1024, lane);
      for (int j = gw >> 3; j < 4096; j += nw >> 3) { const int row = b * 4096 + j;
        Row x1, yr, t, h; ld_row_f32(x1, a.in[0] + (size_t)row * 1024, lane); ld_row_bf(yr, Y1 + (size_t)row * 1024, lane);
        row_norm_r(t, yr, post1); row_res_r(x1, t, g2, 0.5f); row_norm_r(h, x1, mixpre); row_mod_r(h, sh, sc); st_row_bf(h, A + (size_t)row * 1024, lane); } }
    if (row_hi > MLAT) { const float* md = mod + 8 * NMODC;
      const Row g2 = ld_vec(md + 2 * 1024, lane), sh = ld_vec(md + 3 * 1024, lane), sc = ld_vec(md + 4 * 1024, lane);
      for (int row = MLAT + gw; row < MALL; row += nw) {
        Row x1, yr, t, h; ld_row_f32(x1, a.in[2] + (size_t)(row - MLAT) * 1024, lane); ld_row_bf(yr, Y1 + (size_t)row * 1024, lane);
        row_norm_r(t, yr, post1); row_res_r(x1, t, g2, 0.5f); row_norm_r(h, x1, mixpre); row_mod_r(h, sh, sc); st_row_bf(h, A + (size_t)row * 1024, lane); } }
}
__device__ __forceinline__ void phase_h3(const Args& a) {
    const int lane = tid_opaque() & 63, gw = blockIdx.x * 8 + (tid_opaque() >> 6), nw = gridDim.x * 8;
    const float* mod = (const float*)(a.ws + O_MOD); u16* A5 = (u16*)(a.ws + O_A5); const u16* Y = (const u16*)(a.ws + O_Y); const u16* Y1 = (const u16*)(a.ws + O_Y1);
    const int b = gw & 7; const float* md = mod + b * NMODC;
    const Row post1 = ld_vec(a.in[7], lane), mixpost = ld_vec(a.in[11], lane), pre2 = ld_vec(a.in[22], lane);
    const Row g2 = ld_vec(md + 2 * 1024, lane), g5 = ld_vec(md + 5 * 1024, lane), sh = ld_vec(md + 6 * 1024, lane), sc = ld_vec(md + 7 * 1024, lane);
    for (int j = gw >> 3; j < 4096; j += nw >> 3) { const int row = b * 4096 + j;
        Row x2, yr, t, h; ld_row_f32(x2, a.in[0] + (size_t)row * 1024, lane); ld_row_bf(yr, Y1 + (size_t)row * 1024, lane);
        row_norm_r(t, yr, post1); row_res_r(x2, t, g2, 0.5f);
        ld_row_bf(yr, Y + (size_t)row * 1024, lane); row_norm_r(t, yr, mixpost); row_res_r(x2, t, g5, 1.0f);
        st_row_f32(x2, a.out + (size_t)row * 1024, lane);
        row_norm_r(h, x2, pre2); row_mod_r(h, sh, sc); st_row_bf(h, A5 + (size_t)row * 1024, lane);
    }
}
__device__ __forceinline__ void phase_out(const Args& a) {
    const int lane = tid_opaque() & 63, gw = blockIdx.x * 8 + (tid_opaque() >> 6), nw = gridDim.x * 8;
    const float* mod = (const float*)(a.ws + O_MOD); const u16* Y2 = (const u16*)(a.ws + O_Y2);
    const int b = gw & 7; const Row post2 = ld_vec(a.in[23], lane), g8 = ld_vec(mod + b * NMODC + 8 * 1024, lane);
    for (int j = gw >> 3; j < 4096; j += nw >> 3) { const int row = b * 4096 + j;
        Row x2, yr, t; ld_row_f32(x2, a.out + (size_t)row * 1024, lane); ld_row_bf(yr, Y2 + (size_t)row * 1024, lane); row_norm_r(t, yr, post2); row_res_r(x2, t, g8, 0.5f);
        st_row_f32(x2, a.out + (size_t)row * 1024, lane);
    }
}

struct EpiPlain { static constexpr bool PERM = true, AFTER_DRAIN = false; u16* O; int ldc;
    __device__ __forceinline__ void operator()(const pg8::f32x4 (&acc)[2][2][4][2], const pg8::Unit& u, int wr, int wc, int fr, int fq) const {
        const int row0 = u.pm * 256 + wr * 64 + fr, col0 = u.pn * 256 + wc * 32 + 8 * fq;
#pragma unroll
        for (int ai = 0; ai < 2; ++ai)
#pragma unroll
            for (int m = 0; m < 4; ++m) { u16* rp = O + (size_t)(row0 + ai * 128 + m * 16) * ldc + col0;
#pragma unroll
                for (int bj = 0; bj < 2; ++bj) *(u32x4*)(rp + bj * 128) = pk8(acc[ai][bj][m][0], acc[ai][bj][m][1]); } } };

struct EpiSwiglu { static constexpr bool PERM = true, AFTER_DRAIN = false; u16* O;
    __device__ __forceinline__ void operator()(const pg8::f32x4 (&acc)[2][2][4][2], const pg8::Unit& u, int wr, int wc, int fr, int fq) const {
        const int row0 = u.pm * 256 + wr * 64 + fr, col0 = u.pn * 128 + wc * 32 + 8 * fq;
#pragma unroll
        for (int ai = 0; ai < 2; ++ai)
#pragma unroll
            for (int m = 0; m < 4; ++m) { u16* rp = O + (size_t)(row0 + ai * 128 + m * 16) * FH + col0;
                f32x4 o0, o1;
#pragma unroll
                for (int j = 0; j < 4; ++j) { o0[j] = silu_f(acc[ai][0][m][0][j]) * acc[ai][1][m][0][j]; o1[j] = silu_f(acc[ai][0][m][1][j]) * acc[ai][1][m][1][j]; }
                *(u32x4*)rp = pk8(o0, o1); } } };

struct EpiIn1 { static constexpr bool PERM = true, AFTER_DRAIN = false; u16* q; u16* k; u16* v; float* ba;
    __device__ __forceinline__ void operator()(const pg8::f32x4 (&acc)[2][2][4][2], const pg8::Unit& u, int wr, int wc, int fr, int fq) const {
        const int row0 = u.pm * 256 + wr * 64 + fr;
        if (u.pn < 12) {
            const int t3 = u.pn >> 2;
            u16* base = q + (long)(t3 == 1) * (long)(k - q) + (long)(t3 == 2) * (long)(v - q); const int col0 = (u.pn & 3) * 256 + wc * 32 + 8 * fq;
#pragma unroll
            for (int ai = 0; ai < 2; ++ai)
#pragma unroll
                for (int m = 0; m < 4; ++m) { u16* rp = base + (size_t)(row0 + ai * 128 + m * 16) * 1024 + col0;
#pragma unroll
                    for (int bj = 0; bj < 2; ++bj) *(u32x4*)(rp + bj * 128) = pk8(acc[ai][bj][m][0], acc[ai][bj][m][1]); }
        } else if (wc == 0) {
#pragma unroll
            for (int ai = 0; ai < 2; ++ai)
#pragma unroll
                for (int m = 0; m < 4; ++m) { float* rp = ba + (size_t)(row0 + ai * 128 + m * 16) * 32 + 8 * fq;
                    *(f32x4*)rp = acc[ai][0][m][0]; *(f32x4*)(rp + 4) = acc[ai][0][m][1]; }
        } } };
struct EpiIn2 { static constexpr bool PERM = true, AFTER_DRAIN = false; u16* z; u16* qa; u16* kva; u16* gates;
    __device__ __forceinline__ void operator()(const pg8::f32x4 (&acc)[2][2][4][2], const pg8::Unit& u, int wr, int wc, int fr, int fq) const {
        const int row0 = u.pm * 256 + wr * 64 + fr; const bool lat = u.pm < 128;
        u16* base; int ldc, col0; bool sig = false;
        if (u.pn < 4) { if (!lat) return; base = z; ldc = 1024; col0 = u.pn * 256; }
        else if (u.pn < 8) { if (!lat) return; base = qa; ldc = 1024; col0 = (u.pn - 4) * 256; }
        else if (u.pn < 10) { base = kva; ldc = 512; col0 = (u.pn - 8) * 256; }
        else { if (!lat) return; base = gates; ldc = 2048; col0 = (u.pn - 10) * 256; sig = true; }
        col0 += wc * 32 + 8 * fq;
#pragma unroll
        for (int ai = 0; ai < 2; ++ai)
#pragma unroll
            for (int m = 0; m < 4; ++m) { u16* rp = base + (size_t)(row0 + ai * 128 + m * 16) * ldc + col0;
#pragma unroll
                for (int bj = 0; bj < 2; ++bj) { f32x4 v0 = acc[ai][bj][m][0], v1 = acc[ai][bj][m][1];
                    if (sig) {
#pragma unroll
                        for (int j = 0; j < 4; ++j) { v0[j] = sigm_f(v0[j]); v1[j] = sigm_f(v1[j]); } }
                    *(u32x4*)(rp + bj * 128) = pk8(v0, v1); } } } };

template <int SECOND> struct EpiMerge { static constexpr bool PERM = true, AFTER_DRAIN = false; const u16* gates; u16* T;
    __device__ __forceinline__ void operator()(const pg8::f32x4 (&acc)[2][2][4][2], const pg8::Unit& u, int wr, int wc, int fr, int fq) const {
        const int row0 = u.pm * 256 + wr * 64 + fr, col0 = u.pn * 256 + wc * 32 + 8 * fq;
#pragma unroll
        for (int ai = 0; ai < 2; ++ai)
#pragma unroll
            for (int m = 0; m < 4; ++m) { const size_t row = (size_t)(row0 + ai * 128 + m * 16);
#pragma unroll
                for (int bj = 0; bj < 2; ++bj) { const int col = col0 + bj * 128;
                    const u32x4 gw = *(const u32x4*)(gates + row * 2048 + SECOND * 1024 + col); f32x4 g0, g1; unpk8(gw, g0, g1);
                    f32x4 o0 = g0 * acc[ai][bj][m][0], o1 = g1 * acc[ai][bj][m][1];
#if defined(EXP_ZERO_DN)
                    if (!SECOND) { o0 *= 0.f; o1 *= 0.f; }
#endif
#if defined(EXP_ZERO_AT)
                    if (SECOND) { o0 *= 0.f; o1 *= 0.f; }
#endif
                    if (SECOND) { const u32x4 tw = *(const u32x4*)(T + row * 1024 + col); f32x4 t0, t1; unpk8(tw, t0, t1); o0 += t0; o1 += t1; }
                    *(u32x4*)(T + row * 1024 + col) = pk8(o0, o1); } } } };

template <class Epi> __device__ __forceinline__ void run_gemm(unsigned char* shm, const u16* A, const u16* Bt, int M, int N, int K, const Epi& E) {
    pg8::Gemm g; g.A = A; g.Bt = Bt; g.M = M; g.N = N; g.K = K;
    pg8::StaticOrder S; S.init(M, N, (int)gridDim.x, (int)blockIdx.x);
    pg8::gemm_phase<Epi, pg8::StaticOrder, false>((PG8_LAS unsigned char*)shm, g, S, E, nullptr);
}

__device__ __forceinline__ void phase_dn_prep(const Args& a) {
    const int lane = tid_opaque() & 63, gw = blockIdx.x * 8 + (tid_opaque() >> 6), nw = gridDim.x * 8;
    const u16* raw0 = (const u16*)(a.ws + O_QRAW); const u16* raw1 = (const u16*)(a.ws + O_KRAW); const u16* raw2 = (const u16*)a.out;
    u16* out0 = (u16*)(a.ws + O_QD); u16* out1 = (u16*)(a.ws + O_KD);
    const float* cw = a.in[13];
    for (int row = gw; row < MALL; row += nw) {
        const int pos = row < MLAT ? (row & 4095) : ((row - MLAT) & 255); const int L = row < MLAT ? 4096 : 256;
        const bool hp = pos > 0, hn = pos < L - 1;
#pragma unroll
        for (int i = 0; i < 6; ++i) {
            const int kind = i >> 1, cc = (i & 1) * 512 + 8 * lane, cg_ = kind * 1024 + cc;
            const u16* rp = (kind == 0 ? raw0 : (kind == 1 ? raw1 : raw2)) + (size_t)row * 1024 + cc;
            u16* op = (kind == 0 ? out0 + (size_t)row * 1024 : (kind == 1 ? out1 + (size_t)row * 1024 : vd_row(a.ws, row))) + cc;
            const u32x4 zc = {0u, 0u, 0u, 0u};
            const u32x4 cu = *(const u32x4*)rp; const u32x4 pu = hp ? *(const u32x4*)(rp - 1024) : zc; const u32x4 nu = hn ? *(const u32x4*)(rp + 1024) : zc;
            f32x4 c0, c1, p0, p1, n0, n1; unpk8(cu, c0, c1); unpk8(pu, p0, p1); unpk8(nu, n0, n1);
            const f32x4 wa0 = *(const f32x4*)(cw + cg_), wa1 = *(const f32x4*)(cw + cg_ + 4);
            const f32x4 wb0 = *(const f32x4*)(cw + 3072 + cg_), wb1 = *(const f32x4*)(cw + 3072 + cg_ + 4);
            const f32x4 wc0 = *(const f32x4*)(cw + 6144 + cg_), wc1 = *(const f32x4*)(cw + 6144 + cg_ + 4);
            f32x4 v0 = wa0 * p0 + wb0 * c0 + wc0 * n0, v1 = wa1 * p1 + wb1 * c1 + wc1 * n1;
            float ss = 0.f;
#pragma unroll
            for (int j = 0; j < 4; ++j) { v0[j] = silu_f(v0[j]); v1[j] = silu_f(v1[j]); ss += v0[j] * v0[j] + v1[j] * v1[j]; }
            if (kind < 2) { ss = grp16_sum(ss); const float sc = rsqrtf(ss + 1e-6f) * (kind == 0 ? 0.08838834764831845f : 1.f); v0 *= sc; v1 *= sc; }
            *(u32x4*)op = pk8(v0, v1);
        }
    }
}

__device__ __forceinline__ void phase_dn_pre(const Args& a, unsigned char* shm) {
    const int tid = tid_opaque(), wid = tid >> 6, lane0 = tid & 63;
    float* Lm = (float*)(shm + wid * 17408); float* gcs = Lm + 4096; float* bts = gcs + 64;
    const u16* qd = (const u16*)(a.ws + O_QD); const u16* kd = (const u16*)(a.ws + O_KD); const float* BA = (const float*)(a.ws + O_BA);
    unsigned char* REC = a.ws + O_REC;
    for (int task = blockIdx.x * 8 + wid; task < 8704; task += gridDim.x * 8) {
        int lane = lane0; asm volatile("" : "+v"(lane));
        const int fr = lane & 15, quad = lane >> 4;
        const int c68 = task % 68; int tt = task / 68; const int dir = tt & 1; tt >>= 1; const int h = tt & 7; const int b = tt >> 3;
        const int base = c68 < 4 ? MLAT + b * 256 + c68 * 64 : b * 4096 + (c68 - 4) * 64;
        const int tok = dir ? 63 - lane : lane;
        const float* bap = BA + (size_t)(base + tok) * 32;
        const float beta = sigm_f(bap[dir * 8 + h]);
        const float xs = bap[16 + dir * 8 + h] + a.in[15][dir * 8 + h];
        const float sp = fmaxf(xs, 0.f) + log1pf(__expf(-fabsf(xs)));
        const float g = -__expf(a.in[14][dir * 8 + h]) * sp;
        float gc = g;
#pragma unroll
        for (int o = 1; o < 64; o <<= 1) { const float nb = __shfl_up(gc, o); if (lane >= o) gc += nb; }
        const float glast = __shfl(gc, 63);
        asm volatile("s_waitcnt lgkmcnt(0)" ::: "memory");
        gcs[lane] = gc; bts[lane] = beta;
        unsigned char* rec = REC + (size_t)task * REC_BYTES;
        float* rf = (float*)(rec + 16384);
        rf[lane] = __expf(gc); rf[64 + lane] = __expf(glast - gc); if (lane == 0) rf[128] = __expf(glast);
        asm volatile("s_waitcnt lgkmcnt(0)" ::: "memory");
        s16x8 kf[4][4];
#pragma unroll
        for (int mt = 0; mt < 4; ++mt) { const int r = 16 * mt + fr, tr = dir ? 63 - r : r; const u16* p = kd + (size_t)(base + tr) * 1024 + h * 128 + quad * 8;
#pragma unroll
            for (int kk = 0; kk < 4; ++kk) kf[mt][kk] = *(const s16x8*)(p + kk * 32); }
#pragma unroll
        for (int mt = 0; mt < 4; ++mt)
#pragma unroll
            for (int nt = 0; nt <= mt; ++nt) { f32x4 acc = {0.f, 0.f, 0.f, 0.f};
#pragma unroll
                for (int kk = 0; kk < 4; ++kk) acc = mfma16(kf[mt][kk], kf[nt][kk], acc);
                const int j = 16 * nt + fr; const float gj = gcs[j];
#pragma unroll
                for (int r = 0; r < 4; ++r) { const int i = 16 * mt + quad * 4 + r; Lm[i * 64 + j] = bts[i] * acc[r] * __expf(fminf(gcs[i] - gj, 0.f)); } }
        asm volatile("s_waitcnt lgkmcnt(0)" ::: "memory");
        const int hb = lane >> 5, cb = lane & 31;
        float tcol[32];
#pragma unroll
        for (int ii = 0; ii < 32; ++ii) {
            const float* Lrow = Lm + (32 * hb + ii) * 64 + 32 * hb;
            float s0 = (cb == ii) ? 1.f : 0.f, s1 = 0.f, s2 = 0.f, s3 = 0.f;
#pragma unroll
            for (int j4 = 0; j4 < (ii + 3) / 4; ++j4) { const f32x4 l = *(const f32x4*)(Lrow + j4 * 4);
                if (4 * j4 + 0 < ii) s0 -= l[0] * tcol[4 * j4 + 0];
                if (4 * j4 + 1 < ii) s1 -= l[1] * tcol[4 * j4 + 1];
                if (4 * j4 + 2 < ii) s2 -= l[2] * tcol[4 * j4 + 2];
                if (4 * j4 + 3 < ii) s3 -= l[3] * tcol[4 * j4 + 3]; }
            tcol[ii] = (s0 + s1) + (s2 + s3);
            __builtin_amdgcn_sched_barrier(0);
        }
        unsigned char* imgB = (unsigned char*)Lm;
        { const int m = lane >> 1, k0 = (lane & 1) * 16; const float* src = Lm + (32 + m) * 64 + k0;
          const f32x4 c0 = *(const f32x4*)(src), c1 = *(const f32x4*)(src + 4), c2 = *(const f32x4*)(src + 8), c3 = *(const f32x4*)(src + 12);
          *(u32x4*)(imgB + m * 64 + k0 * 2) = pk8(c0, c1); *(u32x4*)(imgB + m * 64 + k0 * 2 + 16) = pk8(c2, c3); }
        if (hb == 0) {
#pragma unroll
            for (int q = 0; q < 4; ++q) { u32x4 w; w.x = pk(tcol[8 * q], tcol[8 * q + 1]); w.y = pk(tcol[8 * q + 2], tcol[8 * q + 3]); w.z = pk(tcol[8 * q + 4], tcol[8 * q + 5]); w.w = pk(tcol[8 * q + 6], tcol[8 * q + 7]);
                *(u32x4*)(imgB + 2048 + cb * 64 + q * 16) = w; }
        } else {
#pragma unroll
            for (int m = 0; m < 32; ++m) *(u16*)(imgB + 4096 + m * 64 + cb * 2) = f2bf(tcol[m]);
        }
        asm volatile("s_waitcnt lgkmcnt(0)" ::: "memory");
        f32x4 Zb[2][2];
#pragma unroll
        for (int m2 = 0; m2 < 2; ++m2)
#pragma unroll
            for (int n2 = 0; n2 < 2; ++n2) { const f32x4 z0 = {0.f, 0.f, 0.f, 0.f};
                Zb[m2][n2] = mfma16(*(const s16x8*)(imgB + (16 * m2 + fr) * 64 + quad * 16), *(const s16x8*)(imgB + 2048 + (16 * n2 + fr) * 64 + quad * 16), z0); }
#pragma unroll
        for (int m2 = 0; m2 < 2; ++m2)
#pragma unroll
            for (int n2 = 0; n2 < 2; ++n2) { u32x2 w; w.x = pk(Zb[m2][n2][0], Zb[m2][n2][1]); w.y = pk(Zb[m2][n2][2], Zb[m2][n2][3]);
                *(u32x2*)(imgB + 6144 + (16 * n2 + fr) * 64 + (16 * m2 + 4 * quad) * 2) = w; }
        asm volatile("s_waitcnt lgkmcnt(0)" ::: "memory");
        f32x4 T21[2][2];
#pragma unroll
        for (int m2 = 0; m2 < 2; ++m2)
#pragma unroll
            for (int n2 = 0; n2 < 2; ++n2) { const f32x4 z0 = {0.f, 0.f, 0.f, 0.f};
                T21[m2][n2] = mfma16(*(const s16x8*)(imgB + 4096 + (16 * m2 + fr) * 64 + quad * 16), *(const s16x8*)(imgB + 6144 + (16 * n2 + fr) * 64 + quad * 16), z0); }
        u16* img = (u16*)Lm;
        asm volatile("s_waitcnt lgkmcnt(0)" ::: "memory");
#pragma unroll
        for (int ii = 0; ii < 32; ++ii) img[4096 + (32 * hb + ii) * 64 + lane] = f2bf(tcol[ii] * beta);
        if (hb == 1) {
#pragma unroll
            for (int ii = 0; ii < 32; ++ii) img[4096 + ii * 64 + lane] = 0; }
#pragma unroll
        for (int m2 = 0; m2 < 2; ++m2)
#pragma unroll
            for (int n2 = 0; n2 < 2; ++n2) { const int col = 16 * n2 + fr; const float bc = bts[col];
#pragma unroll
                for (int r = 0; r < 4; ++r) img[4096 + (32 + 16 * m2 + 4 * quad + r) * 64 + col] = f2bf(-T21[m2][n2][r] * bc); }
#pragma unroll
        for (int mt = 0; mt < 4; ++mt) { const int r_ = 16 * mt + fr, tr = dir ? 63 - r_ : r_; const u16* p = qd + (size_t)(base + tr) * 1024 + h * 128 + quad * 8;
            s16x8 qf[4];
#pragma unroll
            for (int kk = 0; kk < 4; ++kk) qf[kk] = *(const s16x8*)(p + kk * 32);
#pragma unroll
            for (int nt = 0; nt < 4; ++nt) { const int j = 16 * nt + fr;
                if (nt <= mt) { f32x4 acc = {0.f, 0.f, 0.f, 0.f};
#pragma unroll
                    for (int kk = 0; kk < 4; ++kk) acc = mfma16(qf[kk], kf[nt][kk], acc);
                    const float gj = gcs[j];
#pragma unroll
                    for (int r = 0; r < 4; ++r) { const int i = 16 * mt + quad * 4 + r; const float v = (j <= i) ? acc[r] * __expf(fminf(gcs[i] - gj, 0.f)) : 0.f; img[i * 64 + j] = f2bf(v); }
                } else {
#pragma unroll
                    for (int r = 0; r < 4; ++r) { const int i = 16 * mt + quad * 4 + r; img[i * 64 + j] = 0; } } } }
        asm volatile("s_waitcnt lgkmcnt(0)" ::: "memory");
        { const u32x4* src = (const u32x4*)Lm; u32x4* dst = (u32x4*)rec;
#pragma unroll
            for (int q = 0; q < 8; ++q) { dst[q * 64 + lane] = src[512 + q * 64 + lane]; dst[512 + q * 64 + lane] = src[q * 64 + lane]; } }
    }
}

__device__ __forceinline__ void phase_dn_scan(const Args& a, unsigned char* shm) {
    const int tid = tid_opaque(), wid = tid >> 6, lane = tid & 63, fr = lane & 15, quad = lane >> 4, r32 = lane & 31, hi = lane >> 5;
    unsigned char* ST = shm; unsigned char* KV = shm + 17408; unsigned char* RT = KV + 16384; unsigned char* VN = RT + 9216; unsigned char* VS = VN + 9216;
    unsigned char* KR = VS + 9216; unsigned char* QR = KR + 17408;
    const int mt = wid & 3, ng = wid >> 2, mtS = wid & 1, D0 = wid >> 1;
    const int sr = tid >> 4, sc = (tid & 15) * 8, vst0 = at::v_st(sr, sc), vst1 = at::v_st(32 + sr, sc);
    const int vb0 = (int)(uintptr_t)KV + at::v_rd_base(lane);
    const u16* qd = (const u16*)(a.ws + O_QD); const u16* kd = (const u16*)(a.ws + O_KD);
    const unsigned char* REC = a.ws + O_REC;
    for (int task = blockIdx.x; task < 256; task += gridDim.x) {
        const int half = task & 1, dir = (task >> 1) & 1, h = (task >> 2) & 7, b = task >> 5;
        u16* Od = (u16*)a.out + (dir ? (size_t)MLAT * 1024 : (size_t)0);
        at::f32x16 sT;
#pragma unroll
        for (int r = 0; r < 16; ++r) sT[r] = 0.f;
        const int irow = 16 * mt + fr, i0 = 16 * mt + quad * 4;
        const int dv0 = 32 * ng + fr, dv1 = dv0 + 16;
        const int trow = dir ? 63 - irow : irow, t0 = dir ? 63 - sr : sr, t1 = dir ? 31 - sr : 32 + sr;
        const int hoff = h * 128;
#define SCAN_C68(n_) ((n_) < 4 ? (dir ? 3 - (n_) : (n_)) : (dir ? 71 - (n_) : (n_)))
#define SCAN_BASE(c_) ((c_) < 4 ? MLAT + b * 256 + (c_) * 64 : b * 4096 + ((c_) - 4) * 64)
#define SCAN_REC(c_) (REC + (size_t)((((b * 8 + h) * 2 + dir) * 68) + (c_)) * REC_BYTES)
        s16x8 K0, K1, Q0, Q1, TB[2], IN[2]; f32x4 EG, EK, V0, V1; float DCH;
        const unsigned oK0 = (unsigned)(t0 * 1024 + hoff + sc), oK1 = (unsigned)(t1 * 1024 + hoff + sc), oA = (unsigned)(trow * 1024 + hoff + quad * 8), oT = (unsigned)(irow * 64 + quad * 8);
        unsigned oV[4];
#pragma unroll
        for (int r = 0; r < 4; ++r) oV[r] = (unsigned)((dir ? 63 - (i0 + r) : (i0 + r)) * 1024 + hoff + half * 64 + dv0);
#define LD_K(base_)   do { const u16* kb_ = kd + (size_t)(base_) * 1024; const u16* qb_ = qd + (size_t)(base_) * 1024; K0 = *(const s16x8*)(kb_ + oK0); K1 = *(const s16x8*)(kb_ + oK1); Q0 = *(const s16x8*)(qb_ + oK0); Q1 = *(const s16x8*)(qb_ + oK1); } while (0)
#define LD_A(base_)   do { const u16* vb_ = vd_row(a.ws, (base_)); \
        _Pragma("unroll") for (int r = 0; r < 4; ++r) { V0[r] = bf2f(vb_[oV[r]]); V1[r] = bf2f(vb_[oV[r] + 16]); } } while (0)
#define LD_TB(rec_)   do { const u16* p_ = (const u16*)(rec_) + oT; TB[0] = *(const s16x8*)p_; TB[1] = *(const s16x8*)(p_ + 32); EK = *(const f32x4*)((const float*)((rec_) + 16384) + 64 + i0); } while (0)
#define LD_IN(rec_)   do { const u16* p_ = (const u16*)((rec_) + 8192) + oT; IN[0] = *(const s16x8*)p_; IN[1] = *(const s16x8*)(p_ + 32); } while (0)
#define LD_EG(rec_)   do { EG = *(const f32x4*)((const float*)((rec_) + 16384) + i0); } while (0)
#define LD_D(rec_)    do { DCH = ((const float*)((rec_) + 16384))[128]; } while (0)
        { const int c0 = SCAN_C68(0); const int bs = SCAN_BASE(c0); const unsigned char* rc = SCAN_REC(c0);
          LD_K(bs); LD_A(bs); LD_TB(rc); LD_IN(rc); LD_EG(rc); LD_D(rc); }
        for (int n = 0; n < 68; ++n) {
            const int c68 = SCAN_C68(n);
            const int base = SCAN_BASE(c68);
            const int nn = n < 67 ? n + 1 : 67; const int c68n = SCAN_C68(nn); const int basen = SCAN_BASE(c68n); const unsigned char* recn = SCAN_REC(c68n);
#pragma unroll
            for (int r = 0; r < 16; ++r) *(u16*)(ST + (32 * mtS + at::crow(r, hi)) * 272 + (32 * D0 + r32) * 2) = f2bf(sT[r]);
            *(s16x8*)(KV + vst0) = K0; *(s16x8*)(KV + vst1) = K1;
            *(s16x8*)(KR + sr * 272 + sc * 2) = K0; *(s16x8*)(KR + (32 + sr) * 272 + sc * 2) = K1;
            *(s16x8*)(QR + sr * 272 + sc * 2) = Q0; *(s16x8*)(QR + (32 + sr) * 272 + sc * 2) = Q1;
            LD_K(basen);
            __syncthreads();
            f32x4 KS0 = {0.f, 0.f, 0.f, 0.f}, KS1 = KS0, QS0 = KS0, QS1 = KS0;
#pragma unroll
            for (int kk = 0; kk < 4; ++kk) {
                const s16x8 b0 = *(const s16x8*)(ST + dv0 * 272 + (kk * 32 + quad * 8) * 2), b1 = *(const s16x8*)(ST + dv1 * 272 + (kk * 32 + quad * 8) * 2);
                const s16x8 ak = *(const s16x8*)(KR + irow * 272 + (kk * 32 + quad * 8) * 2), aq = *(const s16x8*)(QR + irow * 272 + (kk * 32 + quad * 8) * 2);
                KS0 = mfma16(ak, b0, KS0); KS1 = mfma16(ak, b1, KS1); QS0 = mfma16(aq, b0, QS0); QS1 = mfma16(aq, b1, QS1);
            }
            {
                const f32x4 r0 = V0 - EG * KS0, r1 = V1 - EG * KS1;
                u32x2 w0, w1; w0.x = pk(r0[0], r0[1]); w0.y = pk(r0[2], r0[3]); w1.x = pk(r1[0], r1[1]); w1.y = pk(r1[2], r1[3]);
                *(u32x2*)(RT + dv0 * 144 + i0 * 2) = w0; *(u32x2*)(RT + dv1 * 144 + i0 * 2) = w1;
            }
            LD_A(basen);
            __syncthreads();
            f32x4 N0 = {0.f, 0.f, 0.f, 0.f}, N1 = N0;
            {
#pragma unroll
                for (int kk = 0; kk < 2; ++kk) {
                    const s16x8 b0 = *(const s16x8*)(RT + dv0 * 144 + (kk * 32 + quad * 8) * 2), b1 = *(const s16x8*)(RT + dv1 * 144 + (kk * 32 + quad * 8) * 2);
                    N0 = mfma16(TB[kk], b0, N0); N1 = mfma16(TB[kk], b1, N1); }
                u32x2 w0, w1; w0.x = pk(N0[0], N0[1]); w0.y = pk(N0[2], N0[3]); w1.x = pk(N1[0], N1[1]); w1.y = pk(N1[2], N1[3]);
                *(u32x2*)(VN + dv0 * 144 + i0 * 2) = w0; *(u32x2*)(VN + dv1 * 144 + i0 * 2) = w1;
                const f32x4 s0 = N0 * EK, s1 = N1 * EK;
                w0.x = pk(s0[0], s0[1]); w0.y = pk(s0[2], s0[3]); w1.x = pk(s1[0], s1[1]); w1.y = pk(s1[2], s1[3]);
                *(u32x2*)(VS + dv0 * 144 + i0 * 2) = w0; *(u32x2*)(VS + dv1 * 144 + i0 * 2) = w1;
            }
            LD_TB(recn);
            __syncthreads();
            {
                f32x4 O0 = QS0 * EG, O1 = QS1 * EG;
#pragma unroll
                for (int kk = 0; kk < 2; ++kk) {
                    const s16x8 b0 = *(const s16x8*)(VN + dv0 * 144 + (kk * 32 + quad * 8) * 2), b1 = *(const s16x8*)(VN + dv1 * 144 + (kk * 32 + quad * 8) * 2);
                    O0 = mfma16(IN[kk], b0, O0); O1 = mfma16(IN[kk], b1, O1); }
                if (n >= 4) {
#pragma unroll
                    for (int r = 0; r < 4; ++r) { u16* op = Od + (size_t)base * 1024 + oV[r];
                        op[0] = f2bf(O0[r]); op[16] = f2bf(O1[r]); } }
            }
            LD_IN(recn); LD_EG(recn);
            {
#pragma unroll
                for (int r = 0; r < 16; ++r) sT[r] *= DCH;
                LD_D(recn);
                const unsigned char* vsp = VS + (32 * mtS + r32) * 144 + (8 * hi) * 2;
                const at::bf16x8 pa0 = *(const at::bf16x8*)(vsp), pa1 = *(const at::bf16x8*)(vsp + 32), pa2 = *(const at::bf16x8*)(vsp + 64), pa3 = *(const at::bf16x8*)(vsp + 96);
                if (D0 == 0) at::pv_one<0>(sT, vb0, pa0, pa1, pa2, pa3);
                else if (D0 == 1) at::pv_one<1>(sT, vb0, pa0, pa1, pa2, pa3);
                else if (D0 == 2) at::pv_one<2>(sT, vb0, pa0, pa1, pa2, pa3);
                else at::pv_one<3>(sT, vb0, pa0, pa1, pa2, pa3);
            }
            __syncthreads();
        }
#undef LD_K
#undef LD_A
#undef LD_TB
#undef LD_IN
#undef LD_EG
#undef LD_D
#undef SCAN_C68
#undef SCAN_BASE
#undef SCAN_REC
    }
}

#if defined(EXP_NAIVE_DN)
__device__ __forceinline__ void phase_dn_naive(const Args& a, unsigned char* shm) {
    const int tid = tid_opaque(), dvl = tid & 63, kg = tid >> 6;
    float* red = (float*)shm;
    const u16* qd = (const u16*)(a.ws + O_QD); const u16* kd = (const u16*)(a.ws + O_KD); const u16* vd = (const u16*)(a.ws + O_VD1); const float* BA = (const float*)(a.ws + O_BA);
    for (int task = blockIdx.x; task < 256; task += gridDim.x) {
        const int half = task & 1, dir = (task >> 1) & 1, h = (task >> 2) & 7, b = task >> 5;
#if defined(EXP_HYBRID)
        if (!(EXP_HYBRID)) continue;
#endif
        u16* Od = (u16*)a.out + (dir ? (size_t)MLAT * 1024 : (size_t)0);
        float S[16];
#pragma unroll
        for (int e = 0; e < 16; ++e) S[e] = 0.f;
        const float alog = a.in[14][dir * 8 + h], dtb = a.in[15][dir * 8 + h];
        for (int n = 0; n < 4352; ++n) {
            int row; if (n < 256) { const int t = dir ? 255 - n : n; row = MLAT + b * 256 + t; } else { const int t = dir ? 4095 - (n - 256) : (n - 256); row = b * 4096 + t; }
            const float* bap = BA + (size_t)row * 32;
            const float beta = sigm_f(bap[dir * 8 + h]);
            const float xs = bap[16 + dir * 8 + h] + dtb;
            const float g = -__expf(alog) * (fmaxf(xs, 0.f) + log1pf(__expf(-fabsf(xs))));
            const float eg = __expf(g);
            const u16* kp = kd + (size_t)row * 1024 + h * 128 + kg * 16; const u16* qp = qd + (size_t)row * 1024 + h * 128 + kg * 16;
            float kk[16], qq[16];
#pragma unroll
            for (int e = 0; e < 16; ++e) { kk[e] = bf2f(kp[e]); qq[e] = bf2f(qp[e]); }
            const float v = bf2f(vd[(size_t)row * 1024 + h * 128 + half * 64 + dvl]);
            float ps = 0.f;
#pragma unroll
            for (int e = 0; e < 16; ++e) { S[e] *= eg; ps += kk[e] * S[e]; }
            red[kg * 64 + dvl] = ps;
            __syncthreads();
            float ks = 0.f;
#pragma unroll
            for (int g8 = 0; g8 < 8; ++g8) ks += red[g8 * 64 + dvl];
            __syncthreads();
            const float delta = beta * (v - ks);
            float po = 0.f;
#pragma unroll
            for (int e = 0; e < 16; ++e) { S[e] += kk[e] * delta; po += qq[e] * S[e]; }
            red[kg * 64 + dvl] = po;
            __syncthreads();
            if (n >= 256 && kg == 0) { float o = 0.f;
#pragma unroll
                for (int g8 = 0; g8 < 8; ++g8) o += red[g8 * 64 + dvl];
                Od[(size_t)row * 1024 + h * 128 + half * 64 + dvl] = f2bf(o); }
            __syncthreads();
        }
    }
}
#endif


#if defined(EXP_VALU_SCAN)
#define BR(x) bf2f(f2bf(x))
__device__ __forceinline__ void phase_dn_scan_valu(const Args& a, unsigned char* shm) {
    const int tid = tid_opaque(), dvl = tid & 63, rg = tid >> 6;
    float* S = (float*)shm; float* kc = S + 8192; float* qc = kc + 8192; float* rr = qc + 8192; float* vn = rr + 4096;
    const u16* qd = (const u16*)(a.ws + O_QD); const u16* kd = (const u16*)(a.ws + O_KD);
    const unsigned char* REC = a.ws + O_REC;
    for (int task = blockIdx.x; task < 256; task += gridDim.x) {
        const int half = task & 1, dir = (task >> 1) & 1, h = (task >> 2) & 7, b = task >> 5;
        u16* Od = (u16*)a.out + (dir ? (size_t)MLAT * 1024 : (size_t)0);
        for (int i = tid; i < 8192; i += 512) S[i] = 0.f;
        __syncthreads();
        for (int n = 0; n < 68; ++n) {
            const int c68 = n < 4 ? (dir ? 3 - n : n) : (dir ? 71 - n : n);
            const int base = c68 < 4 ? MLAT + b * 256 + c68 * 64 : b * 4096 + (c68 - 4) * 64;
            const unsigned char* rec = REC + (size_t)((((b * 8 + h) * 2 + dir) * 68) + c68) * REC_BYTES;
            const u16* Tb = (const u16*)rec; const u16* In = (const u16*)(rec + 8192); const float* rf = (const float*)(rec + 16384);
            for (int i = tid; i < 8192; i += 512) { const int p = i >> 7, dk = i & 127, t = dir ? 63 - p : p;
                kc[i] = bf2f(kd[(size_t)(base + t) * 1024 + h * 128 + dk]); qc[i] = bf2f(qd[(size_t)(base + t) * 1024 + h * 128 + dk]); }
            __syncthreads();
            float QS[8];
#pragma unroll
            for (int m = 0; m < 8; ++m) { const int i = rg + 8 * m, t = dir ? 63 - i : i; float ks = 0.f, qs = 0.f;
                for (int dk = 0; dk < 128; ++dk) { const float sv = BR(S[dk * 64 + dvl]); ks += kc[i * 128 + dk] * sv; qs += qc[i * 128 + dk] * sv; }
                QS[m] = qs; rr[i * 64 + dvl] = BR(bf2f(vd[(size_t)(base + t) * 1024 + h * 128 + half * 64 + dvl]) - rf[i] * ks); }
            __syncthreads();
#pragma unroll
            for (int m = 0; m < 8; ++m) { const int i = rg + 8 * m; float s = 0.f;
                for (int j = 0; j < 64; ++j) s += bf2f(Tb[i * 64 + j]) * rr[j * 64 + dvl];
                vn[i * 64 + dvl] = s; }
            __syncthreads();
#pragma unroll
            for (int m = 0; m < 8; ++m) { const int i = rg + 8 * m, t = dir ? 63 - i : i; float s = rf[i] * QS[m];
                for (int j = 0; j < 64; ++j) s += bf2f(In[i * 64 + j]) * BR(vn[j * 64 + dvl]);
                if (n >= 4) Od[(size_t)(base + t) * 1024 + h * 128 + half * 64 + dvl] = f2bf(s); }
            { const float d = rf[128];
#pragma unroll
                for (int e = 0; e < 16; ++e) { const int dk = rg * 16 + e; float s = d * S[dk * 64 + dvl];
                    for (int t = 0; t < 64; ++t) s += kc[t * 128 + dk] * BR(rf[64 + t] * vn[t * 64 + dvl]);
                    S[dk * 64 + dvl] = s; } }
            __syncthreads();
        }
    }
}
#endif

__device__ __forceinline__ void rope8(f32x4& v0, f32x4& v1, const f32x4 p0, const f32x4 p1, bool second, float pos, int f0) {
#pragma unroll
    for (int j = 0; j < 8; ++j) {
        const float invf = exp2f(-(float)(f0 + j) * (13.287712379549449f / 32.f));
        const float ang = pos * invf; const float c = __cosf(ang), s = __sinf(ang);
        const float mine = j < 4 ? v0[j & 3] : v1[j & 3], other = j < 4 ? p0[j & 3] : p1[j & 3];
        const float o = second ? (mine * c + other * s) : (mine * c - other * s);
        if (j < 4) v0[j & 3] = o; else v1[j & 3] = o;
    }
}
__device__ __forceinline__ void phase_attn_prep(const Args& a) {
    const int lane = tid_opaque() & 63, gw = blockIdx.x * 8 + (tid_opaque() >> 6), nw = gridDim.x * 8;
    u16* QA = (u16*)(a.ws + O_QA); const u16* KVA = (const u16*)(a.ws + O_KVA); u16* KALL = (u16*)(a.ws + O_KALL); u16* VALL = (u16*)(a.ws + O_VALL);
    const float* qn = a.in[18]; const float* kn = a.in[19];
    for (int row = gw; row < MALL; row += nw) {
        const bool lat = row < MLAT;
        const int t = lat ? (row & 4095) : ((row - MLAT) & 255); const int b = lat ? (row >> 12) : ((row - MLAT) >> 8);
        {
            const u16* kp = KVA + (size_t)row * 512 + 4 * lane;
            const u32x2 ku = *(const u32x2*)kp; const u32x2 vu = *(const u32x2*)(kp + 256);
            f32x4 kv = (f32x4){bf_lo(ku.x), bf_hi(ku.x), bf_lo(ku.y), bf_hi(ku.y)};
            const int d = 4 * (lane & 31);
            float ss = kv[0] * kv[0] + kv[1] * kv[1] + kv[2] * kv[2] + kv[3] * kv[3];
            ss = grp32_sum(ss); const float rs = rsqrtf(ss * (1.f / 128.f) + 1e-6f);
            kv = kv * rs * *(const f32x4*)(kn + d);
            f32x4 pp;
#pragma unroll
            for (int j = 0; j < 4; ++j) pp[j] = __shfl_xor(kv[j], 8);
            if (lat) { const bool second = (lane >> 3) & 1; const int axis = (lane >> 4) & 1; const float pos = axis ? (float)(t & 63) : (float)(t >> 6);
#pragma unroll
                for (int j = 0; j < 4; ++j) { const float invf = exp2f(-(float)((d & 31) + j) * (13.287712379549449f / 32.f)); const float ang = pos * invf; const float c = __cosf(ang), s = __sinf(ang);
                    kv[j] = second ? (kv[j] * c + pp[j] * s) : (kv[j] * c - pp[j] * s); } }
            const size_t orow = (size_t)b * 4352 + (lat ? 256 + t : t);
            u32x2 ko; ko.x = pk(kv[0], kv[1]); ko.y = pk(kv[2], kv[3]);
            *(u32x2*)(KALL + orow * 256 + 4 * lane) = ko; *(u32x2*)(VALL + orow * 256 + 4 * lane) = vu;
        }
    }
}

__device__ __forceinline__ void phase_attn(const Args& a, unsigned char* shm) {
    u16* QA = (u16*)(a.ws + O_QA); const u16* KALL = (const u16*)(a.ws + O_KALL); const u16* VALL = (const u16*)(a.ws + O_VALL);
    const int nblk = gridDim.x;
    for (int it = 0;; ++it) {
        int task;
        if (nblk == 256) { if (it >= 4) break; const int xcd = blockIdx.x & 7, slot = blockIdx.x >> 3; const int tix = it * 32 + slot; task = (xcd * 2 + (tix >> 6)) * 64 + (tix & 63); }
        else { task = blockIdx.x + it * nblk; if (task >= 1024) break; }
        const int grp = task >> 6, within = task & 63, b = grp >> 1, kvh = grp & 1, qb = within >> 2, g = within & 3, head = kvh * 4 + g;
        u16* Qb = QA + ((size_t)b * 4096 + qb * 256) * 1024 + head * 128;
        const u16* Kh = KALL + (size_t)b * 4352 * 256 + kvh * 128; const u16* Vh = VALL + (size_t)b * 4352 * 256 + kvh * 128;
        at::attn_dense_body<at::bf16>((const at::bf16*)Qb, (const at::bf16*)Kh, (const at::bf16*)Vh, Qb, 4352, (char*)shm, qb * 256, a.in[18]);
        __syncthreads();
    }
}

__device__ __forceinline__ void phase_merge_prep(const Args& a) {
    const int lane = tid_opaque() & 63, gw = blockIdx.x * 8 + (tid_opaque() >> 6), nw = gridDim.x * 8;
    const u16* OF = (const u16*)a.out; const u16* OB = OF + (size_t)MLAT * 1024; const u16* Z = (const u16*)(a.ws + O_Z); u16* A3 = (u16*)(a.ws + O_A3);
    const float* dnn = a.in[16];
    const int d = 8 * (lane & 15); const f32x4 g0 = *(const f32x4*)(dnn + d), g1 = *(const f32x4*)(dnn + d + 4);
    for (int row = gw; row < MLAT; row += nw) {
#pragma unroll
        for (int i = 0; i < 2; ++i) { const size_t off = (size_t)row * 1024 + 512 * i + 8 * lane;
            f32x4 f0, f1, b0, b1, z0, z1; unpk8(*(const u32x4*)(OF + off), f0, f1); unpk8(*(const u32x4*)(OB + off), b0, b1); unpk8(*(const u32x4*)(Z + off), z0, z1);
            f0 += b0; f1 += b1;
            float ss = 0.f;
#pragma unroll
            for (int j = 0; j < 4; ++j) ss += f0[j] * f0[j] + f1[j] * f1[j];
            ss = grp16_sum(ss); const float rs = rsqrtf(ss * (1.f / 128.f) + 1e-6f);
#pragma unroll
            for (int j = 0; j < 4; ++j) { f0[j] = f0[j] * rs * g0[j] * silu_f(z0[j]); f1[j] = f1[j] * rs * g1[j] * silu_f(z1[j]); }
            *(u32x4*)(A3 + off) = pk8(f0, f1); }
    }
}

__global__ void __launch_bounds__(512, 2) fwd_megakernel(Args a) {
    extern __shared__ __attribute__((aligned(16))) unsigned char shm[];
    cg::grid_group grid = cg::this_grid();
    volatile LAS unsigned* xst = (volatile LAS unsigned*)(shm + LDS_BYTES - 16);
    if (threadIdx.x == 0) { xst[0] = 0u; xst[1] = 0u; }
    __syncthreads();
    const xb::XcdBarrier XB = xb::xcd_barrier_post((unsigned*)(a.ws + O_BAR), xst);
#define GSYNC() xb::xcd_barrier(XB)
    unsigned char* ws = a.ws;
    const long gtid = (long)blockIdx.x * 512 + threadIdx.x, gth = (long)gridDim.x * 512;
    cvt_w<1>(a.in[8], 1024, 5632, (u16*)(ws + O_WGU1), 5632, gtid, gth);
    phase_mod(a, shm);
#if defined(EXP_SELFCHK)
    if (blockIdx.x == 0 && threadIdx.x == 0) *(unsigned*)(ws + O_MOD + 9 * 9216 * 4) = 0u;
#endif
    grid.sync();
    phase_h1(a);
    GSYNC();
    { EpiSwiglu E; E.O = (u16*)(ws + O_ACT); run_gemm(shm, (const u16*)(ws + O_A), (const u16*)(ws + O_WGU1), MALL, 5632, 1024, E); }
    { const int G = gridDim.x, rem = ((MALL / 256) * 22) % G;
      if (rem == 0 || (int)blockIdx.x >= rem) { const int f = rem == 0 ? 0 : rem; const long gt = (long)((int)blockIdx.x - f) * 512 + threadIdx.x, gn = (long)(G - f) * 512;
        cvt_w<0>(a.in[9], 2816, 1024, (u16*)(ws + O_WD1), 1024, gt, gn);
        cvt_w<2>(a.in[12], 1024, INW, (u16*)(ws + O_WIN1), 3328, gt, gn); } }
    GSYNC();
    { EpiPlain E; E.O = (u16*)(ws + O_Y1); E.ldc = 1024; run_gemm(shm, (const u16*)(ws + O_ACT), (const u16*)(ws + O_WD1), MLAT, 1024, 2816, E); }
    GSYNC();
    { EpiPlain E; E.O = (u16*)(ws + O_Y1) + (size_t)MLAT * 1024; E.ldc = 1024; run_gemm(shm, (const u16*)(ws + O_ACT) + (size_t)MLAT * FH, (const u16*)(ws + O_WD1), MCTX, 1024, 2816, E); }
    { const int G = gridDim.x, f = G > 32 ? 32 : 0;
      if ((int)blockIdx.x >= f) { const long gt = (long)((int)blockIdx.x - f) * 512 + threadIdx.x, gn = (long)(G - f) * 512;
        cvt_w<3>(a.in[12], 1024, INW, (u16*)(ws + O_WIN2), 4608, gt, gn); }
      phase_h2(a, 0, MLAT, f, G - f); }
    GSYNC();
    phase_h2(a, MLAT, MALL);
    GSYNC();
    { EpiIn1 E; E.q = (u16*)(ws + O_QRAW); E.k = (u16*)(ws + O_KRAW); E.v = (u16*)a.out; E.ba = (float*)(ws + O_BA); run_gemm(shm, (const u16*)(ws + O_A), (const u16*)(ws + O_WIN1), MALL, 3328, 1024, E); }
    GSYNC();
    phase_dn_prep(a);
    GSYNC();
#if defined(EXP_NAIVE_DN) && !defined(EXP_HYBRID)
    phase_dn_naive(a, shm);
#else
    phase_dn_pre(a, shm);
    GSYNC();
#if defined(EXP_VALU_SCAN)
    phase_dn_scan_valu(a, shm);
#else
    phase_dn_scan(a, shm);
#endif
#if defined(EXP_HYBRID)
    GSYNC();
    phase_dn_naive(a, shm);
#endif
#endif
    GSYNC();
    { EpiIn2 E; E.z = (u16*)(ws + O_Z); E.qa = (u16*)(ws + O_QA); E.kva = (u16*)(ws + O_KVA); E.gates = (u16*)(ws + O_GATES); run_gemm(shm, (const u16*)(ws + O_A), (const u16*)(ws + O_WIN2), MALL, 4608, 1024, E); }
    { const int G = gridDim.x, rem = ((MALL / 256) * 18) % G;
      if (rem == 0 || (int)blockIdx.x >= rem) { const int f = rem == 0 ? 0 : rem; const long gt = (long)((int)blockIdx.x - f) * 512 + threadIdx.x, gn = (long)(G - f) * 512;
        cvt_w<0>(a.in[17], 1024, 1024, (u16*)(ws + O_WDN), 1024, gt, gn);
        cvt_w<0>(a.in[20], 1024, 1024, (u16*)(ws + O_WAT), 1024, gt, gn);
        cvt_w<0>(a.in[21], 1024, 1024, (u16*)(ws + O_WOUT), 1024, gt, gn);
        cvt_w<1>(a.in[24], 1024, 5632, (u16*)(ws + O_WGU2), 5632, gt, gn);
        cvt_w<0>(a.in[25], 2816, 1024, (u16*)(ws + O_WD2), 1024, gt, gn); } }
    GSYNC();
    phase_attn_prep(a);
    GSYNC();
    phase_attn(a, shm);
    GSYNC();
    phase_merge_prep(a);
    GSYNC();
    { EpiMerge<0> E; E.gates = (const u16*)(ws + O_GATES); E.T = (u16*)(ws + O_T); run_gemm(shm, (const u16*)(ws + O_A3), (const u16*)(ws + O_WDN), MLAT, 1024, 1024, E); }
    { EpiMerge<1> E; E.gates = (const u16*)(ws + O_GATES); E.T = (u16*)(ws + O_T); run_gemm(shm, (const u16*)(ws + O_QA), (const u16*)(ws + O_WAT), MLAT, 1024, 1024, E); }
    GSYNC();
    { EpiPlain E; E.O = (u16*)(ws + O_Y); E.ldc = 1024; run_gemm(shm, (const u16*)(ws + O_T), (const u16*)(ws + O_WOUT), MLAT, 1024, 1024, E); }
    GSYNC();
    phase_h3(a);
    GSYNC();
    { EpiSwiglu E; E.O = (u16*)(ws + O_ACT2); run_gemm(shm, (const u16*)(ws + O_A5), (const u16*)(ws + O_WGU2), MLAT, 5632, 1024, E); }
    GSYNC();
    { EpiPlain E; E.O = (u16*)(ws + O_Y2); E.ldc = 1024; run_gemm(shm, (const u16*)(ws + O_ACT2), (const u16*)(ws + O_WD2), MLAT, 1024, 2816, E); }
    GSYNC();
    phase_out(a);
#if defined(EXP_SELFCHK)
    GSYNC();
    if (blockIdx.x == 0 && threadIdx.x == 0) { const unsigned f = *(volatile unsigned*)(ws + O_MOD + 9 * 9216 * 4);
        if (f & 8u) a.out[0] += 6.2e6f; if (f & 4u) a.out[1] += 6.2e5f; if (f & 2u) a.out[2] += 6.2e4f; if (f & 1u) a.out[3] += 6.2e3f; }
#endif
}

extern "C" void kernel_launch(void* const* d_in, const int* in_sizes, int n_in, void* d_out, int out_size, void* d_ws, size_t ws_size, hipStream_t stream) {
    static int grid_blocks = 0;
    if (grid_blocks == 0) {
        if (n_in != 26 || out_size != MLAT * 1024 || ws_size < WS_NEED) { fprintf(stderr, "kernel_launch: unexpected shapes: n_in %d out %d ws %zu (need %zu)\n", n_in, out_size, ws_size, (size_t)WS_NEED); grid_blocks = -1; return; }
        int dev = 0, cus = 0, per_cu = 0;
        hipGetDevice(&dev);
        hipDeviceGetAttribute(&cus, hipDeviceAttributeMultiprocessorCount, dev);
        if (hipFuncSetAttribute((const void*)fwd_megakernel, hipFuncAttributeMaxDynamicSharedMemorySize, LDS_BYTES) != hipSuccess) { fprintf(stderr, "kernel_launch: hipFuncSetAttribute failed\n"); grid_blocks = -1; return; }
        if (hipOccupancyMaxActiveBlocksPerMultiprocessor(&per_cu, (const void*)fwd_megakernel, 512, LDS_BYTES) != hipSuccess || per_cu < 1) { fprintf(stderr, "kernel_launch: occupancy query failed (%d)\n", per_cu); (void)hipGetLastError(); per_cu = 1; }
        grid_blocks = cus * per_cu;
    }
    if (grid_blocks < 0) return;
    if (hipMemsetAsync((char*)d_ws + O_BAR, 0, XCD_BAR_WORDS * sizeof(unsigned), stream) != hipSuccess) { fprintf(stderr, "kernel_launch: memset of the barrier words failed\n"); return; }
    Args a{};
    for (int i = 0; i < 26; ++i) a.in[i] = (const float*)d_in[i];
    a.out = (float*)d_out; a.ws = (unsigned char*)d_ws;
    void* args[] = {&a};
    hipError_t e = hipLaunchCooperativeKernel((const void*)fwd_megakernel, dim3(grid_blocks), dim3(512), args, LDS_BYTES, stream);
    if (e != hipSuccess) fprintf(stderr, "cooperative launch failed: %s (grid %d)\n", hipGetErrorString(e), grid_blocks);
}
```

```cpp
#include <hip/hip_runtime.h>
#include <hip/hip_bf16.h>
#include <hip/hip_cooperative_groups.h>
#include <cstdio>
#include <cstdint>
namespace cg = cooperative_groups;
__device__ __forceinline__ int tid_opaque() { int t = threadIdx.x; asm volatile("" : "+v"(t)); return t; }
namespace pg8 {
#define PG8_LAS __attribute__((address_space(3)))
typedef unsigned short bf16_t;
typedef short bf16x8 __attribute__((ext_vector_type(8)));
typedef float f32x4 __attribute__((ext_vector_type(4)));
typedef unsigned u32x4 __attribute__((ext_vector_type(4)));
constexpr int BM = 256, BK = 64, HALF = 128, HTB = HALF * BK * 2  , STAGE_BYTES = 8 * HTB, NXCD = 8, WGM = 8;

__host__ __device__ __forceinline__ int lds_byte(int r, int c) { const int st = (r >> 4) * 2 + (c >> 5), rr = r & 15, cc = c & 31, ob = rr * 64 + cc * 2; return st * 1024 + (ob ^ (((ob >> 9) & 1) << 5)); }
__host__ __device__ __forceinline__ void stage_rc(int b, int& R, int& C) { const int st = b / 1024, sb = b % 1024, swz = sb ^ (((sb >> 9) & 1) << 5); R = (st >> 1) * 16 + swz / 64; C = (st & 1) * 32 + (swz % 64) / 2; }
__host__ __device__ __forceinline__ int perm32(int rho) { const int n = rho >> 4, i = rho & 15; return 8 * (i >> 2) + 4 * n + (i & 3); }

struct Unit { int pm, pn; };
struct Gemm { const bf16_t* A; const bf16_t* Bt; int M, N, K; };

struct StaticOrder {
    int nM, nN, nwg, G, c;
    __host__ __device__ void init(int M, int N, int G_, int c_) { nM = M / BM; nN = N / BM; nwg = nM * nN; G = G_; c = c_; }
    __host__ __device__ bool next(int i, Unit& u) const {
        const long L = (long)i * G + c; if (L >= nwg) return false;
        int wgid = (int)L; { const int q = nwg / NXCD, r = nwg % NXCD, xcd = wgid % NXCD, off = wgid / NXCD; wgid = (xcd < r ? xcd * (q + 1) : r * (q + 1) + (xcd - r) * q) + off; }
        const int nig = WGM * nN, gid = wgid / nig, fm = gid * WGM, gsz = (nM - fm) < WGM ? (nM - fm) : WGM;
        u.pm = fm + ((wgid % nig) % gsz); u.pn = (wgid % nig) / gsz; return true;
    }
    __device__ __forceinline__ void a_ready(const Unit&) const {}
    __device__ __forceinline__ void done(const Unit&) const {}
};
__device__ __forceinline__ unsigned cvt_pk_bf16(float lo, float hi) { unsigned r; asm volatile("v_cvt_pk_bf16_f32 %0, %1, %2" : "=v"(r) : "v"(lo), "v"(hi)); return r; }

template <class Epi, class Sched, bool STAMP = false>
__device__ __forceinline__ void gemm_phase(PG8_LAS unsigned char* lds, const Gemm g, const Sched& S, const Epi& E, unsigned long long* stamps) {
    const int tid = tid_opaque(), wid = __builtin_amdgcn_readfirstlane(tid >> 6), lane = tid & 63, wr = wid >> 2, wc = wid & 3, fr = lane & 15, fq = lane >> 4;
    const int K = g.K, nt = K / BK;
    int ts_lo = 0, ts_hi = 0, nts = 0; const unsigned long long rt_entry = STAMP ? (unsigned long long)wall_clock64() : 0ull;
#define PG8_STAMP() do { if (STAMP && wid == 0 && nts < 64) { const unsigned long long _c = (unsigned long long)clock64(); \
        ts_lo = (lane == nts) ? (int)(unsigned)_c : ts_lo; ts_hi = (lane == nts) ? (int)(unsigned)(_c >> 32) : ts_hi; ++nts; } } while (0)
    PG8_STAMP();
    unsigned voffA[2], voffB[2];
#pragma unroll
    for (int i = 0; i < 2; ++i) { int R, C; stage_rc(tid * 16 + i * 8192, R, C); const int Rb = Epi::PERM ? ((R & ~31) + perm32(R & 31)) : R;
        voffA[i] = (unsigned)(R * K + C) * 2u; voffB[i] = (unsigned)(Rb * K + C) * 2u; }
    const size_t kstep = (size_t)(BK * 2);
    const size_t hstep = (size_t)HALF * K * 2;
    const size_t tstep = 2 * hstep;
    const unsigned ldsw = (unsigned)wid * 1024u;
    const int aoff = lds_byte(wr * 64 + fr, fq * 8), boff = lds_byte(wc * 32 + fr, fq * 8);
#define PG8_SA(b, h) (((b) * 2 + (h)) * HTB)
#define PG8_SB(b, h) ((4 + (b) * 2 + (h)) * HTB)
#define PG8_STAGE(bufoff, gbase, voff) do { _Pragma("unroll") for (int _i = 0; _i < 2; ++_i) \
        __builtin_amdgcn_global_load_lds((const unsigned*)((const char*)(gbase) + (voff)[_i]), (PG8_LAS unsigned*)(lds + (bufoff) + ldsw + _i * 8192), 16, 0, 0); } while (0)
#define PG8_LDA(dst, b, h) do { _Pragma("unroll") for (int m = 0; m < 4; ++m) _Pragma("unroll") for (int k = 0; k < 2; ++k) dst[m][k] = *(const PG8_LAS bf16x8*)(lds + PG8_SA(b, h) + aoff + m * 2048 + k * 1024); } while (0)
#define PG8_LDB(dst, b, h) do { _Pragma("unroll") for (int n = 0; n < 2; ++n) _Pragma("unroll") for (int k = 0; k < 2; ++k) dst[n][k] = *(const PG8_LAS bf16x8*)(lds + PG8_SB(b, h) + boff + n * 2048 + k * 1024); } while (0)
#define PG8_MMA(ai, bj, At, Bt) do { __builtin_amdgcn_s_setprio(1); _Pragma("unroll") for (int m = 0; m < 4; ++m) _Pragma("unroll") for (int n = 0; n < 2; ++n) _Pragma("unroll") for (int k = 0; k < 2; ++k) \
        acc[ai][bj][m][n] = __builtin_amdgcn_mfma_f32_16x16x32_bf16(Bt[n][k], At[m][k], acc[ai][bj][m][n], 0, 0, 0); __builtin_amdgcn_s_setprio(0); } while (0)
#define PG8_WAIT_V(n) asm volatile("s_waitcnt vmcnt(" #n ")" ::: "memory")
#define PG8_WAIT_L(n) asm volatile("s_waitcnt lgkmcnt(" #n ")" ::: "memory")
#define PG8_BAR __builtin_amdgcn_s_barrier()
#define PG8_SCHED __builtin_amdgcn_sched_barrier(0)
    Unit cur, nxt; int ui = 0;
    if (!S.next(0, cur)) return;
    f32x4 acc[2][2][4][2];
#pragma unroll
    for (int a = 0; a < 2; ++a)
#pragma unroll
        for (int b = 0; b < 2; ++b)
#pragma unroll
            for (int m = 0; m < 4; ++m)
#pragma unroll
                for (int n = 0; n < 2; ++n) acc[a][b][m][n] = (f32x4){0.f, 0.f, 0.f, 0.f};
    bf16x8 At[4][2], B0[2][2], B1[2][2];
    const char* cA = (const char*)g.A + (size_t)cur.pm * tstep; const char* cB = (const char*)g.Bt + (size_t)cur.pn * tstep;
    S.a_ready(cur);
    PG8_STAGE(PG8_SB(0, 0), cB, voffB); PG8_STAGE(PG8_SA(0, 0), cA, voffA); PG8_STAGE(PG8_SB(0, 1), cB + hstep, voffB); PG8_STAGE(PG8_SA(0, 1), cA + hstep, voffA);
    if (wr == 1) PG8_BAR;
    PG8_WAIT_V(4); PG8_BAR;
    PG8_STAGE(PG8_SB(1, 0), cB + kstep, voffB); PG8_STAGE(PG8_SA(1, 0), cA + kstep, voffA); PG8_STAGE(PG8_SB(1, 1), cB + hstep + kstep, voffB);
    PG8_WAIT_V(6); PG8_BAR;
    PG8_STAMP();
    for (;;) {
        const bool has_next = S.next(ui + 1, nxt);
        const char* nA = has_next ? (const char*)g.A + (size_t)nxt.pm * tstep : cA; const char* nB = has_next ? (const char*)g.Bt + (size_t)nxt.pn * tstep : cB;
        for (int t = 0; t < nt; t += 2) {
            const bool last = (t == nt - 2);
            const char* a1 = cA + (size_t)(t + 1) * kstep;
            const char* a2 = last ? nA : cA + (size_t)(t + 2) * kstep; const char* b2 = last ? nB : cB + (size_t)(t + 2) * kstep;
            const char* a3 = a2 + kstep; const char* b3 = b2 + kstep;
            if (last && has_next) S.a_ready(nxt);
            PG8_LDB(B0, 0, 0); PG8_SCHED; PG8_LDA(At, 0, 0); PG8_STAGE(PG8_SA(1, 1), a1 + hstep, voffA);
            PG8_WAIT_L(8); PG8_BAR; PG8_WAIT_L(0); PG8_MMA(0, 0, At, B0); PG8_BAR; PG8_SCHED;
            PG8_LDB(B1, 0, 1); PG8_STAGE(PG8_SB(0, 0), b2, voffB);
            PG8_BAR; PG8_WAIT_L(0); PG8_MMA(0, 1, At, B1); PG8_BAR;
            PG8_LDA(At, 0, 1); PG8_STAGE(PG8_SA(0, 0), a2, voffA);
            PG8_BAR; PG8_WAIT_L(0); PG8_MMA(1, 0, At, B0); PG8_BAR; PG8_SCHED;
            PG8_STAGE(PG8_SB(0, 1), b2 + hstep, voffB);
            PG8_WAIT_V(6); PG8_BAR; PG8_MMA(1, 1, At, B1); PG8_BAR;
            PG8_LDB(B0, 1, 0); PG8_SCHED; PG8_LDA(At, 1, 0); PG8_STAGE(PG8_SA(0, 1), a2 + hstep, voffA);
            PG8_WAIT_L(8); PG8_BAR; PG8_WAIT_L(0); PG8_MMA(0, 0, At, B0); PG8_BAR; PG8_SCHED;
            PG8_LDB(B1, 1, 1); PG8_STAGE(PG8_SB(1, 0), b3, voffB);
            PG8_BAR; PG8_WAIT_L(0); PG8_MMA(0, 1, At, B1); PG8_BAR;
            PG8_LDA(At, 1, 1); PG8_STAGE(PG8_SA(1, 0), a3, voffA);
            PG8_BAR; PG8_WAIT_L(0); PG8_MMA(1, 0, At, B0); PG8_BAR; PG8_SCHED;
            PG8_STAGE(PG8_SB(1, 1), b3 + hstep, voffB);
            PG8_WAIT_V(6); PG8_BAR; PG8_MMA(1, 1, At, B1); PG8_BAR;
        }
        PG8_STAMP();
        if constexpr (!Epi::AFTER_DRAIN) { E(acc, cur, wr, wc, fr, fq); S.done(cur); }
        PG8_STAMP();
        if (!has_next) break;
#pragma unroll
        for (int a = 0; a < 2; ++a)
#pragma unroll
            for (int b = 0; b < 2; ++b)
#pragma unroll
                for (int m = 0; m < 4; ++m)
#pragma unroll
                    for (int n = 0; n < 2; ++n) acc[a][b][m][n] = (f32x4){0.f, 0.f, 0.f, 0.f};
        cur = nxt; cA = nA; cB = nB; ++ui;
    }
    PG8_WAIT_V(0);
    if (wr == 0) PG8_BAR;
    PG8_BAR;
    if constexpr (Epi::AFTER_DRAIN) { E.fused(acc, cur, wr, wc, fr, fq, lds, wid, lane); S.done(cur); }
    PG8_STAMP();
    if (STAMP && wid == 0) { stamps[lane] = lane < nts ? (((unsigned long long)(unsigned)ts_hi << 32) | (unsigned)ts_lo) : 0ull;
        if (lane == 62) stamps[62] = rt_entry; if (lane == 63) stamps[63] = (unsigned long long)wall_clock64(); }
#undef PG8_STAMP
#undef PG8_SA
#undef PG8_SB
#undef PG8_STAGE
#undef PG8_LDA
#undef PG8_LDB
#undef PG8_MMA
#undef PG8_WAIT_V
#undef PG8_WAIT_L
#undef PG8_BAR
#undef PG8_SCHED
}
}
namespace xb {

#define XB_TMO      128
#define XB_XCNT(j)  (256  + 64 * (j))
#define XB_XSUB(j)  (1280 + 64 * (j))
#define XB_XGEN(j)  (2304 + 64 * (j))
#define XB_TOP      3328
#define XB_TOPGEN   3392
#define XCD_BAR_WORDS 3456
#define XB_SPIN_CAP (1u << 18)
#define LAS __attribute__((address_space(3)))

__device__ __forceinline__ unsigned xb_ld(unsigned* p)              { return __hip_atomic_load(p, __ATOMIC_RELAXED, __HIP_MEMORY_SCOPE_AGENT); }
__device__ __forceinline__ unsigned xb_add(unsigned* p, unsigned v) { return __hip_atomic_fetch_add(p, v, __ATOMIC_RELAXED, __HIP_MEMORY_SCOPE_AGENT); }
__device__ __forceinline__ unsigned xb_xcc_id() { return (unsigned)__builtin_amdgcn_s_getreg((3 << 11) | 20) & 0xFu; }
#define XB_SPIN(cond, bar) do { unsigned _sp = 0; while (cond) { __builtin_amdgcn_s_sleep(1); \
    if ((++_sp & 255u) == 0u) { if (xb_ld(&(bar)[XB_TMO])) break; if (_sp > XB_SPIN_CAP) { atomicAdd(&(bar)[XB_TMO], 1u); break; } } } } while (0)

struct XcdBarrier {
    unsigned* bar; unsigned x;
    volatile LAS unsigned* st;
};

__device__ __forceinline__ XcdBarrier xcd_barrier_post(unsigned* bar, volatile LAS unsigned* st) {
    XcdBarrier b; b.bar = bar; b.x = xb_xcc_id(); b.st = st;
    if (threadIdx.x == 0) (void)xb_add(&bar[XB_XCNT(b.x)], 1u);
    return b;
}
__device__ __forceinline__ void xcd_barrier_complete(unsigned* bar, unsigned x, unsigned& nloc, unsigned& nx) {
    const unsigned G = gridDim.x * gridDim.y * gridDim.z;
    unsigned sum, cnt, mine, sp = 0u;
    for (;;) {
        sum = 0u; cnt = 0u; mine = 0u;
#pragma unroll
        for (unsigned j = 0; j < 16; ++j) { const unsigned c = xb_ld(&bar[XB_XCNT(j)]); sum += c; cnt += (c > 0u) ? 1u : 0u; mine = (j == x) ? c : mine; }
        if (sum == G) break;
        __builtin_amdgcn_s_sleep(1);
        if ((++sp & 255u) == 0u) { if (xb_ld(&bar[XB_TMO])) break; if (sp > XB_SPIN_CAP) { atomicAdd(&bar[XB_TMO], 1u); break; } }
    }
    nloc = mine > 0u ? mine : 1u; nx = cnt > 0u ? cnt : 1u;
}

__device__ __forceinline__ void xcd_barrier(const XcdBarrier& b) {
    asm volatile("s_waitcnt vmcnt(0)" ::: "memory");
    __syncthreads();
    if (threadIdx.x == 0) {
        unsigned* bar = b.bar;
        __builtin_amdgcn_s_waitcnt(0);
        unsigned nloc = b.st[0], nx = b.st[1];
        if (nloc == 0u) { xcd_barrier_complete(bar, b.x, nloc, nx); b.st[0] = nloc; b.st[1] = nx; }
        const unsigned old = xb_add(&bar[XB_XSUB(b.x)], 1u);
        const unsigned gen = old / nloc;
        if (old + 1u == (gen + 1u) * nloc) {
            __builtin_amdgcn_fence(__ATOMIC_RELEASE, "agent");
            asm volatile("s_waitcnt vmcnt(0)" ::: "memory");
            const unsigned og = xb_add(&bar[XB_TOP], 1u);
            const unsigned tg = og / nx;
            if (og + 1u == (tg + 1u) * nx) xb_add(&bar[XB_TOPGEN], 1u);
            else XB_SPIN(xb_ld(&bar[XB_TOPGEN]) == tg, bar);
            __builtin_amdgcn_fence(__ATOMIC_ACQUIRE, "agent");
            xb_add(&bar[XB_XGEN(b.x)], 1u);
            asm volatile("s_waitcnt vmcnt(0)" ::: "memory");
        } else {
            XB_SPIN(xb_ld(&bar[XB_XGEN(b.x)]) == gen, bar);
            __builtin_amdgcn_fence(__ATOMIC_ACQUIRE, "agent");
            asm volatile("s_waitcnt vmcnt(0)" ::: "memory");
        }
    }
    __syncthreads();
}

}
namespace at {
using bf16 = __hip_bfloat16;
constexpr int   D = 128, NW = 8, QBLK = 32, KVBLK = 64;
constexpr float SCALE = 0.088388347648318440f;
constexpr float THR = 8.f;
constexpr int SDEPTH = 1;
constexpr int LDQ = 1024, LDK = 256, LDO = 1024;
constexpr size_t SHM_V = KVBLK * D * 2, SHM_K = KVBLK * D * 2, SHM_ATTN = 2 * SHM_V + 2 * SHM_K + NW * 64 * 4;
__device__ __forceinline__ unsigned short f2bf_rne(float f) { unsigned u = __float_as_uint(f); u += 0x7FFFu + ((u >> 16) & 1u); return (unsigned short)(u >> 16); }
using bf16x8 = __attribute__((ext_vector_type(8))) short;
using s16x4  = __attribute__((ext_vector_type(4))) short;
using f32x16 = __attribute__((ext_vector_type(16))) float;
using f32x8  = __attribute__((ext_vector_type(8))) float;
using u32x4  = __attribute__((ext_vector_type(4))) unsigned;
#define KSWZ(row, colB) ((row) * 256 + ((colB) ^ (((row) & 7) << 4)))
#define SBAR() __builtin_amdgcn_sched_barrier(0)
__device__ __forceinline__ int crow(int r, int hi) { return (r & 3) + 8 * (r >> 2) + 4 * hi; }
__device__ __forceinline__ unsigned cvtpk(float lo, float hi) {
  unsigned r; asm volatile("v_cvt_pk_bf16_f32 %0, %1, %2" : "=v"(r) : "v"(lo), "v"(hi)); return r;
}
template <typename TIn> struct Stage;
template <> struct Stage<bf16>  { using T = bf16x8;
  __device__ static __forceinline__ T ld8(const bf16* p) { return *reinterpret_cast<const bf16x8*>(p); }
  __device__ static __forceinline__ bf16x8 tobf(T x) { return x; } };
template <> struct Stage<float> { using T = f32x8;
  __device__ static __forceinline__ T ld8(const float* p) { return *reinterpret_cast<const f32x8*>(p); }
  __device__ static __forceinline__ bf16x8 tobf(T x) {
    u32x4 w = {cvtpk(x[0], x[1]), cvtpk(x[2], x[3]), cvtpk(x[4], x[5]), cvtpk(x[6], x[7])}; return *reinterpret_cast<bf16x8*>(&w); } };

__device__ __forceinline__ void partialSM(f32x16& p0, f32x16& p1, float& m_reg, float& mn, float& alpha) {
  constexpr float C = SCALE * 1.4426950408889634f;
  float pmax = p0[0]; for (int r = 1; r < 16; ++r) pmax = fmaxf(pmax, p0[r]); for (int r = 0; r < 16; ++r) pmax = fmaxf(pmax, p1[r]);
  { auto rr = __builtin_amdgcn_permlane32_swap(__float_as_uint(pmax), __float_as_uint(pmax), false, false);
    pmax = fmaxf(__uint_as_float(rr[0]), __uint_as_float(rr[1])); }
  if (__builtin_expect(__all(pmax - m_reg <= THR / SCALE), 1)) { mn = m_reg; alpha = 1.f; }
  else { mn = fmaxf(m_reg, pmax); alpha = __builtin_amdgcn_exp2f((m_reg - mn) * C); m_reg = mn; }
  float mnC = -mn * C;
  for (int r = 0; r < 16; ++r) p0[r] = fmaf(p0[r], C, mnC); for (int r = 0; r < 16; ++r) p1[r] = fmaf(p1[r], C, mnC);
  for (int r = 0; r < 16; ++r) p0[r] = __builtin_amdgcn_exp2f(p0[r]);
}
__device__ __forceinline__ void finishSM(f32x16& p0, f32x16& p1, float alpha, float& l_reg, bf16x8& pa0, bf16x8& pa1, bf16x8& pa2, bf16x8& pa3) {
  for (int r = 0; r < 16; ++r) p1[r] = __builtin_amdgcn_exp2f(p1[r]);
  float ps = 0; for (int r = 0; r < 16; ++r) ps += p0[r]; for (int r = 0; r < 16; ++r) ps += p1[r];
  { auto rr = __builtin_amdgcn_permlane32_swap(__float_as_uint(ps), __float_as_uint(ps), false, false);
    ps = __uint_as_float(rr[0]) + __uint_as_float(rr[1]); }
  l_reg = l_reg * alpha + ps;
#define PK4(P, BASE, OUT) do { unsigned a0 = cvtpk(P[BASE + 0], P[BASE + 1]), a1 = cvtpk(P[BASE + 2], P[BASE + 3]);   \
    unsigned b0 = cvtpk(P[BASE + 4], P[BASE + 5]), b1 = cvtpk(P[BASE + 6], P[BASE + 7]);                              \
    auto r0 = __builtin_amdgcn_permlane32_swap(a0, b0, false, false); auto r1 = __builtin_amdgcn_permlane32_swap(a1, b1, false, false); \
    u32x4 w = {r0[0], r1[0], r0[1], r1[1]}; OUT = *reinterpret_cast<bf16x8*>(&w); } while (0)
  PK4(p0, 0, pa0); PK4(p0, 8, pa1); PK4(p1, 0, pa2); PK4(p1, 8, pa3);
#undef PK4
}
__device__ __forceinline__ void qkt(f32x16& p0, f32x16& p1, const bf16* Ks, const bf16x8* qr, int r32, int hi) {
  p0 = f32x16{}; p1 = f32x16{};
  for (int d0 = 0; d0 < 8; ++d0) { int cb = (d0 * 16 + hi * 8) * 2;
    bf16x8 b0 = *reinterpret_cast<const bf16x8*>((const char*)Ks + KSWZ(r32, cb));
    bf16x8 b1 = *reinterpret_cast<const bf16x8*>((const char*)Ks + KSWZ(32 + r32, cb));
    p0 = __builtin_amdgcn_mfma_f32_32x32x16_bf16(b0, qr[d0], p0, 0, 0, 0);
    p1 = __builtin_amdgcn_mfma_f32_32x32x16_bf16(b1, qr[d0], p1, 0, 0, 0); }
}
__device__ __forceinline__ int v_st(int k, int c) { const int kk = (k & ~0xC) | ((k & 4) << 1) | ((k & 8) >> 1); return ((kk >> 3) * 4 + (c >> 5)) * 512 + ((kk & 7) * 32 + (c & 31)) * 2; }
__device__ __forceinline__ int v_rd_base(int lane) { return ((lane & 3) << 3) | (((lane >> 2) & 3) << 6) | (((lane >> 4) & 1) << 5) | (((lane >> 5) & 1) << 8); }
constexpr int v_rd_off(int d0, int ks, int half) { return d0 * 512 + ks * 4096 + half * 2048; }
template <int OFF> __device__ __forceinline__ s16x4 tr_read(int vb) {
  s16x4 r; asm volatile("ds_read_b64_tr_b16 %0, %1 offset:%2" : "=&v"(r) : "v"(vb), "i"(OFF) : "memory"); return r;
}
template <int D0> __device__ __forceinline__ void pv_one(f32x16& od, int vb, bf16x8 pa0, bf16x8 pa1, bf16x8 pa2, bf16x8 pa3) {
  const s16x4 l0 = tr_read<v_rd_off(D0, 0, 0)>(vb), h0 = tr_read<v_rd_off(D0, 0, 1)>(vb), l1 = tr_read<v_rd_off(D0, 1, 0)>(vb), h1 = tr_read<v_rd_off(D0, 1, 1)>(vb);
  const s16x4 l2 = tr_read<v_rd_off(D0, 2, 0)>(vb), h2 = tr_read<v_rd_off(D0, 2, 1)>(vb), l3 = tr_read<v_rd_off(D0, 3, 0)>(vb), h3 = tr_read<v_rd_off(D0, 3, 1)>(vb);
  asm volatile("s_waitcnt lgkmcnt(0)" ::: "memory"); SBAR();
#define PK(L, H) (bf16x8){L[0], L[1], L[2], L[3], H[0], H[1], H[2], H[3]}
  od = __builtin_amdgcn_mfma_f32_32x32x16_bf16(pa0, PK(l0, h0), od, 0, 0, 0);
  od = __builtin_amdgcn_mfma_f32_32x32x16_bf16(pa1, PK(l1, h1), od, 0, 0, 0);
  od = __builtin_amdgcn_mfma_f32_32x32x16_bf16(pa2, PK(l2, h2), od, 0, 0, 0);
  od = __builtin_amdgcn_mfma_f32_32x32x16_bf16(pa3, PK(l3, h3), od, 0, 0, 0);
#undef PK
}
__device__ __forceinline__ void pv_d0(f32x16* o, int vb, bf16x8 pa0, bf16x8 pa1, bf16x8 pa2, bf16x8 pa3) {
  pv_one<0>(o[0], vb, pa0, pa1, pa2, pa3); pv_one<1>(o[1], vb, pa0, pa1, pa2, pa3); pv_one<2>(o[2], vb, pa0, pa1, pa2, pa3); pv_one<3>(o[3], vb, pa0, pa1, pa2, pa3);
}

template <typename TQ>
__device__ __forceinline__ void attn_dense_body(const TQ* __restrict__ Qb, const bf16* __restrict__ Kh, const bf16* __restrict__ Vh,
                                                unsigned short* Ob, int seq, char* lds, int t_base, const float* __restrict__ qn) {
  using St = Stage<bf16>; using SQ = Stage<TQ>;
  const int tid = tid_opaque(), wid = tid >> 6, lane = tid & 63, r32 = lane & 31, hi = lane >> 5;
  bf16* V_lds = (bf16*)lds; bf16* K_lds = (bf16*)(lds + 2 * SHM_V);
  float* ws = (float*)(lds + 2 * SHM_V + 2 * SHM_K) + wid * 64; float* li_l = ws; float* al_l = ws + 32;
  float m_reg = -1e30f, l_reg = 0; f32x16 o[4] = {}; bf16x8 qr[8];
  const TQ* Qw = Qb + (long)(wid * QBLK + r32) * LDQ + hi * 8;
#pragma unroll
  for (int d0 = 0; d0 < 8; ++d0) qr[d0] = SQ::tobf(SQ::ld8(Qw + d0 * 16));
  {
    const int tq = t_base + wid * QBLK + r32;
    float v[8][8]; float ss = 0.f;
#pragma unroll
    for (int d0 = 0; d0 < 8; ++d0)
#pragma unroll
      for (int j = 0; j < 8; ++j) { v[d0][j] = __uint_as_float(((unsigned)(unsigned short)qr[d0][j]) << 16); ss += v[d0][j] * v[d0][j]; }
    ss += __shfl_xor(ss, 32);
    const float rs = rsqrtf(ss * (1.f / 128.f) + 1e-6f);
#pragma unroll
    for (int d0 = 0; d0 < 8; ++d0) { const float4 g0 = *reinterpret_cast<const float4*>(qn + d0 * 16 + hi * 8), g1 = *reinterpret_cast<const float4*>(qn + d0 * 16 + hi * 8 + 4);
      v[d0][0] *= rs * g0.x; v[d0][1] *= rs * g0.y; v[d0][2] *= rs * g0.z; v[d0][3] *= rs * g0.w; v[d0][4] *= rs * g1.x; v[d0][5] *= rs * g1.y; v[d0][6] *= rs * g1.z; v[d0][7] *= rs * g1.w; }
#pragma unroll
    for (int ax = 0; ax < 2; ++ax) { const float pos = ax ? (float)(tq & 63) : (float)(tq >> 6);
#pragma unroll
      for (int e = 0; e < 2; ++e)
#pragma unroll
        for (int j = 0; j < 8; ++j) { const int f = e * 16 + hi * 8 + j; const float ang = pos * exp2f(-(float)f * (13.287712379549449f / 32.f)); const float c = __cosf(ang), s = __sinf(ang);
          const float x1 = v[ax * 4 + e][j], x2 = v[ax * 4 + 2 + e][j]; v[ax * 4 + e][j] = x1 * c - x2 * s; v[ax * 4 + 2 + e][j] = x2 * c + x1 * s; } }
#pragma unroll
    for (int d0 = 0; d0 < 8; ++d0) { u32x4 w = {cvtpk(v[d0][0], v[d0][1]), cvtpk(v[d0][2], v[d0][3]), cvtpk(v[d0][4], v[d0][5]), cvtpk(v[d0][6], v[d0][7])}; qr[d0] = *reinterpret_cast<bf16x8*>(&w); }
  }
  const int sr = tid >> 4, sc = (tid & 15) * 8, vst0 = v_st(sr, sc), vst1 = v_st(32 + sr, sc);
  const int vb0 = (int)(uintptr_t)V_lds + v_rd_base(lane);
  struct { typename St::T vs0, vs1, ks0, ks1; } sr_[SDEPTH];
#define SLOAD(i, k0) do { sr_[i].vs0 = St::ld8(&Vh[(long)((k0) + sr) * LDK + sc]); sr_[i].vs1 = St::ld8(&Vh[(long)((k0) + 32 + sr) * LDK + sc]); \
    sr_[i].ks0 = St::ld8(&Kh[(long)((k0) + sr) * LDK + sc]); sr_[i].ks1 = St::ld8(&Kh[(long)((k0) + 32 + sr) * LDK + sc]); } while (0)
#define SWRITE(b, i) do { *(bf16x8*)((char*)V_lds + (b) * SHM_V + vst0) = St::tobf(sr_[i].vs0);          \
    *(bf16x8*)((char*)V_lds + (b) * SHM_V + vst1) = St::tobf(sr_[i].vs1); int kc = sc * 2;               \
    *(bf16x8*)((char*)K_lds + (b) * SHM_K + KSWZ(sr, kc)) = St::tobf(sr_[i].ks0);                       \
    *(bf16x8*)((char*)K_lds + (b) * SHM_K + KSWZ(32 + sr, kc)) = St::tobf(sr_[i].ks1); } while (0)
#define SWAIT() do { if constexpr (SDEPTH == 2) asm volatile("s_waitcnt vmcnt(4)" ::: "memory"); else asm volatile("s_waitcnt vmcnt(0)" ::: "memory"); } while (0)
#define RESC(a) do { if (__any((a) < 1.f)) { if (hi == 0) al_l[r32] = (a); asm volatile("s_waitcnt lgkmcnt(0)" ::: "memory"); \
    for (int d = 0; d < 4; ++d) for (int r = 0; r < 16; ++r) o[d][r] *= al_l[crow(r, hi)]; } } while (0)
  f32x16 pA0, pA1, pB0, pB1; float mnA, mnB, alA, alB; bf16x8 pa0, pa1, pa2, pa3; const int NT = seq / KVBLK;
  constexpr int SE = 0, SO = SDEPTH - 1;
  SLOAD(SE, 0); asm volatile("s_waitcnt vmcnt(0)" ::: "memory"); SWRITE(0, SE); __syncthreads();
  qkt(pA0, pA1, K_lds, qr, r32, hi); partialSM(pA0, pA1, m_reg, mnA, alA);
  SLOAD(SO, KVBLK); if constexpr (SDEPTH == 2) { if (2 < NT) SLOAD(SE, 2 * KVBLK); }
  SWAIT(); SWRITE(1, SO); __syncthreads();
  for (int j = 1; j + 1 < NT; j += 2) {
    SBAR(); qkt(pB0, pB1, (bf16*)((char*)K_lds + SHM_K), qr, r32, hi);
    finishSM(pA0, pA1, alA, l_reg, pa0, pa1, pa2, pa3); SBAR();
    SLOAD(SO, (j + SDEPTH) * KVBLK); SBAR();
    pv_d0(o, vb0, pa0, pa1, pa2, pa3); partialSM(pB0, pB1, m_reg, mnB, alB);
    __syncthreads(); SWAIT(); SWRITE(0, SE);
    RESC(alB); __syncthreads();
    SBAR(); qkt(pA0, pA1, K_lds, qr, r32, hi);
    finishSM(pB0, pB1, alB, l_reg, pa0, pa1, pa2, pa3); SBAR();
    if (SDEPTH == 1 || j + 3 < NT) SLOAD(SE, (j + 1 + SDEPTH) * KVBLK); SBAR();
    pv_d0(o, vb0 + (int)SHM_V, pa0, pa1, pa2, pa3); partialSM(pA0, pA1, m_reg, mnA, alA);
    __syncthreads(); SWAIT(); SWRITE(1, SO);
    RESC(alA); __syncthreads();
  }
  SBAR(); qkt(pB0, pB1, (bf16*)((char*)K_lds + SHM_K), qr, r32, hi);
  finishSM(pA0, pA1, alA, l_reg, pa0, pa1, pa2, pa3); SBAR();
  pv_d0(o, vb0, pa0, pa1, pa2, pa3); partialSM(pB0, pB1, m_reg, mnB, alB);
  __syncthreads(); RESC(alB);
  finishSM(pB0, pB1, alB, l_reg, pa0, pa1, pa2, pa3); SBAR();
  pv_d0(o, vb0 + (int)SHM_V, pa0, pa1, pa2, pa3);
  if (hi == 0) li_l[r32] = l_reg; asm volatile("s_waitcnt lgkmcnt(0)" ::: "memory");
  float rli[16];
#pragma unroll
  for (int r = 0; r < 16; ++r) rli[r] = __builtin_amdgcn_rcpf(li_l[crow(r, hi)]);
  unsigned short* Ow = Ob + (long)(wid * QBLK) * LDO;
#pragma unroll
  for (int r = 0; r < 16; ++r) { int orow = crow(r, hi);
    for (int d0 = 0; d0 < 4; ++d0) Ow[(long)orow * LDO + d0 * 32 + r32] = f2bf_rne(o[d0][r] * rli[r]); }
#undef SLOAD
#undef SWRITE
#undef SWAIT
#undef RESC
}

}

typedef unsigned short u16;
typedef float f32x4 __attribute__((ext_vector_type(4)));
typedef unsigned u32x4 __attribute__((ext_vector_type(4)));
typedef unsigned u32x2 __attribute__((ext_vector_type(2)));
typedef short s16x8 __attribute__((ext_vector_type(8)));

constexpr int MLAT = 32768, MCTX = 2048, MALL = 34816, FH = 2816, INW = 7712, NMODC = 9216;
constexpr int LDS_BYTES = 147456;
constexpr size_t MiB = 1048576;
constexpr size_t O_WGU1 = 0;
constexpr size_t O_WD1  = O_WGU1 + (size_t)5632 * 1024 * 2;
constexpr size_t O_WGU2 = O_WD1 + (size_t)1024 * 2816 * 2;
constexpr size_t O_WD2  = O_WGU2 + (size_t)5632 * 1024 * 2;
constexpr size_t O_WIN1 = O_WD2 + (size_t)1024 * 2816 * 2;
constexpr size_t O_WIN2 = O_WIN1 + (size_t)3328 * 1024 * 2;
constexpr size_t O_WDN  = O_WIN2 + (size_t)4608 * 1024 * 2;
constexpr size_t O_WAT  = O_WDN + (size_t)1024 * 1024 * 2;
constexpr size_t O_WOUT = O_WAT + (size_t)1024 * 1024 * 2;
constexpr size_t O_MOD  = O_WOUT + (size_t)1024 * 1024 * 2;
static_assert(O_MOD + 9 * 9216 * 4 + 64 <= 55 * MiB + 512 * 1024, "persistent region");
constexpr size_t O_Y1 = 56 * MiB;
constexpr size_t O_A = 124 * MiB;
constexpr size_t O_ACT = 192 * MiB;
constexpr size_t O_QRAW = 192 * MiB, O_KRAW = 260 * MiB, O_REC = 192 * MiB, O_QD = 340 * MiB, O_KD = 408 * MiB, O_BA = 476 * MiB;
constexpr int VD_SPLIT = 20224;
constexpr size_t O_VD1 = 0, O_VD2 = 480 * MiB + 512 * 1024;
static_assert((size_t)VD_SPLIT * 2048 <= O_WIN2 && O_VD2 + (size_t)(MALL - VD_SPLIT) * 2048 <= 512 * MiB && O_VD2 >= O_BA + (size_t)MALL * 32 * 4, "v_d split regions");

constexpr size_t O_QA = 192 * MiB, O_KVA = 256 * MiB, O_GATES = 290 * MiB, O_Z = 418 * MiB;
constexpr size_t O_KALL = 124 * MiB, O_VALL = 141 * MiB;
constexpr size_t O_A3 = O_A, O_T = O_Z, O_Y = O_A, O_A5 = O_QA, O_ACT2 = 256 * MiB, O_Y2 = O_A;
constexpr size_t O_BAR = 55 * MiB + 512 * 1024;
constexpr size_t O_X2B = 440 * MiB;
constexpr size_t WS_NEED = 512 * MiB;
constexpr int REC_BYTES = 17408;

struct Args { const float* in[26]; float* out; unsigned char* ws; };
__device__ __forceinline__ u16* vd_row(unsigned char* ws, int row) { return row < VD_SPLIT ? (u16*)(ws + O_VD1) + (size_t)row * 1024 : (u16*)(ws + O_VD2) + (size_t)(row - VD_SPLIT) * 1024; }

__device__ __forceinline__ float bf_lo(unsigned w) { return __uint_as_float(w << 16); }
__device__ __forceinline__ float bf_hi(unsigned w) { return __uint_as_float(w & 0xffff0000u); }
__device__ __forceinline__ float bf2f(u16 v) { return __uint_as_float(((unsigned)v) << 16); }
__device__ __forceinline__ u16 f2bf(float f) { unsigned u = __float_as_uint(f); u += 0x7FFFu + ((u >> 16) & 1u); return (u16)(u >> 16); }
typedef __bf16 bf16x2_t __attribute__((ext_vector_type(2)));
__device__ __forceinline__ unsigned pk(float lo, float hi) { bf16x2_t v; v[0] = (__bf16)lo; v[1] = (__bf16)hi; return __builtin_bit_cast(unsigned, v); }
__device__ __forceinline__ float silu_f(float v) { return v * __builtin_amdgcn_rcpf(1.f + __expf(-v)); }
__device__ __forceinline__ float sigm_f(float v) { return __builtin_amdgcn_rcpf(1.f + __expf(-v)); }
__device__ __forceinline__ float wave_sum(float v) {
#pragma unroll
    for (int o = 32; o > 0; o >>= 1) v += __shfl_xor(v, o);
    return v; }
__device__ __forceinline__ float grp16_sum(float v) {
#pragma unroll
    for (int o = 8; o > 0; o >>= 1) v += __shfl_xor(v, o);
    return v; }
__device__ __forceinline__ float grp32_sum(float v) {
#pragma unroll
    for (int o = 16; o > 0; o >>= 1) v += __shfl_xor(v, o);
    return v; }
__device__ __forceinline__ f32x4 mfma16(s16x8 a, s16x8 b, f32x4 c) { return __builtin_amdgcn_mfma_f32_16x16x32_bf16(a, b, c, 0, 0, 0); }
__device__ __forceinline__ u32x4 pk8(f32x4 a, f32x4 b) { return (u32x4){pk(a[0], a[1]), pk(a[2], a[3]), pk(b[0], b[1]), pk(b[2], b[3])}; }
__device__ __forceinline__ void unpk8(u32x4 w, f32x4& a, f32x4& b) { a = (f32x4){bf_lo(w.x), bf_hi(w.x), bf_lo(w.y), bf_hi(w.y)}; b = (f32x4){bf_lo(w.z), bf_hi(w.z), bf_lo(w.w), bf_hi(w.w)}; }

__device__ __forceinline__ int map_gu(int n) { const int p = n >> 8, r = n & 255; return r < 128 ? p * 128 + r : 2816 + p * 128 + (r - 128); }
__device__ __forceinline__ int map_in1(int n) { return n < 3072 ? n : (n < 3104 ? 4096 + (n - 3072) : -1); }
__device__ __forceinline__ int map_in2(int n) { return n < 1024 ? 3072 + n : (n < 2048 ? 4128 + (n - 1024) : (n < 2560 ? 5152 + (n - 2048) : 5664 + (n - 2560))); }

template <int MAP> __device__ __forceinline__ void cvt_w(const float* __restrict__ src, int K, int Nsrc, u16* __restrict__ dst, int Np, long gtid, long gthreads) {
    const long total = (long)Np * (K >> 5);
    for (long idx = gtid; idx < total; idx += gthreads) {
        const int np = (int)(idx % Np), kg = (int)(idx / Np);
        const int sc = MAP == 0 ? np : (MAP == 1 ? map_gu(np) : (MAP == 2 ? map_in1(np) : map_in2(np)));
        u32x4 w0 = {0u, 0u, 0u, 0u}, w1 = w0, w2 = w0, w3 = w0;
        if (sc >= 0) {
            const float* p = src + (size_t)(kg * 32) * Nsrc + sc;
            float f[32];
#pragma unroll
            for (int j = 0; j < 32; ++j) f[j] = p[(size_t)j * Nsrc];
            w0 = (u32x4){pk(f[0], f[1]), pk(f[2], f[3]), pk(f[4], f[5]), pk(f[6], f[7])};
            w1 = (u32x4){pk(f[8], f[9]), pk(f[10], f[11]), pk(f[12], f[13]), pk(f[14], f[15])};
            w2 = (u32x4){pk(f[16], f[17]), pk(f[18], f[19]), pk(f[20], f[21]), pk(f[22], f[23])};
            w3 = (u32x4){pk(f[24], f[25]), pk(f[26], f[27]), pk(f[28], f[29]), pk(f[30], f[31])};
        }
        u32x4* d = (u32x4*)(dst + (size_t)np * K + kg * 32);
        d[0] = w0; d[1] = w1; d[2] = w2; d[3] = w3;
    }
}

__device__ __forceinline__ void phase_mod(const Args& a, unsigned char* shm) {
    float* sc = (float*)shm;
    float* red = sc + 9216;
    const float* c = a.in[1]; const float* cc = a.in[3]; const float* wmod = a.in[4]; const float* bmod = a.in[5];
    float* mod = (float*)(a.ws + O_MOD);
    const int tid = tid_opaque();
    for (int i = tid; i < 9216; i += 512) { const int r = i >> 10, k = i & 1023; const float v = r < 8 ? c[r * 1024 + k] : cc[k]; sc[i] = silu_f(v); }
    __syncthreads();
    const int cl = tid & 31, kg = tid >> 5;
    for (int task = blockIdx.x; task < 288; task += gridDim.x) {
        const int col = task * 32 + cl;
        float acc[9];
#pragma unroll
        for (int r = 0; r < 9; ++r) acc[r] = 0.f;
#pragma unroll 8
        for (int kk = 0; kk < 64; ++kk) { const int k = kg * 64 + kk; const float w = wmod[(size_t)k * NMODC + col];
#pragma unroll
            for (int r = 0; r < 9; ++r) acc[r] += sc[r * 1024 + k] * w; }
#pragma unroll
        for (int r = 0; r < 9; ++r) red[(kg * 9 + r) * 32 + cl] = acc[r];
        __syncthreads();
        if (tid < 288) { const int r = tid >> 5; float s = bmod[task * 32 + cl];
            for (int g = 0; g < 16; ++g) s += red[(g * 9 + r) * 32 + cl];
            mod[r * NMODC + task * 32 + cl] = s; }
        __syncthreads();
    }
}

struct Row { f32x4 v[4]; };
__device__ __forceinline__ void ld_row_f32(Row& r, const float* p, int lane) {
#pragma unroll
    for (int i = 0; i < 4; ++i) r.v[i] = *(const f32x4*)(p + 256 * i + 4 * lane); }
__device__ __forceinline__ void st_row_f32(const Row& r, float* p, int lane) {
#pragma unroll
    for (int i = 0; i < 4; ++i) *(f32x4*)(p + 256 * i + 4 * lane) = r.v[i]; }
__device__ __forceinline__ void ld_row_bf(Row& r, const u16* p, int lane) {
#pragma unroll
    for (int i = 0; i < 4; ++i) { const u32x2 u = *(const u32x2*)(p + 256 * i + 4 * lane); r.v[i] = (f32x4){bf_lo(u.x), bf_hi(u.x), bf_lo(u.y), bf_hi(u.y)}; } }
__device__ __forceinline__ void st_row_bf(const Row& r, u16* p, int lane) {
#pragma unroll
    for (int i = 0; i < 4; ++i) { u32x2 u; u.x = pk(r.v[i][0], r.v[i][1]); u.y = pk(r.v[i][2], r.v[i][3]); *(u32x2*)(p + 256 * i + 4 * lane) = u; } }
__device__ __forceinline__ void row_norm(Row& y, const Row& x, const float* g, int lane) {
    float s = 0.f;
#pragma unroll
    for (int i = 0; i < 4; ++i) s += x.v[i][0] * x.v[i][0] + x.v[i][1] * x.v[i][1] + x.v[i][2] * x.v[i][2] + x.v[i][3] * x.v[i][3];
    s = wave_sum(s);
    const float rs = rsqrtf(s * (1.f / 1024.f) + 1e-6f);
#pragma unroll
    for (int i = 0; i < 4; ++i) { const f32x4 gv = *(const f32x4*)(g + 256 * i + 4 * lane); y.v[i] = x.v[i] * rs * gv; } }
__device__ __forceinline__ void row_mod(Row& h, const float* shift, const float* scale, int lane) {
#pragma unroll
    for (int i = 0; i < 4; ++i) { const f32x4 sh = *(const f32x4*)(shift + 256 * i + 4 * lane), sc = *(const f32x4*)(scale + 256 * i + 4 * lane); h.v[i] = h.v[i] * (sc + 1.f) + sh; } }
__device__ __forceinline__ void row_res(Row& x, const Row& t, const float* gate, float w, int lane) {
#pragma unroll
    for (int i = 0; i < 4; ++i) { const f32x4 gv = *(const f32x4*)(gate + 256 * i + 4 * lane); x.v[i] = x.v[i] + gv * t.v[i] * w; } }

__device__ __forceinline__ Row ld_vec(const float* p, int lane) { Row r; ld_row_f32(r, p, lane); return r; }
__device__ __forceinline__ float row_rs(const Row& x) {
    float s = 0.f;
#pragma unroll
    for (int i = 0; i < 4; ++i) s += x.v[i][0] * x.v[i][0] + x.v[i][1] * x.v[i][1] + x.v[i][2] * x.v[i][2] + x.v[i][3] * x.v[i][3];
    s = wave_sum(s);
    return rsqrtf(s * (1.f / 1024.f) + 1e-6f); }
__device__ __forceinline__ void row_norm_r(Row& y, const Row& x, const Row& g) { const float rs = row_rs(x);
#pragma unroll
    for (int i = 0; i < 4; ++i) y.v[i] = x.v[i] * rs * g.v[i]; }
__device__ __forceinline__ void row_mod_r(Row& h, const Row& sh, const Row& sc) {
#pragma unroll
    for (int i = 0; i < 4; ++i) h.v[i] = h.v[i] * (sc.v[i] + 1.f) + sh.v[i]; }
__device__ __forceinline__ void row_res_r(Row& x, const Row& t, const Row& gate, float w) {
#pragma unroll
    for (int i = 0; i < 4; ++i) x.v[i] = x.v[i] + gate.v[i] * t.v[i] * w; }

__device__ __forceinline__ void phase_h1(const Args& a) {
    const int lane = tid_opaque() & 63, gw = blockIdx.x * 8 + (tid_opaque() >> 6), nw = gridDim.x * 8;
    const float* mod = (const float*)(a.ws + O_MOD); u16* A = (u16*)(a.ws + O_A);
    const Row pre = ld_vec(a.in[6], lane);
    { const int b = gw & 7; const float* md = mod + b * NMODC; const Row sh = ld_vec(md, lane), sc = ld_vec(md + 1024, lane);
      for (int j = gw >> 3; j < 4096; j += nw >> 3) { const int row = b * 4096 + j;
        Row xr, h; ld_row_f32(xr, a.in[0] + (size_t)row * 1024, lane); row_norm_r(h, xr, pre); row_mod_r(h, sh, sc); st_row_bf(h, A + (size_t)row * 1024, lane); } }
    { const float* md = mod + 8 * NMODC; const Row sh = ld_vec(md, lane), sc = ld_vec(md + 1024, lane);
      for (int row = MLAT + gw; row < MALL; row += nw) {
        Row xr, h; ld_row_f32(xr, a.in[2] + (size_t)(row - MLAT) * 1024, lane); row_norm_r(h, xr, pre); row_mod_r(h, sh, sc); st_row_bf(h, A + (size_t)row * 1024, lane); } }
}
__device__ __forceinline__ void phase_h2(const Args& a, int row_lo = 0, int row_hi = MALL, int bfirst = 0, int nblk = -1) {
    if (nblk < 0) nblk = gridDim.x;
    if ((int)blockIdx.x < bfirst || (int)blockIdx.x >= bfirst + nblk) return;
    const int lane = tid_opaque() & 63, gw = ((int)blockIdx.x - bfirst) * 8 + (tid_opaque() >> 6), nw = nblk * 8;
    const float* mod = (const float*)(a.ws + O_MOD); u16* A = (u16*)(a.ws + O_A); const u16* Y1 = (const u16*)(a.ws + O_Y1);
    const Row post1 = ld_vec(a.in[7], lane), mixpre = ld_vec(a.in[10], lane);
    if (row_lo < MLAT) { const int b = gw & 7; const float* md = mod + b * NMODC;
      const Row g2 = ld_vec(md + 2 * 1024, lane), sh = ld_vec(md + 3 * 1024, lane), sc = ld_vec(md + 4 * 1024, lane);
      for (int j = gw >> 3; j < 4096; j += nw >> 3) { const int row = b * 4096 + j;
        Row x1, yr, t, h; ld_row_f32(x1, a.in[0] + (size_t)row * 1024, lane); ld_row_bf(yr, Y1 + (size_t)row * 1024, lane);
        row_norm_r(t, yr, post1); row_res_r(x1, t, g2, 0.5f); row_norm_r(h, x1, mixpre); row_mod_r(h, sh, sc); st_row_bf(h, A + (size_t)row * 1024, lane); } }
    if (row_hi > MLAT) { const float* md = mod + 8 * NMODC;
      const Row g2 = ld_vec(md + 2 * 1024, lane), sh = ld_vec(md + 3 * 1024, lane), sc = ld_vec(md + 4 * 1024, lane);
      for (int row = MLAT + gw; row < MALL; row += nw) {
        Row x1, yr, t, h; ld_row_f32(x1, a.in[2] + (size_t)(row - MLAT) * 1024, lane); ld_row_bf(yr, Y1 + (size_t)row * 1024, lane);
        row_norm_r(t, yr, post1); row_res_r(x1, t, g2, 0.5f); row_norm_r(h, x1, mixpre); row_mod_r(h, sh, sc); st_row_bf(h, A + (size_t)row * 1024, lane); } }
}
__device__ __forceinline__ void phase_h3(const Args& a) {
    const int lane = tid_opaque() & 63, gw = blockIdx.x * 8 + (tid_opaque() >> 6), nw = gridDim.x * 8;
    const float* mod = (const float*)(a.ws + O_MOD); u16* A5 = (u16*)(a.ws + O_A5); const u16* Y = (const u16*)(a.ws + O_Y); const u16* Y1 = (const u16*)(a.ws + O_Y1);
    const int b = gw & 7; const float* md = mod + b * NMODC;
    const Row post1 = ld_vec(a.in[7], lane), mixpost = ld_vec(a.in[11], lane), pre2 = ld_vec(a.in[22], lane);
    const Row g2 = ld_vec(md + 2 * 1024, lane), g5 = ld_vec(md + 5 * 1024, lane), sh = ld_vec(md + 6 * 1024, lane), sc = ld_vec(md + 7 * 1024, lane);
    for (int j = gw >> 3; j < 4096; j += nw >> 3) { const int row = b * 4096 + j;
        Row x2, yr, t, h; ld_row_f32(x2, a.in[0] + (size_t)row * 1024, lane); ld_row_bf(yr, Y1 + (size_t)row * 1024, lane);
        row_norm_r(t, yr, post1); row_res_r(x2, t, g2, 0.5f);
        ld_row_bf(yr, Y + (size_t)row * 1024, lane); row_norm_r(t, yr, mixpost); row_res_r(x2, t, g5, 1.0f);
        st_row_bf(x2, (u16*)(a.ws + O_X2B) + (size_t)row * 1024, lane);
        row_norm_r(h, x2, pre2); row_mod_r(h, sh, sc); st_row_bf(h, A5 + (size_t)row * 1024, lane);
    }
}
__device__ __forceinline__ void phase_out(const Args& a) {
    const int lane = tid_opaque() & 63, gw = blockIdx.x * 8 + (tid_opaque() >> 6), nw = gridDim.x * 8;
    const float* mod = (const float*)(a.ws + O_MOD); const u16* Y2 = (const u16*)(a.ws + O_Y2);
    const int b = gw & 7; const Row post2 = ld_vec(a.in[23], lane), g8 = ld_vec(mod + b * NMODC + 8 * 1024, lane);
    for (int j = gw >> 3; j < 4096; j += nw >> 3) { const int row = b * 4096 + j;
        Row x2, yr, t; ld_row_bf(x2, (const u16*)(a.ws + O_X2B) + (size_t)row * 1024, lane); ld_row_bf(yr, Y2 + (size_t)row * 1024, lane); row_norm_r(t, yr, post2); row_res_r(x2, t, g8, 0.5f);
        st_row_f32(x2, a.out + (size_t)row * 1024, lane);
    }
}

struct EpiPlain { static constexpr bool PERM = true, AFTER_DRAIN = false; u16* O; int ldc;
    __device__ __forceinline__ void operator()(const pg8::f32x4 (&acc)[2][2][4][2], const pg8::Unit& u, int wr, int wc, int fr, int fq) const {
        const int row0 = u.pm * 256 + wr * 64 + fr, col0 = u.pn * 256 + wc * 32 + 8 * fq;
#pragma unroll
        for (int ai = 0; ai < 2; ++ai)
#pragma unroll
            for (int m = 0; m < 4; ++m) { u16* rp = O + (size_t)(row0 + ai * 128 + m * 16) * ldc + col0;
#pragma unroll
                for (int bj = 0; bj < 2; ++bj) *(u32x4*)(rp + bj * 128) = pk8(acc[ai][bj][m][0], acc[ai][bj][m][1]); } } };

struct EpiSwiglu { static constexpr bool PERM = true, AFTER_DRAIN = false; u16* O;
    __device__ __forceinline__ void operator()(const pg8::f32x4 (&acc)[2][2][4][2], const pg8::Unit& u, int wr, int wc, int fr, int fq) const {
        const int row0 = u.pm * 256 + wr * 64 + fr, col0 = u.pn * 128 + wc * 32 + 8 * fq;
#pragma unroll
        for (int ai = 0; ai < 2; ++ai)
#pragma unroll
            for (int m = 0; m < 4; ++m) { u16* rp = O + (size_t)(row0 + ai * 128 + m * 16) * FH + col0;
                f32x4 o0, o1;
#pragma unroll
                for (int j = 0; j < 4; ++j) { o0[j] = silu_f(acc[ai][0][m][0][j]) * acc[ai][1][m][0][j]; o1[j] = silu_f(acc[ai][0][m][1][j]) * acc[ai][1][m][1][j]; }
                *(u32x4*)rp = pk8(o0, o1); } } };

struct EpiIn1 { static constexpr bool PERM = true, AFTER_DRAIN = false; u16* q; u16* k; u16* v; float* ba;
    __device__ __forceinline__ void operator()(const pg8::f32x4 (&acc)[2][2][4][2], const pg8::Unit& u, int wr, int wc, int fr, int fq) const {
        const int row0 = u.pm * 256 + wr * 64 + fr;
        if (u.pn < 12) {
            const int t3 = u.pn >> 2;
            u16* base = q + (long)(t3 == 1) * (long)(k - q) + (long)(t3 == 2) * (long)(v - q); const int col0 = (u.pn & 3) * 256 + wc * 32 + 8 * fq;
#pragma unroll
            for (int ai = 0; ai < 2; ++ai)
#pragma unroll
                for (int m = 0; m < 4; ++m) { u16* rp = base + (size_t)(row0 + ai * 128 + m * 16) * 1024 + col0;
#pragma unroll
                    for (int bj = 0; bj < 2; ++bj) *(u32x4*)(rp + bj * 128) = pk8(acc[ai][bj][m][0], acc[ai][bj][m][1]); }
        } else if (wc == 0) {
#pragma unroll
            for (int ai = 0; ai < 2; ++ai)
#pragma unroll
                for (int m = 0; m < 4; ++m) { float* rp = ba + (size_t)(row0 + ai * 128 + m * 16) * 32 + 8 * fq;
                    *(f32x4*)rp = acc[ai][0][m][0]; *(f32x4*)(rp + 4) = acc[ai][0][m][1]; }
        } } };
struct EpiIn2 { static constexpr bool PERM = true, AFTER_DRAIN = false; u16* z; u16* qa; u16* kva; u16* gates;
    __device__ __forceinline__ void operator()(const pg8::f32x4 (&acc)[2][2][4][2], const pg8::Unit& u, int wr, int wc, int fr, int fq) const {
        const int row0 = u.pm * 256 + wr * 64 + fr; const bool lat = u.pm < 128;
        u16* base; int ldc, col0; bool sig = false;
        if (u.pn < 4) { if (!lat) return; base = z; ldc = 1024; col0 = u.pn * 256; }
        else if (u.pn < 8) { if (!lat) return; base = qa; ldc = 1024; col0 = (u.pn - 4) * 256; }
        else if (u.pn < 10) { base = kva; ldc = 512; col0 = (u.pn - 8) * 256; }
        else { if (!lat) return; base = gates; ldc = 2048; col0 = (u.pn - 10) * 256; sig = true; }
        col0 += wc * 32 + 8 * fq;
#pragma unroll
        for (int ai = 0; ai < 2; ++ai)
#pragma unroll
            for (int m = 0; m < 4; ++m) { u16* rp = base + (size_t)(row0 + ai * 128 + m * 16) * ldc + col0;
#pragma unroll
                for (int bj = 0; bj < 2; ++bj) { f32x4 v0 = acc[ai][bj][m][0], v1 = acc[ai][bj][m][1];
                    if (sig) {
#pragma unroll
                        for (int j = 0; j < 4; ++j) { v0[j] = sigm_f(v0[j]); v1[j] = sigm_f(v1[j]); } }
                    *(u32x4*)(rp + bj * 128) = pk8(v0, v1); } } } };

template <int SECOND> struct EpiMerge { static constexpr bool PERM = true, AFTER_DRAIN = false; const u16* gates; u16* T;
    __device__ __forceinline__ void operator()(const pg8::f32x4 (&acc)[2][2][4][2], const pg8::Unit& u, int wr, int wc, int fr, int fq) const {
        const int row0 = u.pm * 256 + wr * 64 + fr, col0 = u.pn * 256 + wc * 32 + 8 * fq;
#pragma unroll
        for (int ai = 0; ai < 2; ++ai)
#pragma unroll
            for (int m = 0; m < 4; ++m) { const size_t row = (size_t)(row0 + ai * 128 + m * 16);
#pragma unroll
                for (int bj = 0; bj < 2; ++bj) { const int col = col0 + bj * 128;
                    const u32x4 gw = *(const u32x4*)(gates + row * 2048 + SECOND * 1024 + col); f32x4 g0, g1; unpk8(gw, g0, g1);
                    f32x4 o0 = g0 * acc[ai][bj][m][0], o1 = g1 * acc[ai][bj][m][1];
#if defined(EXP_ZERO_DN)
                    if (!SECOND) { o0 *= 0.f; o1 *= 0.f; }
#endif
#if defined(EXP_ZERO_AT)
                    if (SECOND) { o0 *= 0.f; o1 *= 0.f; }
#endif
                    if (SECOND) { const u32x4 tw = *(const u32x4*)(T + row * 1024 + col); f32x4 t0, t1; unpk8(tw, t0, t1); o0 += t0; o1 += t1; }
                    *(u32x4*)(T + row * 1024 + col) = pk8(o0, o1); } } } };

template <class Epi> __device__ __forceinline__ void run_gemm(unsigned char* shm, const u16* A, const u16* Bt, int M, int N, int K, const Epi& E) {
    pg8::Gemm g; g.A = A; g.Bt = Bt; g.M = M; g.N = N; g.K = K;
    pg8::StaticOrder S; S.init(M, N, (int)gridDim.x, (int)blockIdx.x);
    pg8::gemm_phase<Epi, pg8::StaticOrder, false>((PG8_LAS unsigned char*)shm, g, S, E, nullptr);
}

__device__ __forceinline__ void phase_dn_prep(const Args& a) {
    const int lane = tid_opaque() & 63, gw = blockIdx.x * 8 + (tid_opaque() >> 6), nw = gridDim.x * 8;
    const u16* raw0 = (const u16*)(a.ws + O_QRAW); const u16* raw1 = (const u16*)(a.ws + O_KRAW); const u16* raw2 = (const u16*)a.out;
    u16* out0 = (u16*)(a.ws + O_QD); u16* out1 = (u16*)(a.ws + O_KD);
    const float* cw = a.in[13];
    for (int row = gw; row < MALL; row += nw) {
        const int pos = row < MLAT ? (row & 4095) : ((row - MLAT) & 255); const int L = row < MLAT ? 4096 : 256;
        const bool hp = pos > 0, hn = pos < L - 1;
#pragma unroll
        for (int i = 0; i < 6; ++i) {
            const int kind = i >> 1, cc = (i & 1) * 512 + 8 * lane, cg_ = kind * 1024 + cc;
            const u16* rp = (kind == 0 ? raw0 : (kind == 1 ? raw1 : raw2)) + (size_t)row * 1024 + cc;
            u16* op = (kind == 0 ? out0 + (size_t)row * 1024 : (kind == 1 ? out1 + (size_t)row * 1024 : vd_row(a.ws, row))) + cc;
            const u32x4 zc = {0u, 0u, 0u, 0u};
            const u32x4 cu = *(const u32x4*)rp; const u32x4 pu = hp ? *(const u32x4*)(rp - 1024) : zc; const u32x4 nu = hn ? *(const u32x4*)(rp + 1024) : zc;
            f32x4 c0, c1, p0, p1, n0, n1; unpk8(cu, c0, c1); unpk8(pu, p0, p1); unpk8(nu, n0, n1);
            const f32x4 wa0 = *(const f32x4*)(cw + cg_), wa1 = *(const f32x4*)(cw + cg_ + 4);
            const f32x4 wb0 = *(const f32x4*)(cw + 3072 + cg_), wb1 = *(const f32x4*)(cw + 3072 + cg_ + 4);
            const f32x4 wc0 = *(const f32x4*)(cw + 6144 + cg_), wc1 = *(const f32x4*)(cw + 6144 + cg_ + 4);
            f32x4 v0 = wa0 * p0 + wb0 * c0 + wc0 * n0, v1 = wa1 * p1 + wb1 * c1 + wc1 * n1;
            float ss = 0.f;
#pragma unroll
            for (int j = 0; j < 4; ++j) { v0[j] = silu_f(v0[j]); v1[j] = silu_f(v1[j]); ss += v0[j] * v0[j] + v1[j] * v1[j]; }
            if (kind < 2) { ss = grp16_sum(ss); const float sc = rsqrtf(ss + 1e-6f) * (kind == 0 ? 0.08838834764831845f : 1.f); v0 *= sc; v1 *= sc; }
            *(u32x4*)op = pk8(v0, v1);
        }
    }
}

__device__ __forceinline__ void phase_dn_pre(const Args& a, unsigned char* shm) {
    const int tid = tid_opaque(), wid = tid >> 6, lane0 = tid & 63;
    float* Lm = (float*)(shm + wid * 17408); float* gcs = Lm + 4096; float* bts = gcs + 64;
    const u16* qd = (const u16*)(a.ws + O_QD); const u16* kd = (const u16*)(a.ws + O_KD); const float* BA = (const float*)(a.ws + O_BA);
    unsigned char* REC = a.ws + O_REC;
    for (int task = blockIdx.x * 8 + wid; task < 8704; task += gridDim.x * 8) {
        int lane = lane0; asm volatile("" : "+v"(lane));
        const int fr = lane & 15, quad = lane >> 4;
        const int c68 = task % 68; int tt = task / 68; const int dir = tt & 1; tt >>= 1; const int h = tt & 7; const int b = tt >> 3;
        const int base = c68 < 4 ? MLAT + b * 256 + c68 * 64 : b * 4096 + (c68 - 4) * 64;
        const int tok = dir ? 63 - lane : lane;
        const float* bap = BA + (size_t)(base + tok) * 32;
        const float beta = sigm_f(bap[dir * 8 + h]);
        const float xs = bap[16 + dir * 8 + h] + a.in[15][dir * 8 + h];
        const float sp = fmaxf(xs, 0.f) + log1pf(__expf(-fabsf(xs)));
        const float g = -__expf(a.in[14][dir * 8 + h]) * sp;
        float gc = g;
#pragma unroll
        for (int o = 1; o < 64; o <<= 1) { const float nb = __shfl_up(gc, o); if (lane >= o) gc += nb; }
        const float glast = __shfl(gc, 63);
        asm volatile("s_waitcnt lgkmcnt(0)" ::: "memory");
        gcs[lane] = gc; bts[lane] = beta;
        unsigned char* rec = REC + (size_t)task * REC_BYTES;
        float* rf = (float*)(rec + 16384);
        rf[lane] = __expf(gc); rf[64 + lane] = __expf(glast - gc); if (lane == 0) rf[128] = __expf(glast);
        asm volatile("s_waitcnt lgkmcnt(0)" ::: "memory");
        s16x8 kf[4][4];
#pragma unroll
        for (int mt = 0; mt < 4; ++mt) { const int r = 16 * mt + fr, tr = dir ? 63 - r : r; const u16* p = kd + (size_t)(base + tr) * 1024 + h * 128 + quad * 8;
#pragma unroll
            for (int kk = 0; kk < 4; ++kk) kf[mt][kk] = *(const s16x8*)(p + kk * 32); }
#pragma unroll
        for (int mt = 0; mt < 4; ++mt)
#pragma unroll
            for (int nt = 0; nt <= mt; ++nt) { f32x4 acc = {0.f, 0.f, 0.f, 0.f};
#pragma unroll
                for (int kk = 0; kk < 4; ++kk) acc = mfma16(kf[mt][kk], kf[nt][kk], acc);
                const int j = 16 * nt + fr; const float gj = gcs[j];
#pragma unroll
                for (int r = 0; r < 4; ++r) { const int i = 16 * mt + quad * 4 + r; Lm[i * 64 + j] = bts[i] * acc[r] * __expf(fminf(gcs[i] - gj, 0.f)); } }
        asm volatile("s_waitcnt lgkmcnt(0)" ::: "memory");
        const int hb = lane >> 5, cb = lane & 31;
        float tcol[32];
#pragma unroll
        for (int ii = 0; ii < 32; ++ii) {
            const float* Lrow = Lm + (32 * hb + ii) * 64 + 32 * hb;
            float s0 = (cb == ii) ? 1.f : 0.f, s1 = 0.f, s2 = 0.f, s3 = 0.f;
#pragma unroll
            for (int j4 = 0; j4 < (ii + 3) / 4; ++j4) { const f32x4 l = *(const f32x4*)(Lrow + j4 * 4);
                if (4 * j4 + 0 < ii) s0 -= l[0] * tcol[4 * j4 + 0];
                if (4 * j4 + 1 < ii) s1 -= l[1] * tcol[4 * j4 + 1];
                if (4 * j4 + 2 < ii) s2 -= l[2] * tcol[4 * j4 + 2];
                if (4 * j4 + 3 < ii) s3 -= l[3] * tcol[4 * j4 + 3]; }
            tcol[ii] = (s0 + s1) + (s2 + s3);
            __builtin_amdgcn_sched_barrier(0);
        }
        unsigned char* imgB = (unsigned char*)Lm;
        { const int m = lane >> 1, k0 = (lane & 1) * 16; const float* src = Lm + (32 + m) * 64 + k0;
          const f32x4 c0 = *(const f32x4*)(src), c1 = *(const f32x4*)(src + 4), c2 = *(const f32x4*)(src + 8), c3 = *(const f32x4*)(src + 12);
          *(u32x4*)(imgB + m * 64 + k0 * 2) = pk8(c0, c1); *(u32x4*)(imgB + m * 64 + k0 * 2 + 16) = pk8(c2, c3); }
        if (hb == 0) {
#pragma unroll
            for (int q = 0; q < 4; ++q) { u32x4 w; w.x = pk(tcol[8 * q], tcol[8 * q + 1]); w.y = pk(tcol[8 * q + 2], tcol[8 * q + 3]); w.z = pk(tcol[8 * q + 4], tcol[8 * q + 5]); w.w = pk(tcol[8 * q + 6], tcol[8 * q + 7]);
                *(u32x4*)(imgB + 2048 + cb * 64 + q * 16) = w; }
        } else {
#pragma unroll
            for (int m = 0; m < 32; ++m) *(u16*)(imgB + 4096 + m * 64 + cb * 2) = f2bf(tcol[m]);
        }
        asm volatile("s_waitcnt lgkmcnt(0)" ::: "memory");
        f32x4 Zb[2][2];
#pragma unroll
        for (int m2 = 0; m2 < 2; ++m2)
#pragma unroll
            for (int n2 = 0; n2 < 2; ++n2) { const f32x4 z0 = {0.f, 0.f, 0.f, 0.f};
                Zb[m2][n2] = mfma16(*(const s16x8*)(imgB + (16 * m2 + fr) * 64 + quad * 16), *(const s16x8*)(imgB + 2048 + (16 * n2 + fr) * 64 + quad * 16), z0); }
#pragma unroll
        for (int m2 = 0; m2 < 2; ++m2)
#pragma unroll
            for (int n2 = 0; n2 < 2; ++n2) { u32x2 w; w.x = pk(Zb[m2][n2][0], Zb[m2][n2][1]); w.y = pk(Zb[m2][n2][2], Zb[m2][n2][3]);
                *(u32x2*)(imgB + 6144 + (16 * n2 + fr) * 64 + (16 * m2 + 4 * quad) * 2) = w; }
        asm volatile("s_waitcnt lgkmcnt(0)" ::: "memory");
        f32x4 T21[2][2];
#pragma unroll
        for (int m2 = 0; m2 < 2; ++m2)
#pragma unroll
            for (int n2 = 0; n2 < 2; ++n2) { const f32x4 z0 = {0.f, 0.f, 0.f, 0.f};
                T21[m2][n2] = mfma16(*(const s16x8*)(imgB + 4096 + (16 * m2 + fr) * 64 + quad * 16), *(const s16x8*)(imgB + 6144 + (16 * n2 + fr) * 64 + quad * 16), z0); }
        u16* img = (u16*)Lm;
        asm volatile("s_waitcnt lgkmcnt(0)" ::: "memory");
#pragma unroll
        for (int ii = 0; ii < 32; ++ii) img[4096 + (32 * hb + ii) * 64 + lane] = f2bf(tcol[ii] * beta);
        if (hb == 1) {
#pragma unroll
            for (int ii = 0; ii < 32; ++ii) img[4096 + ii * 64 + lane] = 0; }
#pragma unroll
        for (int m2 = 0; m2 < 2; ++m2)
#pragma unroll
            for (int n2 = 0; n2 < 2; ++n2) { const int col = 16 * n2 + fr; const float bc = bts[col];
#pragma unroll
                for (int r = 0; r < 4; ++r) img[4096 + (32 + 16 * m2 + 4 * quad + r) * 64 + col] = f2bf(-T21[m2][n2][r] * bc); }
#pragma unroll
        for (int mt = 0; mt < 4; ++mt) { const int r_ = 16 * mt + fr, tr = dir ? 63 - r_ : r_; const u16* p = qd + (size_t)(base + tr) * 1024 + h * 128 + quad * 8;
            s16x8 qf[4];
#pragma unroll
            for (int kk = 0; kk < 4; ++kk) qf[kk] = *(const s16x8*)(p + kk * 32);
#pragma unroll
            for (int nt = 0; nt < 4; ++nt) { const int j = 16 * nt + fr;
                if (nt <= mt) { f32x4 acc = {0.f, 0.f, 0.f, 0.f};
#pragma unroll
                    for (int kk = 0; kk < 4; ++kk) acc = mfma16(qf[kk], kf[nt][kk], acc);
                    const float gj = gcs[j];
#pragma unroll
                    for (int r = 0; r < 4; ++r) { const int i = 16 * mt + quad * 4 + r; const float v = (j <= i) ? acc[r] * __expf(fminf(gcs[i] - gj, 0.f)) : 0.f; img[i * 64 + j] = f2bf(v); }
                } else {
#pragma unroll
                    for (int r = 0; r < 4; ++r) { const int i = 16 * mt + quad * 4 + r; img[i * 64 + j] = 0; } } } }
        asm volatile("s_waitcnt lgkmcnt(0)" ::: "memory");
        { const u32x4* src = (const u32x4*)Lm; u32x4* dst = (u32x4*)rec;
#pragma unroll
            for (int q = 0; q < 8; ++q) { dst[q * 64 + lane] = src[512 + q * 64 + lane]; dst[512 + q * 64 + lane] = src[q * 64 + lane]; } }
    }
}

__device__ __forceinline__ void phase_dn_scan(const Args& a, unsigned char* shm) {
    const int tid = tid_opaque(), wid = tid >> 6, lane = tid & 63, fr = lane & 15, quad = lane >> 4, r32 = lane & 31, hi = lane >> 5;
    unsigned char* ST = shm; unsigned char* KV = shm + 17408; unsigned char* RT = KV + 16384; unsigned char* VN = RT + 9216; unsigned char* VS = VN + 9216;
    unsigned char* KR = VS + 9216; unsigned char* QR = KR + 17408;
    const int mt = wid & 3, ng = wid >> 2, mtS = wid & 1, D0 = wid >> 1;
    const int sr = tid >> 4, sc = (tid & 15) * 8, vst0 = at::v_st(sr, sc), vst1 = at::v_st(32 + sr, sc);
    const int vb0 = (int)(uintptr_t)KV + at::v_rd_base(lane);
    const u16* qd = (const u16*)(a.ws + O_QD); const u16* kd = (const u16*)(a.ws + O_KD);
    const unsigned char* REC = a.ws + O_REC;
    for (int task = blockIdx.x; task < 256; task += gridDim.x) {
        const int half = task & 1, dir = (task >> 1) & 1, h = (task >> 2) & 7, b = task >> 5;
        u16* Od = (u16*)a.out + (dir ? (size_t)MLAT * 1024 : (size_t)0);
        at::f32x16 sT;
#pragma unroll
        for (int r = 0; r < 16; ++r) sT[r] = 0.f;
        const int irow = 16 * mt + fr, i0 = 16 * mt + quad * 4;
        const int dv0 = 32 * ng + fr, dv1 = dv0 + 16;
        const int trow = dir ? 63 - irow : irow, t0 = dir ? 63 - sr : sr, t1 = dir ? 31 - sr : 32 + sr;
        const int hoff = h * 128;
#define SCAN_C68(n_) ((n_) < 4 ? (dir ? 3 - (n_) : (n_)) : (dir ? 71 - (n_) : (n_)))
#define SCAN_BASE(c_) ((c_) < 4 ? MLAT + b * 256 + (c_) * 64 : b * 4096 + ((c_) - 4) * 64)
#define SCAN_REC(c_) (REC + (size_t)((((b * 8 + h) * 2 + dir) * 68) + (c_)) * REC_BYTES)
        s16x8 K0, K1, Q0, Q1, TB[2], IN[2]; f32x4 EG, EK, V0, V1; float DCH;
        const unsigned oK0 = (unsigned)(t0 * 1024 + hoff + sc), oK1 = (unsigned)(t1 * 1024 + hoff + sc), oA = (unsigned)(trow * 1024 + hoff + quad * 8), oT = (unsigned)(irow * 64 + quad * 8);
        unsigned oV[4];
#pragma unroll
        for (int r = 0; r < 4; ++r) oV[r] = (unsigned)((dir ? 63 - (i0 + r) : (i0 + r)) * 1024 + hoff + half * 64 + dv0);
#define LD_K(base_)   do { const u16* kb_ = kd + (size_t)(base_) * 1024; const u16* qb_ = qd + (size_t)(base_) * 1024; K0 = *(const s16x8*)(kb_ + oK0); K1 = *(const s16x8*)(kb_ + oK1); Q0 = *(const s16x8*)(qb_ + oK0); Q1 = *(const s16x8*)(qb_ + oK1); } while (0)
#define LD_A(base_)   do { const u16* vb_ = vd_row(a.ws, (base_)); \
        _Pragma("unroll") for (int r = 0; r < 4; ++r) { V0[r] = bf2f(vb_[oV[r]]); V1[r] = bf2f(vb_[oV[r] + 16]); } } while (0)
#define LD_TB(rec_)   do { const u16* p_ = (const u16*)(rec_) + oT; TB[0] = *(const s16x8*)p_; TB[1] = *(const s16x8*)(p_ + 32); EK = *(const f32x4*)((const float*)((rec_) + 16384) + 64 + i0); } while (0)
#define LD_IN(rec_)   do { const u16* p_ = (const u16*)((rec_) + 8192) + oT; IN[0] = *(const s16x8*)p_; IN[1] = *(const s16x8*)(p_ + 32); } while (0)
#define LD_EG(rec_)   do { EG = *(const f32x4*)((const float*)((rec_) + 16384) + i0); } while (0)
#define LD_D(rec_)    do { DCH = ((const float*)((rec_) + 16384))[128]; } while (0)
        { const int c0 = SCAN_C68(0); const int bs = SCAN_BASE(c0); const unsigned char* rc = SCAN_REC(c0);
          LD_K(bs); LD_A(bs); LD_TB(rc); LD_IN(rc); LD_EG(rc); LD_D(rc); }
        for (int n = 0; n < 68; ++n) {
            const int c68 = SCAN_C68(n);
            const int base = SCAN_BASE(c68);
            const int nn = n < 67 ? n + 1 : 67; const int c68n = SCAN_C68(nn); const int basen = SCAN_BASE(c68n); const unsigned char* recn = SCAN_REC(c68n);
#pragma unroll
            for (int r = 0; r < 16; ++r) *(u16*)(ST + (32 * mtS + at::crow(r, hi)) * 272 + (32 * D0 + r32) * 2) = f2bf(sT[r]);
            *(s16x8*)(KV + vst0) = K0; *(s16x8*)(KV + vst1) = K1;
            *(s16x8*)(KR + sr * 272 + sc * 2) = K0; *(s16x8*)(KR + (32 + sr) * 272 + sc * 2) = K1;
            *(s16x8*)(QR + sr * 272 + sc * 2) = Q0; *(s16x8*)(QR + (32 + sr) * 272 + sc * 2) = Q1;
            LD_K(basen);
            __syncthreads();
            f32x4 KS0 = {0.f, 0.f, 0.f, 0.f}, KS1 = KS0, QS0 = KS0, QS1 = KS0;
#pragma unroll
            for (int kk = 0; kk < 4; ++kk) {
                const s16x8 b0 = *(const s16x8*)(ST + dv0 * 272 + (kk * 32 + quad * 8) * 2), b1 = *(const s16x8*)(ST + dv1 * 272 + (kk * 32 + quad * 8) * 2);
                const s16x8 ak = *(const s16x8*)(KR + irow * 272 + (kk * 32 + quad * 8) * 2), aq = *(const s16x8*)(QR + irow * 272 + (kk * 32 + quad * 8) * 2);
                KS0 = mfma16(ak, b0, KS0); KS1 = mfma16(ak, b1, KS1); QS0 = mfma16(aq, b0, QS0); QS1 = mfma16(aq, b1, QS1);
            }
            {
                const f32x4 r0 = V0 - EG * KS0, r1 = V1 - EG * KS1;
                u32x2 w0, w1; w0.x = pk(r0[0], r0[1]); w0.y = pk(r0[2], r0[3]); w1.x = pk(r1[0], r1[1]); w1.y = pk(r1[2], r1[3]);
                *(u32x2*)(RT + dv0 * 144 + i0 * 2) = w0; *(u32x2*)(RT + dv1 * 144 + i0 * 2) = w1;
            }
            LD_A(basen);
            __syncthreads();
            f32x4 N0 = {0.f, 0.f, 0.f, 0.f}, N1 = N0;
            {
#pragma unroll
                for (int kk = 0; kk < 2; ++kk) {
                    const s16x8 b0 = *(const s16x8*)(RT + dv0 * 144 + (kk * 32 + quad * 8) * 2), b1 = *(const s16x8*)(RT + dv1 * 144 + (kk * 32 + quad * 8) * 2);
                    N0 = mfma16(TB[kk], b0, N0); N1 = mfma16(TB[kk], b1, N1); }
                u32x2 w0, w1; w0.x = pk(N0[0], N0[1]); w0.y = pk(N0[2], N0[3]); w1.x = pk(N1[0], N1[1]); w1.y = pk(N1[2], N1[3]);
                *(u32x2*)(VN + dv0 * 144 + i0 * 2) = w0; *(u32x2*)(VN + dv1 * 144 + i0 * 2) = w1;
                const f32x4 s0 = N0 * EK, s1 = N1 * EK;
                w0.x = pk(s0[0], s0[1]); w0.y = pk(s0[2], s0[3]); w1.x = pk(s1[0], s1[1]); w1.y = pk(s1[2], s1[3]);
                *(u32x2*)(VS + dv0 * 144 + i0 * 2) = w0; *(u32x2*)(VS + dv1 * 144 + i0 * 2) = w1;
            }
            LD_TB(recn);
            __syncthreads();
            {
                f32x4 O0 = QS0 * EG, O1 = QS1 * EG;
#pragma unroll
                for (int kk = 0; kk < 2; ++kk) {
                    const s16x8 b0 = *(const s16x8*)(VN + dv0 * 144 + (kk * 32 + quad * 8) * 2), b1 = *(const s16x8*)(VN + dv1 * 144 + (kk * 32 + quad * 8) * 2);
                    O0 = mfma16(IN[kk], b0, O0); O1 = mfma16(IN[kk], b1, O1); }
                if (n >= 4) {
#pragma unroll
                    for (int r = 0; r < 4; ++r) { u16* op = Od + (size_t)base * 1024 + oV[r];
                        op[0] = f2bf(O0[r]); op[16] = f2bf(O1[r]); } }
            }
            LD_IN(recn); LD_EG(recn);
            {
#pragma unroll
                for (int r = 0; r < 16; ++r) sT[r] *= DCH;
                LD_D(recn);
                const unsigned char* vsp = VS + (32 * mtS + r32) * 144 + (8 * hi) * 2;
                const at::bf16x8 pa0 = *(const at::bf16x8*)(vsp), pa1 = *(const at::bf16x8*)(vsp + 32), pa2 = *(const at::bf16x8*)(vsp + 64), pa3 = *(const at::bf16x8*)(vsp + 96);
                if (D0 == 0) at::pv_one<0>(sT, vb0, pa0, pa1, pa2, pa3);
                else if (D0 == 1) at::pv_one<1>(sT, vb0, pa0, pa1, pa2, pa3);
                else if (D0 == 2) at::pv_one<2>(sT, vb0, pa0, pa1, pa2, pa3);
                else at::pv_one<3>(sT, vb0, pa0, pa1, pa2, pa3);
            }
            __syncthreads();
        }
#undef LD_K
#undef LD_A
#undef LD_TB
#undef LD_IN
#undef LD_EG
#undef LD_D
#undef SCAN_C68
#undef SCAN_BASE
#undef SCAN_REC
    }
}

#if defined(EXP_NAIVE_DN)
__device__ __forceinline__ void phase_dn_naive(const Args& a, unsigned char* shm) {
    const int tid = tid_opaque(), dvl = tid & 63, kg = tid >> 6;
    float* red = (float*)shm;
    const u16* qd = (const u16*)(a.ws + O_QD); const u16* kd = (const u16*)(a.ws + O_KD); const u16* vd = (const u16*)(a.ws + O_VD1); const float* BA = (const float*)(a.ws + O_BA);
    for (int task = blockIdx.x; task < 256; task += gridDim.x) {
        const int half = task & 1, dir = (task >> 1) & 1, h = (task >> 2) & 7, b = task >> 5;
#if defined(EXP_HYBRID)
        if (!(EXP_HYBRID)) continue;
#endif
        u16* Od = (u16*)a.out + (dir ? (size_t)MLAT * 1024 : (size_t)0);
        float S[16];
#pragma unroll
        for (int e = 0; e < 16; ++e) S[e] = 0.f;
        const float alog = a.in[14][dir * 8 + h], dtb = a.in[15][dir * 8 + h];
        for (int n = 0; n < 4352; ++n) {
            int row; if (n < 256) { const int t = dir ? 255 - n : n; row = MLAT + b * 256 + t; } else { const int t = dir ? 4095 - (n - 256) : (n - 256); row = b * 4096 + t; }
            const float* bap = BA + (size_t)row * 32;
            const float beta = sigm_f(bap[dir * 8 + h]);
            const float xs = bap[16 + dir * 8 + h] + dtb;
            const float g = -__expf(alog) * (fmaxf(xs, 0.f) + log1pf(__expf(-fabsf(xs))));
            const float eg = __expf(g);
            const u16* kp = kd + (size_t)row * 1024 + h * 128 + kg * 16; const u16* qp = qd + (size_t)row * 1024 + h * 128 + kg * 16;
            float kk[16], qq[16];
#pragma unroll
            for (int e = 0; e < 16; ++e) { kk[e] = bf2f(kp[e]); qq[e] = bf2f(qp[e]); }
            const float v = bf2f(vd[(size_t)row * 1024 + h * 128 + half * 64 + dvl]);
            float ps = 0.f;
#pragma unroll
            for (int e = 0; e < 16; ++e) { S[e] *= eg; ps += kk[e] * S[e]; }
            red[kg * 64 + dvl] = ps;
            __syncthreads();
            float ks = 0.f;
#pragma unroll
            for (int g8 = 0; g8 < 8; ++g8) ks += red[g8 * 64 + dvl];
            __syncthreads();
            const float delta = beta * (v - ks);
            float po = 0.f;
#pragma unroll
            for (int e = 0; e < 16; ++e) { S[e] += kk[e] * delta; po += qq[e] * S[e]; }
            red[kg * 64 + dvl] = po;
            __syncthreads();
            if (n >= 256 && kg == 0) { float o = 0.f;
#pragma unroll
                for (int g8 = 0; g8 < 8; ++g8) o += red[g8 * 64 + dvl];
                Od[(size_t)row * 1024 + h * 128 + half * 64 + dvl] = f2bf(o); }
            __syncthreads();
        }
    }
}
#endif


#if defined(EXP_VALU_SCAN)
#define BR(x) bf2f(f2bf(x))
__device__ __forceinline__ void phase_dn_scan_valu(const Args& a, unsigned char* shm) {
    const int tid = tid_opaque(), dvl = tid & 63, rg = tid >> 6;
    float* S = (float*)shm; float* kc = S + 8192; float* qc = kc + 8192; float* rr = qc + 8192; float* vn = rr + 4096;
    const u16* qd = (const u16*)(a.ws + O_QD); const u16* kd = (const u16*)(a.ws + O_KD);
    const unsigned char* REC = a.ws + O_REC;
    for (int task = blockIdx.x; task < 256; task += gridDim.x) {
        const int half = task & 1, dir = (task >> 1) & 1, h = (task >> 2) & 7, b = task >> 5;
        u16* Od = (u16*)a.out + (dir ? (size_t)MLAT * 1024 : (size_t)0);
        for (int i = tid; i < 8192; i += 512) S[i] = 0.f;
        __syncthreads();
        for (int n = 0; n < 68; ++n) {
            const int c68 = n < 4 ? (dir ? 3 - n : n) : (dir ? 71 - n : n);
            const int base = c68 < 4 ? MLAT + b * 256 + c68 * 64 : b * 4096 + (c68 - 4) * 64;
            const unsigned char* rec = REC + (size_t)((((b * 8 + h) * 2 + dir) * 68) + c68) * REC_BYTES;
            const u16* Tb = (const u16*)rec; const u16* In = (const u16*)(rec + 8192); const float* rf = (const float*)(rec + 16384);
            for (int i = tid; i < 8192; i += 512) { const int p = i >> 7, dk = i & 127, t = dir ? 63 - p : p;
                kc[i] = bf2f(kd[(size_t)(base + t) * 1024 + h * 128 + dk]); qc[i] = bf2f(qd[(size_t)(base + t) * 1024 + h * 128 + dk]); }
            __syncthreads();
            float QS[8];
#pragma unroll
            for (int m = 0; m < 8; ++m) { const int i = rg + 8 * m, t = dir ? 63 - i : i; float ks = 0.f, qs = 0.f;
                for (int dk = 0; dk < 128; ++dk) { const float sv = BR(S[dk * 64 + dvl]); ks += kc[i * 128 + dk] * sv; qs += qc[i * 128 + dk] * sv; }
                QS[m] = qs; rr[i * 64 + dvl] = BR(bf2f(vd[(size_t)(base + t) * 1024 + h * 128 + half * 64 + dvl]) - rf[i] * ks); }
            __syncthreads();
#pragma unroll
            for (int m = 0; m < 8; ++m) { const int i = rg + 8 * m; float s = 0.f;
                for (int j = 0; j < 64; ++j) s += bf2f(Tb[i * 64 + j]) * rr[j * 64 + dvl];
                vn[i * 64 + dvl] = s; }
            __syncthreads();
#pragma unroll
            for (int m = 0; m < 8; ++m) { const int i = rg + 8 * m, t = dir ? 63 - i : i; float s = rf[i] * QS[m];
                for (int j = 0; j < 64; ++j) s += bf2f(In[i * 64 + j]) * BR(vn[j * 64 + dvl]);
                if (n >= 4) Od[(size_t)(base + t) * 1024 + h * 128 + half * 64 + dvl] = f2bf(s); }
            { const float d = rf[128];
#pragma unroll
                for (int e = 0; e < 16; ++e) { const int dk = rg * 16 + e; float s = d * S[dk * 64 + dvl];
                    for (int t = 0; t < 64; ++t) s += kc[t * 128 + dk] * BR(rf[64 + t] * vn[t * 64 + dvl]);
                    S[dk * 64 + dvl] = s; } }
            __syncthreads();
        }
    }
}
#endif

__device__ __forceinline__ void rope8(f32x4& v0, f32x4& v1, const f32x4 p0, const f32x4 p1, bool second, float pos, int f0) {
#pragma unroll
    for (int j = 0; j < 8; ++j) {
        const float invf = exp2f(-(float)(f0 + j) * (13.287712379549449f / 32.f));
        const float ang = pos * invf; const float c = __cosf(ang), s = __sinf(ang);
        const float mine = j < 4 ? v0[j & 3] : v1[j & 3], other = j < 4 ? p0[j & 3] : p1[j & 3];
        const float o = second ? (mine * c + other * s) : (mine * c - other * s);
        if (j < 4) v0[j & 3] = o; else v1[j & 3] = o;
    }
}
__device__ __forceinline__ void phase_attn_prep(const Args& a) {
    const int lane = tid_opaque() & 63, gw = blockIdx.x * 8 + (tid_opaque() >> 6), nw = gridDim.x * 8;
    u16* QA = (u16*)(a.ws + O_QA); const u16* KVA = (const u16*)(a.ws + O_KVA); u16* KALL = (u16*)(a.ws + O_KALL); u16* VALL = (u16*)(a.ws + O_VALL);
    const float* qn = a.in[18]; const float* kn = a.in[19];
    for (int row = gw; row < MALL; row += nw) {
        const bool lat = row < MLAT;
        const int t = lat ? (row & 4095) : ((row - MLAT) & 255); const int b = lat ? (row >> 12) : ((row - MLAT) >> 8);
        {
            const u16* kp = KVA + (size_t)row * 512 + 4 * lane;
            const u32x2 ku = *(const u32x2*)kp; const u32x2 vu = *(const u32x2*)(kp + 256);
            f32x4 kv = (f32x4){bf_lo(ku.x), bf_hi(ku.x), bf_lo(ku.y), bf_hi(ku.y)};
            const int d = 4 * (lane & 31);
            float ss = kv[0] * kv[0] + kv[1] * kv[1] + kv[2] * kv[2] + kv[3] * kv[3];
            ss = grp32_sum(ss); const float rs = rsqrtf(ss * (1.f / 128.f) + 1e-6f);
            kv = kv * rs * *(const f32x4*)(kn + d);
            f32x4 pp;
#pragma unroll
            for (int j = 0; j < 4; ++j) pp[j] = __shfl_xor(kv[j], 8);
            if (lat) { const bool second = (lane >> 3) & 1; const int axis = (lane >> 4) & 1; const float pos = axis ? (float)(t & 63) : (float)(t >> 6);
#pragma unroll
                for (int j = 0; j < 4; ++j) { const float invf = exp2f(-(float)((d & 31) + j) * (13.287712379549449f / 32.f)); const float ang = pos * invf; const float c = __cosf(ang), s = __sinf(ang);
                    kv[j] = second ? (kv[j] * c + pp[j] * s) : (kv[j] * c - pp[j] * s); } }
            const size_t orow = (size_t)b * 4352 + (lat ? 256 + t : t);
            u32x2 ko; ko.x = pk(kv[0], kv[1]); ko.y = pk(kv[2], kv[3]);
            *(u32x2*)(KALL + orow * 256 + 4 * lane) = ko; *(u32x2*)(VALL + orow * 256 + 4 * lane) = vu;
        }
    }
}

__device__ __forceinline__ void phase_attn(const Args& a, unsigned char* shm) {
    u16* QA = (u16*)(a.ws + O_QA); const u16* KALL = (const u16*)(a.ws + O_KALL); const u16* VALL = (const u16*)(a.ws + O_VALL);
    const int nblk = gridDim.x;
    for (int it = 0;; ++it) {
        int task;
        if (nblk == 256) { if (it >= 4) break; const int xcd = blockIdx.x & 7, slot = blockIdx.x >> 3; const int tix = it * 32 + slot; task = (xcd * 2 + (tix >> 6)) * 64 + (tix & 63); }
        else { task = blockIdx.x + it * nblk; if (task >= 1024) break; }
        const int grp = task >> 6, within = task & 63, b = grp >> 1, kvh = grp & 1, qb = within >> 2, g = within & 3, head = kvh * 4 + g;
        u16* Qb = QA + ((size_t)b * 4096 + qb * 256) * 1024 + head * 128;
        const u16* Kh = KALL + (size_t)b * 4352 * 256 + kvh * 128; const u16* Vh = VALL + (size_t)b * 4352 * 256 + kvh * 128;
        at::attn_dense_body<at::bf16>((const at::bf16*)Qb, (const at::bf16*)Kh, (const at::bf16*)Vh, Qb, 4352, (char*)shm, qb * 256, a.in[18]);
        __syncthreads();
    }
}

__device__ __forceinline__ void phase_merge_prep(const Args& a) {
    const int lane = tid_opaque() & 63, gw = blockIdx.x * 8 + (tid_opaque() >> 6), nw = gridDim.x * 8;
    const u16* OF = (const u16*)a.out; const u16* OB = OF + (size_t)MLAT * 1024; const u16* Z = (const u16*)(a.ws + O_Z); u16* A3 = (u16*)(a.ws + O_A3);
    const float* dnn = a.in[16];
    const int d = 8 * (lane & 15); const f32x4 g0 = *(const f32x4*)(dnn + d), g1 = *(const f32x4*)(dnn + d + 4);
    for (int row = gw; row < MLAT; row += nw) {
#pragma unroll
        for (int i = 0; i < 2; ++i) { const size_t off = (size_t)row * 1024 + 512 * i + 8 * lane;
            f32x4 f0, f1, b0, b1, z0, z1; unpk8(*(const u32x4*)(OF + off), f0, f1); unpk8(*(const u32x4*)(OB + off), b0, b1); unpk8(*(const u32x4*)(Z + off), z0, z1);
            f0 += b0; f1 += b1;
            float ss = 0.f;
#pragma unroll
            for (int j = 0; j < 4; ++j) ss += f0[j] * f0[j] + f1[j] * f1[j];
            ss = grp16_sum(ss); const float rs = rsqrtf(ss * (1.f / 128.f) + 1e-6f);
#pragma unroll
            for (int j = 0; j < 4; ++j) { f0[j] = f0[j] * rs * g0[j] * silu_f(z0[j]); f1[j] = f1[j] * rs * g1[j] * silu_f(z1[j]); }
            *(u32x4*)(A3 + off) = pk8(f0, f1); }
    }
}

__global__ void __launch_bounds__(512, 2) fwd_megakernel(Args a) {
    extern __shared__ __attribute__((aligned(16))) unsigned char shm[];
    cg::grid_group grid = cg::this_grid();
    volatile LAS unsigned* xst = (volatile LAS unsigned*)(shm + LDS_BYTES - 16);
    if (threadIdx.x == 0) { xst[0] = 0u; xst[1] = 0u; }
    __syncthreads();
    const xb::XcdBarrier XB = xb::xcd_barrier_post((unsigned*)(a.ws + O_BAR), xst);
#define GSYNC() xb::xcd_barrier(XB)
    unsigned char* ws = a.ws;
    const long gtid = (long)blockIdx.x * 512 + threadIdx.x, gth = (long)gridDim.x * 512;
    cvt_w<1>(a.in[8], 1024, 5632, (u16*)(ws + O_WGU1), 5632, gtid, gth);
    phase_mod(a, shm);
#if defined(EXP_SELFCHK)
    if (blockIdx.x == 0 && threadIdx.x == 0) *(unsigned*)(ws + O_MOD + 9 * 9216 * 4) = 0u;
#endif
    grid.sync();
    phase_h1(a);
    GSYNC();
    { EpiSwiglu E; E.O = (u16*)(ws + O_ACT); run_gemm(shm, (const u16*)(ws + O_A), (const u16*)(ws + O_WGU1), MALL, 5632, 1024, E); }
    { const int G = gridDim.x, rem = ((MALL / 256) * 22) % G;
      if (rem == 0 || (int)blockIdx.x >= rem) { const int f = rem == 0 ? 0 : rem; const long gt = (long)((int)blockIdx.x - f) * 512 + threadIdx.x, gn = (long)(G - f) * 512;
        cvt_w<0>(a.in[9], 2816, 1024, (u16*)(ws + O_WD1), 1024, gt, gn);
        cvt_w<2>(a.in[12], 1024, INW, (u16*)(ws + O_WIN1), 3328, gt, gn); } }
    GSYNC();
    { EpiPlain E; E.O = (u16*)(ws + O_Y1); E.ldc = 1024; run_gemm(shm, (const u16*)(ws + O_ACT), (const u16*)(ws + O_WD1), MLAT, 1024, 2816, E); }
    GSYNC();
    { EpiPlain E; E.O = (u16*)(ws + O_Y1) + (size_t)MLAT * 1024; E.ldc = 1024; run_gemm(shm, (const u16*)(ws + O_ACT) + (size_t)MLAT * FH, (const u16*)(ws + O_WD1), MCTX, 1024, 2816, E); }
    { const int G = gridDim.x, f = G > 32 ? 32 : 0;
      if ((int)blockIdx.x >= f) { const long gt = (long)((int)blockIdx.x - f) * 512 + threadIdx.x, gn = (long)(G - f) * 512;
        cvt_w<3>(a.in[12], 1024, INW, (u16*)(ws + O_WIN2), 4608, gt, gn); }
      phase_h2(a, 0, MLAT, f, G - f); }
    GSYNC();
    phase_h2(a, MLAT, MALL);
    GSYNC();
    { EpiIn1 E; E.q = (u16*)(ws + O_QRAW); E.k = (u16*)(ws + O_KRAW); E.v = (u16*)a.out; E.ba = (float*)(ws + O_BA); run_gemm(shm, (const u16*)(ws + O_A), (const u16*)(ws + O_WIN1), MALL, 3328, 1024, E); }
    GSYNC();
    phase_dn_prep(a);
    GSYNC();
#if defined(EXP_NAIVE_DN) && !defined(EXP_HYBRID)
    phase_dn_naive(a, shm);
#else
    phase_dn_pre(a, shm);
    GSYNC();
#if defined(EXP_VALU_SCAN)
    phase_dn_scan_valu(a, shm);
#else
    phase_dn_scan(a, shm);
#endif
#if defined(EXP_HYBRID)
    GSYNC();
    phase_dn_naive(a, shm);
#endif
#endif
    GSYNC();
    { EpiIn2 E; E.z = (u16*)(ws + O_Z); E.qa = (u16*)(ws + O_QA); E.kva = (u16*)(ws + O_KVA); E.gates = (u16*)(ws + O_GATES); run_gemm(shm, (const u16*)(ws + O_A), (const u16*)(ws + O_WIN2), MALL, 4608, 1024, E); }
    { const int G = gridDim.x, rem = ((MALL / 256) * 18) % G;
      if (rem == 0 || (int)blockIdx.x >= rem) { const int f = rem == 0 ? 0 : rem; const long gt = (long)((int)blockIdx.x - f) * 512 + threadIdx.x, gn = (long)(G - f) * 512;
        cvt_w<0>(a.in[17], 1024, 1024, (u16*)(ws + O_WDN), 1024, gt, gn);
        cvt_w<0>(a.in[20], 1024, 1024, (u16*)(ws + O_WAT), 1024, gt, gn);
        cvt_w<0>(a.in[21], 1024, 1024, (u16*)(ws + O_WOUT), 1024, gt, gn);
        cvt_w<1>(a.in[24], 1024, 5632, (u16*)(ws + O_WGU2), 5632, gt, gn);
        cvt_w<0>(a.in[25], 2816, 1024, (u16*)(ws + O_WD2), 1024, gt, gn); } }
    GSYNC();
    phase_attn_prep(a);
    GSYNC();
    phase_attn(a, shm);
    GSYNC();
    phase_merge_prep(a);
    GSYNC();
    { EpiMerge<0> E; E.gates = (const u16*)(ws + O_GATES); E.T = (u16*)(ws + O_T); run_gemm(shm, (const u16*)(ws + O_A3), (const u16*)(ws + O_WDN), MLAT, 1024, 1024, E); }
    { EpiMerge<1> E; E.gates = (const u16*)(ws + O_GATES); E.T = (u16*)(ws + O_T); run_gemm(shm, (const u16*)(ws + O_QA), (const u16*)(ws + O_WAT), MLAT, 1024, 1024, E); }
    GSYNC();
    { EpiPlain E; E.O = (u16*)(ws + O_Y); E.ldc = 1024; run_gemm(shm, (const u16*)(ws + O_T), (const u16*)(ws + O_WOUT), MLAT, 1024, 1024, E); }
    GSYNC();
    phase_h3(a);
    GSYNC();
    { EpiSwiglu E; E.O = (u16*)(ws + O_ACT2); run_gemm(shm, (const u16*)(ws + O_A5), (const u16*)(ws + O_WGU2), MLAT, 5632, 1024, E); }
    GSYNC();
    { EpiPlain E; E.O = (u16*)(ws + O_Y2); E.ldc = 1024; run_gemm(shm, (const u16*)(ws + O_ACT2), (const u16*)(ws + O_WD2), MLAT, 1024, 2816, E); }
    GSYNC();
    phase_out(a);
#if defined(EXP_SELFCHK)
    GSYNC();
    if (blockIdx.x == 0 && threadIdx.x == 0) { const unsigned f = *(volatile unsigned*)(ws + O_MOD + 9 * 9216 * 4);
        if (f & 8u) a.out[0] += 6.2e6f; if (f & 4u) a.out[1] += 6.2e5f; if (f & 2u) a.out[2] += 6.2e4f; if (f & 1u) a.out[3] += 6.2e3f; }
#endif
}

extern "C" void kernel_launch(void* const* d_in, const int* in_sizes, int n_in, void* d_out, int out_size, void* d_ws, size_t ws_size, hipStream_t stream) {
    static int grid_blocks = 0;
    if (grid_blocks == 0) {
        if (n_in != 26 || out_size != MLAT * 1024 || ws_size < WS_NEED) { fprintf(stderr, "kernel_launch: unexpected shapes: n_in %d out %d ws %zu (need %zu)\n", n_in, out_size, ws_size, (size_t)WS_NEED); grid_blocks = -1; return; }
        int dev = 0, cus = 0, per_cu = 0;
        hipGetDevice(&dev);
        hipDeviceGetAttribute(&cus, hipDeviceAttributeMultiprocessorCount, dev);
        if (hipFuncSetAttribute((const void*)fwd_megakernel, hipFuncAttributeMaxDynamicSharedMemorySize, LDS_BYTES) != hipSuccess) { fprintf(stderr, "kernel_launch: hipFuncSetAttribute failed\n"); grid_blocks = -1; return; }
        if (hipOccupancyMaxActiveBlocksPerMultiprocessor(&per_cu, (const void*)fwd_megakernel, 512, LDS_BYTES) != hipSuccess || per_cu < 1) { fprintf(stderr, "kernel_launch: occupancy query failed (%d)\n", per_cu); (void)hipGetLastError(); per_cu = 1; }
        grid_blocks = cus * per_cu;
    }
    if (grid_blocks < 0) return;
    if (hipMemsetAsync((char*)d_ws + O_BAR, 0, XCD_BAR_WORDS * sizeof(unsigned), stream) != hipSuccess) { fprintf(stderr, "kernel_launch: memset of the barrier words failed\n"); return; }
    Args a{};
    for (int i = 0; i < 26; ++i) a.in[i] = (const float*)d_in[i];
    a.out = (float*)d_out; a.ws = (unsigned char*)d_ws;
    void* args[] = {&a};
    hipError_t e = hipLaunchCooperativeKernel((const void*)fwd_megakernel, dim3(grid_blocks), dim3(512), args, LDS_BYTES, stream);
    if (e != hipSuccess) fprintf(stderr, "cooperative launch failed: %s (grid %d)\n", hipGetErrorString(e), grid_blocks);
}
```

```cpp
#include <hip/hip_runtime.h>
#include <hip/hip_bf16.h>
#include <hip/hip_cooperative_groups.h>
#include <cstdio>
#include <cstdint>
namespace cg = cooperative_groups;
__device__ __forceinline__ int tid_opaque() { int t = threadIdx.x; asm volatile("" : "+v"(t)); return t; }
namespace pg8 {
#define PG8_LAS __attribute__((address_space(3)))
typedef unsigned short bf16_t;
typedef short bf16x8 __attribute__((ext_vector_type(8)));
typedef float f32x4 __attribute__((ext_vector_type(4)));
typedef unsigned u32x4 __attribute__((ext_vector_type(4)));
constexpr int BM = 256, BK = 64, HALF = 128, HTB = HALF * BK * 2  , STAGE_BYTES = 8 * HTB, NXCD = 8, WGM = 8;

__host__ __device__ __forceinline__ int lds_byte(int r, int c) { const int st = (r >> 4) * 2 + (c >> 5), rr = r & 15, cc = c & 31, ob = rr * 64 + cc * 2; return st * 1024 + (ob ^ (((ob >> 9) & 1) << 5)); }
__host__ __device__ __forceinline__ void stage_rc(int b, int& R, int& C) { const int st = b / 1024, sb = b % 1024, swz = sb ^ (((sb >> 9) & 1) << 5); R = (st >> 1) * 16 + swz / 64; C = (st & 1) * 32 + (swz % 64) / 2; }
__host__ __device__ __forceinline__ int perm32(int rho) { const int n = rho >> 4, i = rho & 15; return 8 * (i >> 2) + 4 * n + (i & 3); }

struct Unit { int pm, pn; };
struct Gemm { const bf16_t* A; const bf16_t* Bt; int M, N, K; };

struct StaticOrder {
    int nM, nN, nwg, G, c;
    __host__ __device__ void init(int M, int N, int G_, int c_) { nM = M / BM; nN = N / BM; nwg = nM * nN; G = G_; c = c_; }
    __host__ __device__ bool next(int i, Unit& u) const {
        const long L = (long)i * G + c; if (L >= nwg) return false;
        int wgid = (int)L; { const int q = nwg / NXCD, r = nwg % NXCD, xcd = wgid % NXCD, off = wgid / NXCD; wgid = (xcd < r ? xcd * (q + 1) : r * (q + 1) + (xcd - r) * q) + off; }
        const int nig = WGM * nN, gid = wgid / nig, fm = gid * WGM, gsz = (nM - fm) < WGM ? (nM - fm) : WGM;
        u.pm = fm + ((wgid % nig) % gsz); u.pn = (wgid % nig) / gsz; return true;
    }
    __device__ __forceinline__ void a_ready(const Unit&) const {}
    __device__ __forceinline__ void done(const Unit&) const {}
};
__device__ __forceinline__ unsigned cvt_pk_bf16(float lo, float hi) { unsigned r; asm volatile("v_cvt_pk_bf16_f32 %0, %1, %2" : "=v"(r) : "v"(lo), "v"(hi)); return r; }

template <class Epi, class Sched, bool STAMP = false>
__device__ __forceinline__ void gemm_phase(PG8_LAS unsigned char* lds, const Gemm g, const Sched& S, const Epi& E, unsigned long long* stamps) {
    const int tid = tid_opaque(), wid = __builtin_amdgcn_readfirstlane(tid >> 6), lane = tid & 63, wr = wid >> 2, wc = wid & 3, fr = lane & 15, fq = lane >> 4;
    const int K = g.K, nt = K / BK;
    int ts_lo = 0, ts_hi = 0, nts = 0; const unsigned long long rt_entry = STAMP ? (unsigned long long)wall_clock64() : 0ull;
#define PG8_STAMP() do { if (STAMP && wid == 0 && nts < 64) { const unsigned long long _c = (unsigned long long)clock64(); \
        ts_lo = (lane == nts) ? (int)(unsigned)_c : ts_lo; ts_hi = (lane == nts) ? (int)(unsigned)(_c >> 32) : ts_hi; ++nts; } } while (0)
    PG8_STAMP();
    unsigned voffA[2], voffB[2];
#pragma unroll
    for (int i = 0; i < 2; ++i) { int R, C; stage_rc(tid * 16 + i * 8192, R, C); const int Rb = Epi::PERM ? ((R & ~31) + perm32(R & 31)) : R;
        voffA[i] = (unsigned)(R * K + C) * 2u; voffB[i] = (unsigned)(Rb * K + C) * 2u; }
    const size_t kstep = (size_t)(BK * 2);
    const size_t hstep = (size_t)HALF * K * 2;
    const size_t tstep = 2 * hstep;
    const unsigned ldsw = (unsigned)wid * 1024u;
    const int aoff = lds_byte(wr * 64 + fr, fq * 8), boff = lds_byte(wc * 32 + fr, fq * 8);
#define PG8_SA(b, h) (((b) * 2 + (h)) * HTB)
#define PG8_SB(b, h) ((4 + (b) * 2 + (h)) * HTB)
#define PG8_STAGE(bufoff, gbase, voff) do { _Pragma("unroll") for (int _i = 0; _i < 2; ++_i) \
        __builtin_amdgcn_global_load_lds((const unsigned*)((const char*)(gbase) + (voff)[_i]), (PG8_LAS unsigned*)(lds + (bufoff) + ldsw + _i * 8192), 16, 0, 0); } while (0)
#define PG8_LDA(dst, b, h) do { _Pragma("unroll") for (int m = 0; m < 4; ++m) _Pragma("unroll") for (int k = 0; k < 2; ++k) dst[m][k] = *(const PG8_LAS bf16x8*)(lds + PG8_SA(b, h) + aoff + m * 2048 + k * 1024); } while (0)
#define PG8_LDB(dst, b, h) do { _Pragma("unroll") for (int n = 0; n < 2; ++n) _Pragma("unroll") for (int k = 0; k < 2; ++k) dst[n][k] = *(const PG8_LAS bf16x8*)(lds + PG8_SB(b, h) + boff + n * 2048 + k * 1024); } while (0)
#define PG8_MMA(ai, bj, At, Bt) do { __builtin_amdgcn_s_setprio(1); _Pragma("unroll") for (int m = 0; m < 4; ++m) _Pragma("unroll") for (int n = 0; n < 2; ++n) _Pragma("unroll") for (int k = 0; k < 2; ++k) \
        acc[ai][bj][m][n] = __builtin_amdgcn_mfma_f32_16x16x32_bf16(Bt[n][k], At[m][k], acc[ai][bj][m][n], 0, 0, 0); __builtin_amdgcn_s_setprio(0); } while (0)
#define PG8_WAIT_V(n) asm volatile("s_waitcnt vmcnt(" #n ")" ::: "memory")
#define PG8_WAIT_L(n) asm volatile("s_waitcnt lgkmcnt(" #n ")" ::: "memory")
#define PG8_BAR __builtin_amdgcn_s_barrier()
#define PG8_SCHED __builtin_amdgcn_sched_barrier(0)
    Unit cur, nxt; int ui = 0;
    if (!S.next(0, cur)) return;
    f32x4 acc[2][2][4][2];
#pragma unroll
    for (int a = 0; a < 2; ++a)
#pragma unroll
        for (int b = 0; b < 2; ++b)
#pragma unroll
            for (int m = 0; m < 4; ++m)
#pragma unroll
                for (int n = 0; n < 2; ++n) acc[a][b][m][n] = (f32x4){0.f, 0.f, 0.f, 0.f};
    bf16x8 At[4][2], B0[2][2], B1[2][2];
    const char* cA = (const char*)g.A + (size_t)cur.pm * tstep; const char* cB = (const char*)g.Bt + (size_t)cur.pn * tstep;
    S.a_ready(cur);
    PG8_STAGE(PG8_SB(0, 0), cB, voffB); PG8_STAGE(PG8_SA(0, 0), cA, voffA); PG8_STAGE(PG8_SB(0, 1), cB + hstep, voffB); PG8_STAGE(PG8_SA(0, 1), cA + hstep, voffA);
    if (wr == 1) PG8_BAR;
    PG8_WAIT_V(4); PG8_BAR;
    PG8_STAGE(PG8_SB(1, 0), cB + kstep, voffB); PG8_STAGE(PG8_SA(1, 0), cA + kstep, voffA); PG8_STAGE(PG8_SB(1, 1), cB + hstep + kstep, voffB);
    PG8_WAIT_V(6); PG8_BAR;
    PG8_STAMP();
    for (;;) {
        const bool has_next = S.next(ui + 1, nxt);
        const char* nA = has_next ? (const char*)g.A + (size_t)nxt.pm * tstep : cA; const char* nB = has_next ? (const char*)g.Bt + (size_t)nxt.pn * tstep : cB;
        for (int t = 0; t < nt; t += 2) {
            const bool last = (t == nt - 2);
            const char* a1 = cA + (size_t)(t + 1) * kstep;
            const char* a2 = last ? nA : cA + (size_t)(t + 2) * kstep; const char* b2 = last ? nB : cB + (size_t)(t + 2) * kstep;
            const char* a3 = a2 + kstep; const char* b3 = b2 + kstep;
            if (last && has_next) S.a_ready(nxt);
            PG8_LDB(B0, 0, 0); PG8_SCHED; PG8_LDA(At, 0, 0); PG8_STAGE(PG8_SA(1, 1), a1 + hstep, voffA);
            PG8_WAIT_L(8); PG8_BAR; PG8_WAIT_L(0); PG8_MMA(0, 0, At, B0); PG8_BAR; PG8_SCHED;
            PG8_LDB(B1, 0, 1); PG8_STAGE(PG8_SB(0, 0), b2, voffB);
            PG8_BAR; PG8_WAIT_L(0); PG8_MMA(0, 1, At, B1); PG8_BAR;
            PG8_LDA(At, 0, 1); PG8_STAGE(PG8_SA(0, 0), a2, voffA);
            PG8_BAR; PG8_WAIT_L(0); PG8_MMA(1, 0, At, B0); PG8_BAR; PG8_SCHED;
            PG8_STAGE(PG8_SB(0, 1), b2 + hstep, voffB);
            PG8_WAIT_V(6); PG8_BAR; PG8_MMA(1, 1, At, B1); PG8_BAR;
            PG8_LDB(B0, 1, 0); PG8_SCHED; PG8_LDA(At, 1, 0); PG8_STAGE(PG8_SA(0, 1), a2 + hstep, voffA);
            PG8_WAIT_L(8); PG8_BAR; PG8_WAIT_L(0); PG8_MMA(0, 0, At, B0); PG8_BAR; PG8_SCHED;
            PG8_LDB(B1, 1, 1); PG8_STAGE(PG8_SB(1, 0), b3, voffB);
            PG8_BAR; PG8_WAIT_L(0); PG8_MMA(0, 1, At, B1); PG8_BAR;
            PG8_LDA(At, 1, 1); PG8_STAGE(PG8_SA(1, 0), a3, voffA);
            PG8_BAR; PG8_WAIT_L(0); PG8_MMA(1, 0, At, B0); PG8_BAR; PG8_SCHED;
            PG8_STAGE(PG8_SB(1, 1), b3 + hstep, voffB);
            PG8_WAIT_V(6); PG8_BAR; PG8_MMA(1, 1, At, B1); PG8_BAR;
        }
        PG8_STAMP();
        if constexpr (!Epi::AFTER_DRAIN) { E(acc, cur, wr, wc, fr, fq); S.done(cur); }
        PG8_STAMP();
        if (!has_next) break;
#pragma unroll
        for (int a = 0; a < 2; ++a)
#pragma unroll
            for (int b = 0; b < 2; ++b)
#pragma unroll
                for (int m = 0; m < 4; ++m)
#pragma unroll
                    for (int n = 0; n < 2; ++n) acc[a][b][m][n] = (f32x4){0.f, 0.f, 0.f, 0.f};
        cur = nxt; cA = nA; cB = nB; ++ui;
    }
    PG8_WAIT_V(0);
    if (wr == 0) PG8_BAR;
    PG8_BAR;
    if constexpr (Epi::AFTER_DRAIN) { E.fused(acc, cur, wr, wc, fr, fq, lds, wid, lane); S.done(cur); }
    PG8_STAMP();
    if (STAMP && wid == 0) { stamps[lane] = lane < nts ? (((unsigned long long)(unsigned)ts_hi << 32) | (unsigned)ts_lo) : 0ull;
        if (lane == 62) stamps[62] = rt_entry; if (lane == 63) stamps[63] = (unsigned long long)wall_clock64(); }
#undef PG8_STAMP
#undef PG8_SA
#undef PG8_SB
#undef PG8_STAGE
#undef PG8_LDA
#undef PG8_LDB
#undef PG8_MMA
#undef PG8_WAIT_V
#undef PG8_WAIT_L
#undef PG8_BAR
#undef PG8_SCHED
}
}
namespace xb {

#define XB_TMO      128
#define XB_XCNT(j)  (256  + 64 * (j))
#define XB_XSUB(j)  (1280 + 64 * (j))
#define XB_XGEN(j)  (2304 + 64 * (j))
#define XB_TOP      3328
#define XB_TOPGEN   3392
#define XCD_BAR_WORDS 3456
#define XB_SPIN_CAP (1u << 18)
#define LAS __attribute__((address_space(3)))

__device__ __forceinline__ unsigned xb_ld(unsigned* p)              { return __hip_atomic_load(p, __ATOMIC_RELAXED, __HIP_MEMORY_SCOPE_AGENT); }
__device__ __forceinline__ unsigned xb_add(unsigned* p, unsigned v) { return __hip_atomic_fetch_add(p, v, __ATOMIC_RELAXED, __HIP_MEMORY_SCOPE_AGENT); }
__device__ __forceinline__ unsigned xb_xcc_id() { return (unsigned)__builtin_amdgcn_s_getreg((3 << 11) | 20) & 0xFu; }
#define XB_SPIN(cond, bar) do { unsigned _sp = 0; while (cond) { __builtin_amdgcn_s_sleep(1); \
    if ((++_sp & 255u) == 0u) { if (xb_ld(&(bar)[XB_TMO])) break; if (_sp > XB_SPIN_CAP) { atomicAdd(&(bar)[XB_TMO], 1u); break; } } } } while (0)

struct XcdBarrier {
    unsigned* bar; unsigned x;
    volatile LAS unsigned* st;
};

__device__ __forceinline__ XcdBarrier xcd_barrier_post(unsigned* bar, volatile LAS unsigned* st) {
    XcdBarrier b; b.bar = bar; b.x = xb_xcc_id(); b.st = st;
    if (threadIdx.x == 0) (void)xb_add(&bar[XB_XCNT(b.x)], 1u);
    return b;
}
__device__ __forceinline__ void xcd_barrier_complete(unsigned* bar, unsigned x, unsigned& nloc, unsigned& nx) {
    const unsigned G = gridDim.x * gridDim.y * gridDim.z;
    unsigned sum, cnt, mine, sp = 0u;
    for (;;) {
        sum = 0u; cnt = 0u; mine = 0u;
#pragma unroll
        for (unsigned j = 0; j < 16; ++j) { const unsigned c = xb_ld(&bar[XB_XCNT(j)]); sum += c; cnt += (c > 0u) ? 1u : 0u; mine = (j == x) ? c : mine; }
        if (sum == G) break;
        __builtin_amdgcn_s_sleep(1);
        if ((++sp & 255u) == 0u) { if (xb_ld(&bar[XB_TMO])) break; if (sp > XB_SPIN_CAP) { atomicAdd(&bar[XB_TMO], 1u); break; } }
    }
    nloc = mine > 0u ? mine : 1u; nx = cnt > 0u ? cnt : 1u;
}

__device__ __forceinline__ void xcd_barrier(const XcdBarrier& b) {
    asm volatile("s_waitcnt vmcnt(0)" ::: "memory");
    __syncthreads();
    if (threadIdx.x == 0) {
        unsigned* bar = b.bar;
        __builtin_amdgcn_s_waitcnt(0);
        unsigned nloc = b.st[0], nx = b.st[1];
        if (nloc == 0u) { xcd_barrier_complete(bar, b.x, nloc, nx); b.st[0] = nloc; b.st[1] = nx; }
        const unsigned old = xb_add(&bar[XB_XSUB(b.x)], 1u);
        const unsigned gen = old / nloc;
        if (old + 1u == (gen + 1u) * nloc) {
            __builtin_amdgcn_fence(__ATOMIC_RELEASE, "agent");
            asm volatile("s_waitcnt vmcnt(0)" ::: "memory");
            const unsigned og = xb_add(&bar[XB_TOP], 1u);
            const unsigned tg = og / nx;
            if (og + 1u == (tg + 1u) * nx) xb_add(&bar[XB_TOPGEN], 1u);
            else XB_SPIN(xb_ld(&bar[XB_TOPGEN]) == tg, bar);
            __builtin_amdgcn_fence(__ATOMIC_ACQUIRE, "agent");
            xb_add(&bar[XB_XGEN(b.x)], 1u);
            asm volatile("s_waitcnt vmcnt(0)" ::: "memory");
        } else {
            XB_SPIN(xb_ld(&bar[XB_XGEN(b.x)]) == gen, bar);
            __builtin_amdgcn_fence(__ATOMIC_ACQUIRE, "agent");
            asm volatile("s_waitcnt vmcnt(0)" ::: "memory");
        }
    }
    __syncthreads();
}

}
namespace at {
using bf16 = __hip_bfloat16;
constexpr int   D = 128, NW = 8, QBLK = 32, KVBLK = 64;
constexpr float SCALE = 0.088388347648318440f;
constexpr float THR = 8.f;
constexpr int SDEPTH = 1;
constexpr int LDQ = 1024, LDK = 256, LDO = 1024;
constexpr size_t SHM_V = KVBLK * D * 2, SHM_K = KVBLK * D * 2, SHM_ATTN = 2 * SHM_V + 2 * SHM_K + NW * 64 * 4;
__device__ __forceinline__ unsigned short f2bf_rne(float f) { unsigned u = __float_as_uint(f); u += 0x7FFFu + ((u >> 16) & 1u); return (unsigned short)(u >> 16); }
using bf16x8 = __attribute__((ext_vector_type(8))) short;
using s16x4  = __attribute__((ext_vector_type(4))) short;
using f32x16 = __attribute__((ext_vector_type(16))) float;
using f32x8  = __attribute__((ext_vector_type(8))) float;
using u32x4  = __attribute__((ext_vector_type(4))) unsigned;
#define KSWZ(row, colB) ((row) * 256 + ((colB) ^ (((row) & 7) << 4)))
#define SBAR() __builtin_amdgcn_sched_barrier(0)
__device__ __forceinline__ int crow(int r, int hi) { return (r & 3) + 8 * (r >> 2) + 4 * hi; }
__device__ __forceinline__ unsigned cvtpk(float lo, float hi) {
  unsigned r; asm volatile("v_cvt_pk_bf16_f32 %0, %1, %2" : "=v"(r) : "v"(lo), "v"(hi)); return r;
}
template <typename TIn> struct Stage;
template <> struct Stage<bf16>  { using T = bf16x8;
  __device__ static __forceinline__ T ld8(const bf16* p) { return *reinterpret_cast<const bf16x8*>(p); }
  __device__ static __forceinline__ bf16x8 tobf(T x) { return x; } };
template <> struct Stage<float> { using T = f32x8;
  __device__ static __forceinline__ T ld8(const float* p) { return *reinterpret_cast<const f32x8*>(p); }
  __device__ static __forceinline__ bf16x8 tobf(T x) {
    u32x4 w = {cvtpk(x[0], x[1]), cvtpk(x[2], x[3]), cvtpk(x[4], x[5]), cvtpk(x[6], x[7])}; return *reinterpret_cast<bf16x8*>(&w); } };

__device__ __forceinline__ void partialSM(f32x16& p0, f32x16& p1, float& m_reg, float& mn, float& alpha) {
  constexpr float C = SCALE * 1.4426950408889634f;
  float pmax = p0[0]; for (int r = 1; r < 16; ++r) pmax = fmaxf(pmax, p0[r]); for (int r = 0; r < 16; ++r) pmax = fmaxf(pmax, p1[r]);
  { auto rr = __builtin_amdgcn_permlane32_swap(__float_as_uint(pmax), __float_as_uint(pmax), false, false);
    pmax = fmaxf(__uint_as_float(rr[0]), __uint_as_float(rr[1])); }
  if (__builtin_expect(__all(pmax - m_reg <= THR / SCALE), 1)) { mn = m_reg; alpha = 1.f; }
  else { mn = fmaxf(m_reg, pmax); alpha = __builtin_amdgcn_exp2f((m_reg - mn) * C); m_reg = mn; }
  float mnC = -mn * C;
  for (int r = 0; r < 16; ++r) p0[r] = fmaf(p0[r], C, mnC); for (int r = 0; r < 16; ++r) p1[r] = fmaf(p1[r], C, mnC);
  for (int r = 0; r < 16; ++r) p0[r] = __builtin_amdgcn_exp2f(p0[r]);
}
__device__ __forceinline__ void finishSM(f32x16& p0, f32x16& p1, float alpha, float& l_reg, bf16x8& pa0, bf16x8& pa1, bf16x8& pa2, bf16x8& pa3) {
  for (int r = 0; r < 16; ++r) p1[r] = __builtin_amdgcn_exp2f(p1[r]);
  float ps = 0; for (int r = 0; r < 16; ++r) ps += p0[r]; for (int r = 0; r < 16; ++r) ps += p1[r];
  { auto rr = __builtin_amdgcn_permlane32_swap(__float_as_uint(ps), __float_as_uint(ps), false, false);
    ps = __uint_as_float(rr[0]) + __uint_as_float(rr[1]); }
  l_reg = l_reg * alpha + ps;
#define PK4(P, BASE, OUT) do { unsigned a0 = cvtpk(P[BASE + 0], P[BASE + 1]), a1 = cvtpk(P[BASE + 2], P[BASE + 3]);   \
    unsigned b0 = cvtpk(P[BASE + 4], P[BASE + 5]), b1 = cvtpk(P[BASE + 6], P[BASE + 7]);                              \
    auto r0 = __builtin_amdgcn_permlane32_swap(a0, b0, false, false); auto r1 = __builtin_amdgcn_permlane32_swap(a1, b1, false, false); \
    u32x4 w = {r0[0], r1[0], r0[1], r1[1]}; OUT = *reinterpret_cast<bf16x8*>(&w); } while (0)
  PK4(p0, 0, pa0); PK4(p0, 8, pa1); PK4(p1, 0, pa2); PK4(p1, 8, pa3);
#undef PK4
}
__device__ __forceinline__ void qkt(f32x16& p0, f32x16& p1, const bf16* Ks, const bf16x8* qr, int r32, int hi) {
  p0 = f32x16{}; p1 = f32x16{};
  for (int d0 = 0; d0 < 8; ++d0) { int cb = (d0 * 16 + hi * 8) * 2;
    bf16x8 b0 = *reinterpret_cast<const bf16x8*>((const char*)Ks + KSWZ(r32, cb));
    bf16x8 b1 = *reinterpret_cast<const bf16x8*>((const char*)Ks + KSWZ(32 + r32, cb));
    p0 = __builtin_amdgcn_mfma_f32_32x32x16_bf16(b0, qr[d0], p0, 0, 0, 0);
    p1 = __builtin_amdgcn_mfma_f32_32x32x16_bf16(b1, qr[d0], p1, 0, 0, 0); }
}
__device__ __forceinline__ int v_st(int k, int c) { const int kk = (k & ~0xC) | ((k & 4) << 1) | ((k & 8) >> 1); return ((kk >> 3) * 4 + (c >> 5)) * 512 + ((kk & 7) * 32 + (c & 31)) * 2; }
__device__ __forceinline__ int v_rd_base(int lane) { return ((lane & 3) << 3) | (((lane >> 2) & 3) << 6) | (((lane >> 4) & 1) << 5) | (((lane >> 5) & 1) << 8); }
constexpr int v_rd_off(int d0, int ks, int half) { return d0 * 512 + ks * 4096 + half * 2048; }
template <int OFF> __device__ __forceinline__ s16x4 tr_read(int vb) {
  s16x4 r; asm volatile("ds_read_b64_tr_b16 %0, %1 offset:%2" : "=&v"(r) : "v"(vb), "i"(OFF) : "memory"); return r;
}
template <int D0> __device__ __forceinline__ void pv_one(f32x16& od, int vb, bf16x8 pa0, bf16x8 pa1, bf16x8 pa2, bf16x8 pa3) {
  const s16x4 l0 = tr_read<v_rd_off(D0, 0, 0)>(vb), h0 = tr_read<v_rd_off(D0, 0, 1)>(vb), l1 = tr_read<v_rd_off(D0, 1, 0)>(vb), h1 = tr_read<v_rd_off(D0, 1, 1)>(vb);
  const s16x4 l2 = tr_read<v_rd_off(D0, 2, 0)>(vb), h2 = tr_read<v_rd_off(D0, 2, 1)>(vb), l3 = tr_read<v_rd_off(D0, 3, 0)>(vb), h3 = tr_read<v_rd_off(D0, 3, 1)>(vb);
  asm volatile("s_waitcnt lgkmcnt(0)" ::: "memory"); SBAR();
#define PK(L, H) (bf16x8){L[0], L[1], L[2], L[3], H[0], H[1], H[2], H[3]}
  od = __builtin_amdgcn_mfma_f32_32x32x16_bf16(pa0, PK(l0, h0), od, 0, 0, 0);
  od = __builtin_amdgcn_mfma_f32_32x32x16_bf16(pa1, PK(l1, h1), od, 0, 0, 0);
  od = __builtin_amdgcn_mfma_f32_32x32x16_bf16(pa2, PK(l2, h2), od, 0, 0, 0);
  od = __builtin_amdgcn_mfma_f32_32x32x16_bf16(pa3, PK(l3, h3), od, 0, 0, 0);
#undef PK
}
__device__ __forceinline__ void pv_d0(f32x16* o, int vb, bf16x8 pa0, bf16x8 pa1, bf16x8 pa2, bf16x8 pa3) {
  pv_one<0>(o[0], vb, pa0, pa1, pa2, pa3); pv_one<1>(o[1], vb, pa0, pa1, pa2, pa3); pv_one<2>(o[2], vb, pa0, pa1, pa2, pa3); pv_one<3>(o[3], vb, pa0, pa1, pa2, pa3);
}

template <typename TQ>
__device__ __forceinline__ void attn_dense_body(const TQ* __restrict__ Qb, const bf16* __restrict__ Kh, const bf16* __restrict__ Vh,
                                                unsigned short* Ob, int seq, char* lds, int t_base, const float* __restrict__ qn) {
  using St = Stage<bf16>; using SQ = Stage<TQ>;
  const int tid = tid_opaque(), wid = tid >> 6, lane = tid & 63, r32 = lane & 31, hi = lane >> 5;
  bf16* V_lds = (bf16*)lds; bf16* K_lds = (bf16*)(lds + 2 * SHM_V);
  float* ws = (float*)(lds + 2 * SHM_V + 2 * SHM_K) + wid * 64; float* li_l = ws; float* al_l = ws + 32;
  float m_reg = -1e30f, l_reg = 0; f32x16 o[4] = {}; bf16x8 qr[8];
  const TQ* Qw = Qb + (long)(wid * QBLK + r32) * LDQ + hi * 8;
#pragma unroll
  for (int d0 = 0; d0 < 8; ++d0) qr[d0] = SQ::tobf(SQ::ld8(Qw + d0 * 16));
  {
    const int tq = t_base + wid * QBLK + r32;
    float v[8][8]; float ss = 0.f;
#pragma unroll
    for (int d0 = 0; d0 < 8; ++d0)
#pragma unroll
      for (int j = 0; j < 8; ++j) { v[d0][j] = __uint_as_float(((unsigned)(unsigned short)qr[d0][j]) << 16); ss += v[d0][j] * v[d0][j]; }
    ss += __shfl_xor(ss, 32);
    const float rs = rsqrtf(ss * (1.f / 128.f) + 1e-6f);
#pragma unroll
    for (int d0 = 0; d0 < 8; ++d0) { const float4 g0 = *reinterpret_cast<const float4*>(qn + d0 * 16 + hi * 8), g1 = *reinterpret_cast<const float4*>(qn + d0 * 16 + hi * 8 + 4);
      v[d0][0] *= rs * g0.x; v[d0][1] *= rs * g0.y; v[d0][2] *= rs * g0.z; v[d0][3] *= rs * g0.w; v[d0][4] *= rs * g1.x; v[d0][5] *= rs * g1.y; v[d0][6] *= rs * g1.z; v[d0][7] *= rs * g1.w; }
#pragma unroll
    for (int ax = 0; ax < 2; ++ax) { const float pos = ax ? (float)(tq & 63) : (float)(tq >> 6);
#pragma unroll
      for (int e = 0; e < 2; ++e)
#pragma unroll
        for (int j = 0; j < 8; ++j) { const int f = e * 16 + hi * 8 + j; const float ang = pos * exp2f(-(float)f * (13.287712379549449f / 32.f)); const float c = __cosf(ang), s = __sinf(ang);
          const float x1 = v[ax * 4 + e][j], x2 = v[ax * 4 + 2 + e][j]; v[ax * 4 + e][j] = x1 * c - x2 * s; v[ax * 4 + 2 + e][j] = x2 * c + x1 * s; } }
#pragma unroll
    for (int d0 = 0; d0 < 8; ++d0) { u32x4 w = {cvtpk(v[d0][0], v[d0][1]), cvtpk(v[d0][2], v[d0][3]), cvtpk(v[d0][4], v[d0][5]), cvtpk(v[d0][6], v[d0][7])}; qr[d0] = *reinterpret_cast<bf16x8*>(&w); }
  }
  const int sr = tid >> 4, sc = (tid & 15) * 8, vst0 = v_st(sr, sc), vst1 = v_st(32 + sr, sc);
  const int vb0 = (int)(uintptr_t)V_lds + v_rd_base(lane);
  struct { typename St::T vs0, vs1, ks0, ks1; } sr_[SDEPTH];
#define SLOAD(i, k0) do { sr_[i].vs0 = St::ld8(&Vh[(long)((k0) + sr) * LDK + sc]); sr_[i].vs1 = St::ld8(&Vh[(long)((k0) + 32 + sr) * LDK + sc]); \
    sr_[i].ks0 = St::ld8(&Kh[(long)((k0) + sr) * LDK + sc]); sr_[i].ks1 = St::ld8(&Kh[(long)((k0) + 32 + sr) * LDK + sc]); } while (0)
#define SWRITE(b, i) do { *(bf16x8*)((char*)V_lds + (b) * SHM_V + vst0) = St::tobf(sr_[i].vs0);          \
    *(bf16x8*)((char*)V_lds + (b) * SHM_V + vst1) = St::tobf(sr_[i].vs1); int kc = sc * 2;               \
    *(bf16x8*)((char*)K_lds + (b) * SHM_K + KSWZ(sr, kc)) = St::tobf(sr_[i].ks0);                       \
    *(bf16x8*)((char*)K_lds + (b) * SHM_K + KSWZ(32 + sr, kc)) = St::tobf(sr_[i].ks1); } while (0)
#define SWAIT() do { if constexpr (SDEPTH == 2) asm volatile("s_waitcnt vmcnt(4)" ::: "memory"); else asm volatile("s_waitcnt vmcnt(0)" ::: "memory"); } while (0)
#define RESC(a) do { if (__any((a) < 1.f)) { if (hi == 0) al_l[r32] = (a); asm volatile("s_waitcnt lgkmcnt(0)" ::: "memory"); \
    for (int d = 0; d < 4; ++d) for (int r = 0; r < 16; ++r) o[d][r] *= al_l[crow(r, hi)]; } } while (0)
  f32x16 pA0, pA1, pB0, pB1; float mnA, mnB, alA, alB; bf16x8 pa0, pa1, pa2, pa3; const int NT = seq / KVBLK;
  constexpr int SE = 0, SO = SDEPTH - 1;
  SLOAD(SE, 0); asm volatile("s_waitcnt vmcnt(0)" ::: "memory"); SWRITE(0, SE); __syncthreads();
  qkt(pA0, pA1, K_lds, qr, r32, hi); partialSM(pA0, pA1, m_reg, mnA, alA);
  SLOAD(SO, KVBLK); if constexpr (SDEPTH == 2) { if (2 < NT) SLOAD(SE, 2 * KVBLK); }
  SWAIT(); SWRITE(1, SO); __syncthreads();
  for (int j = 1; j + 1 < NT; j += 2) {
    SBAR(); qkt(pB0, pB1, (bf16*)((char*)K_lds + SHM_K), qr, r32, hi);
    finishSM(pA0, pA1, alA, l_reg, pa0, pa1, pa2, pa3); SBAR();
    SLOAD(SO, (j + SDEPTH) * KVBLK); SBAR();
    pv_d0(o, vb0, pa0, pa1, pa2, pa3); partialSM(pB0, pB1, m_reg, mnB, alB);
    __syncthreads(); SWAIT(); SWRITE(0, SE);
    RESC(alB); __syncthreads();
    SBAR(); qkt(pA0, pA1, K_lds, qr, r32, hi);
    finishSM(pB0, pB1, alB, l_reg, pa0, pa1, pa2, pa3); SBAR();
    if (SDEPTH == 1 || j + 3 < NT) SLOAD(SE, (j + 1 + SDEPTH) * KVBLK); SBAR();
    pv_d0(o, vb0 + (int)SHM_V, pa0, pa1, pa2, pa3); partialSM(pA0, pA1, m_reg, mnA, alA);
    __syncthreads(); SWAIT(); SWRITE(1, SO);
    RESC(alA); __syncthreads();
  }
  SBAR(); qkt(pB0, pB1, (bf16*)((char*)K_lds + SHM_K), qr, r32, hi);
  finishSM(pA0, pA1, alA, l_reg, pa0, pa1, pa2, pa3); SBAR();
  pv_d0(o, vb0, pa0, pa1, pa2, pa3); partialSM(pB0, pB1, m_reg, mnB, alB);
  __syncthreads(); RESC(alB);
  finishSM(pB0, pB1, alB, l_reg, pa0, pa1, pa2, pa3); SBAR();
  pv_d0(o, vb0 + (int)SHM_V, pa0, pa1, pa2, pa3);
  if (hi == 0) li_l[r32] = l_reg; asm volatile("s_waitcnt lgkmcnt(0)" ::: "memory");
  float rli[16];
#pragma unroll
  for (int r = 0; r < 16; ++r) rli[r] = __builtin_amdgcn_rcpf(li_l[crow(r, hi)]);
  unsigned short* Ow = Ob + (long)(wid * QBLK) * LDO;
#pragma unroll
  for (int r = 0; r < 16; ++r) { int orow = crow(r, hi);
    for (int d0 = 0; d0 < 4; ++d0) Ow[(long)orow * LDO + d0 * 32 + r32] = f2bf_rne(o[d0][r] * rli[r]); }
#undef SLOAD
#undef SWRITE
#undef SWAIT
#undef RESC
}

}

typedef unsigned short u16;
typedef float f32x4 __attribute__((ext_vector_type(4)));
typedef unsigned u32x4 __attribute__((ext_vector_type(4)));
typedef unsigned u32x2 __attribute__((ext_vector_type(2)));
typedef short s16x8 __attribute__((ext_vector_type(8)));

constexpr int MLAT = 32768, MCTX = 2048, MALL = 34816, FH = 2816, INW = 7712, NMODC = 9216;
constexpr int LDS_BYTES = 147456;
constexpr size_t MiB = 1048576;
constexpr size_t O_WGU1 = 0;
constexpr size_t O_WD1  = O_WGU1 + (size_t)5632 * 1024 * 2;
constexpr size_t O_WGU2 = O_WD1 + (size_t)1024 * 2816 * 2;
constexpr size_t O_WD2  = O_WGU2 + (size_t)5632 * 1024 * 2;
constexpr size_t O_WIN1 = O_WD2 + (size_t)1024 * 2816 * 2;
constexpr size_t O_WIN2 = O_WIN1 + (size_t)3328 * 1024 * 2;
constexpr size_t O_WDN  = O_WIN2 + (size_t)4608 * 1024 * 2;
constexpr size_t O_WAT  = O_WDN + (size_t)1024 * 1024 * 2;
constexpr size_t O_WOUT = O_WAT + (size_t)1024 * 1024 * 2;
constexpr size_t O_MOD  = O_WOUT + (size_t)1024 * 1024 * 2;
static_assert(O_MOD + 9 * 9216 * 4 + 64 <= 55 * MiB + 512 * 1024, "persistent region");
constexpr size_t O_Y1 = 56 * MiB;
constexpr size_t O_A = 124 * MiB;
constexpr size_t O_ACT = 192 * MiB;
constexpr size_t O_QRAW = 192 * MiB, O_KRAW = 260 * MiB, O_REC = 192 * MiB, O_QD = 340 * MiB, O_KD = 408 * MiB, O_BA = 476 * MiB;
constexpr int VD_SPLIT = 20224;
constexpr size_t O_VD1 = 0, O_VD2 = 480 * MiB + 512 * 1024;
static_assert((size_t)VD_SPLIT * 2048 <= O_WIN2 && O_VD2 + (size_t)(MALL - VD_SPLIT) * 2048 <= 512 * MiB && O_VD2 >= O_BA + (size_t)MALL * 32 * 4, "v_d split regions");

constexpr size_t O_QA = 192 * MiB, O_KVA = 256 * MiB, O_GATES = 290 * MiB, O_Z = 418 * MiB;
constexpr size_t O_KALL = 124 * MiB, O_VALL = 141 * MiB;
constexpr size_t O_A3 = O_A, O_T = O_Z, O_Y = O_A, O_A5 = O_QA, O_ACT2 = 256 * MiB, O_Y2 = O_A;
constexpr size_t O_BAR = 55 * MiB + 512 * 1024;
constexpr size_t O_X2B = 440 * MiB;
constexpr size_t WS_NEED = 512 * MiB;
constexpr int REC_BYTES = 17408;

struct Args { const float* in[26]; float* out; unsigned char* ws; };
__device__ __forceinline__ u16* vd_row(unsigned char* ws, int row) { return row < VD_SPLIT ? (u16*)(ws + O_VD1) + (size_t)row * 1024 : (u16*)(ws + O_VD2) + (size_t)(row - VD_SPLIT) * 1024; }

__device__ __forceinline__ float bf_lo(unsigned w) { return __uint_as_float(w << 16); }
__device__ __forceinline__ float bf_hi(unsigned w) { return __uint_as_float(w & 0xffff0000u); }
__device__ __forceinline__ float bf2f(u16 v) { return __uint_as_float(((unsigned)v) << 16); }
__device__ __forceinline__ u16 f2bf(float f) { unsigned u = __float_as_uint(f); u += 0x7FFFu + ((u >> 16) & 1u); return (u16)(u >> 16); }
typedef __bf16 bf16x2_t __attribute__((ext_vector_type(2)));
__device__ __forceinline__ unsigned pk(float lo, float hi) { bf16x2_t v; v[0] = (__bf16)lo; v[1] = (__bf16)hi; return __builtin_bit_cast(unsigned, v); }
__device__ __forceinline__ float silu_f(float v) { return v * __builtin_amdgcn_rcpf(1.f + __expf(-v)); }
__device__ __forceinline__ float sigm_f(float v) { return __builtin_amdgcn_rcpf(1.f + __expf(-v)); }
__device__ __forceinline__ float wave_sum(float v) {
#pragma unroll
    for (int o = 32; o > 0; o >>= 1) v += __shfl_xor(v, o);
    return v; }
__device__ __forceinline__ float grp16_sum(float v) {
#pragma unroll
    for (int o = 8; o > 0; o >>= 1) v += __shfl_xor(v, o);
    return v; }
__device__ __forceinline__ float grp32_sum(float v) {
#pragma unroll
    for (int o = 16; o > 0; o >>= 1) v += __shfl_xor(v, o);
    return v; }
__device__ __forceinline__ f32x4 mfma16(s16x8 a, s16x8 b, f32x4 c) { return __builtin_amdgcn_mfma_f32_16x16x32_bf16(a, b, c, 0, 0, 0); }
__device__ __forceinline__ u32x4 pk8(f32x4 a, f32x4 b) { return (u32x4){pk(a[0], a[1]), pk(a[2], a[3]), pk(b[0], b[1]), pk(b[2], b[3])}; }
__device__ __forceinline__ void unpk8(u32x4 w, f32x4& a, f32x4& b) { a = (f32x4){bf_lo(w.x), bf_hi(w.x), bf_lo(w.y), bf_hi(w.y)}; b = (f32x4){bf_lo(w.z), bf_hi(w.z), bf_lo(w.w), bf_hi(w.w)}; }

__device__ __forceinline__ int map_gu(int n) { const int p = n >> 8, r = n & 255; return r < 128 ? p * 128 + r : 2816 + p * 128 + (r - 128); }
__device__ __forceinline__ int map_in1(int n) { return n < 3072 ? n : (n < 3104 ? 4096 + (n - 3072) : -1); }
__device__ __forceinline__ int map_in2(int n) { return n < 1024 ? 3072 + n : (n < 2048 ? 4128 + (n - 1024) : (n < 2560 ? 5152 + (n - 2048) : 5664 + (n - 2560))); }

template <int MAP> __device__ __forceinline__ void cvt_w(const float* __restrict__ src, int K, int Nsrc, u16* __restrict__ dst, int Np, long gtid, long gthreads) {
    const long total = (long)Np * (K >> 5);
    for (long idx = gtid; idx < total; idx += gthreads) {
        const int np = (int)(idx % Np), kg = (int)(idx / Np);
        const int sc = MAP == 0 ? np : (MAP == 1 ? map_gu(np) : (MAP == 2 ? map_in1(np) : map_in2(np)));
        u32x4 w0 = {0u, 0u, 0u, 0u}, w1 = w0, w2 = w0, w3 = w0;
        if (sc >= 0) {
            const float* p = src + (size_t)(kg * 32) * Nsrc + sc;
            float f[32];
#pragma unroll
            for (int j = 0; j < 32; ++j) f[j] = p[(size_t)j * Nsrc];
            w0 = (u32x4){pk(f[0], f[1]), pk(f[2], f[3]), pk(f[4], f[5]), pk(f[6], f[7])};
            w1 = (u32x4){pk(f[8], f[9]), pk(f[10], f[11]), pk(f[12], f[13]), pk(f[14], f[15])};
            w2 = (u32x4){pk(f[16], f[17]), pk(f[18], f[19]), pk(f[20], f[21]), pk(f[22], f[23])};
            w3 = (u32x4){pk(f[24], f[25]), pk(f[26], f[27]), pk(f[28], f[29]), pk(f[30], f[31])};
        }
        u32x4* d = (u32x4*)(dst + (size_t)np * K + kg * 32);
        d[0] = w0; d[1] = w1; d[2] = w2; d[3] = w3;
    }
}

__device__ __forceinline__ void phase_mod(const Args& a, unsigned char* shm) {
    float* sc = (float*)shm;
    float* red = sc + 9216;
    const float* c = a.in[1]; const float* cc = a.in[3]; const float* wmod = a.in[4]; const float* bmod = a.in[5];
    float* mod = (float*)(a.ws + O_MOD);
    const int tid = tid_opaque();
    for (int i = tid; i < 9216; i += 512) { const int r = i >> 10, k = i & 1023; const float v = r < 8 ? c[r * 1024 + k] : cc[k]; sc[i] = silu_f(v); }
    __syncthreads();
    const int cl = tid & 31, kg = tid >> 5;
    for (int task = blockIdx.x; task < 288; task += gridDim.x) {
        const int col = task * 32 + cl;
        float acc[9];
#pragma unroll
        for (int r = 0; r < 9; ++r) acc[r] = 0.f;
#pragma unroll 8
        for (int kk = 0; kk < 64; ++kk) { const int k = kg * 64 + kk; const float w = wmod[(size_t)k * NMODC + col];
#pragma unroll
            for (int r = 0; r < 9; ++r) acc[r] += sc[r * 1024 + k] * w; }
#pragma unroll
        for (int r = 0; r < 9; ++r) red[(kg * 9 + r) * 32 + cl] = acc[r];
        __syncthreads();
        if (tid < 288) { const int r = tid >> 5; float s = bmod[task * 32 + cl];
            for (int g = 0; g < 16; ++g) s += red[(g * 9 + r) * 32 + cl];
            mod[r * NMODC + task * 32 + cl] = s; }
        __syncthreads();
    }
}

struct Row { f32x4 v[4]; };
__device__ __forceinline__ void ld_row_f32(Row& r, const float* p, int lane) {
#pragma unroll
    for (int i = 0; i < 4; ++i) r.v[i] = *(const f32x4*)(p + 256 * i + 4 * lane); }
__device__ __forceinline__ void st_row_f32(const Row& r, float* p, int lane) {
#pragma unroll
    for (int i = 0; i < 4; ++i) *(f32x4*)(p + 256 * i + 4 * lane) = r.v[i]; }
__device__ __forceinline__ void ld_row_bf(Row& r, const u16* p, int lane) {
#pragma unroll
    for (int i = 0; i < 4; ++i) { const u32x2 u = *(const u32x2*)(p + 256 * i + 4 * lane); r.v[i] = (f32x4){bf_lo(u.x), bf_hi(u.x), bf_lo(u.y), bf_hi(u.y)}; } }
__device__ __forceinline__ void st_row_bf(const Row& r, u16* p, int lane) {
#pragma unroll
    for (int i = 0; i < 4; ++i) { u32x2 u; u.x = pk(r.v[i][0], r.v[i][1]); u.y = pk(r.v[i][2], r.v[i][3]); *(u32x2*)(p + 256 * i + 4 * lane) = u; } }
__device__ __forceinline__ void row_norm(Row& y, const Row& x, const float* g, int lane) {
    float s = 0.f;
#pragma unroll
    for (int i = 0; i < 4; ++i) s += x.v[i][0] * x.v[i][0] + x.v[i][1] * x.v[i][1] + x.v[i][2] * x.v[i][2] + x.v[i][3] * x.v[i][3];
    s = wave_sum(s);
    const float rs = rsqrtf(s * (1.f / 1024.f) + 1e-6f);
#pragma unroll
    for (int i = 0; i < 4; ++i) { const f32x4 gv = *(const f32x4*)(g + 256 * i + 4 * lane); y.v[i] = x.v[i] * rs * gv; } }
__device__ __forceinline__ void row_mod(Row& h, const float* shift, const float* scale, int lane) {
#pragma unroll
    for (int i = 0; i < 4; ++i) { const f32x4 sh = *(const f32x4*)(shift + 256 * i + 4 * lane), sc = *(const f32x4*)(scale + 256 * i + 4 * lane); h.v[i] = h.v[i] * (sc + 1.f) + sh; } }
__device__ __forceinline__ void row_res(Row& x, const Row& t, const float* gate, float w, int lane) {
#pragma unroll
    for (int i = 0; i < 4; ++i) { const f32x4 gv = *(const f32x4*)(gate + 256 * i + 4 * lane); x.v[i] = x.v[i] + gv * t.v[i] * w; } }

__device__ __forceinline__ Row ld_vec(const float* p, int lane) { Row r; ld_row_f32(r, p, lane); return r; }
__device__ __forceinline__ float row_rs(const Row& x) {
    float s = 0.f;
#pragma unroll
    for (int i = 0; i < 4; ++i) s += x.v[i][0] * x.v[i][0] + x.v[i][1] * x.v[i][1] + x.v[i][2] * x.v[i][2] + x.v[i][3] * x.v[i][3];
    s = wave_sum(s);
    return rsqrtf(s * (1.f / 1024.f) + 1e-6f); }
__device__ __forceinline__ void row_norm_r(Row& y, const Row& x, const Row& g) { const float rs = row_rs(x);
#pragma unroll
    for (int i = 0; i < 4; ++i) y.v[i] = x.v[i] * rs * g.v[i]; }
__device__ __forceinline__ void row_mod_r(Row& h, const Row& sh, const Row& sc) {
#pragma unroll
    for (int i = 0; i < 4; ++i) h.v[i] = h.v[i] * (sc.v[i] + 1.f) + sh.v[i]; }
__device__ __forceinline__ void row_res_r(Row& x, const Row& t, const Row& gate, float w) {
#pragma unroll
    for (int i = 0; i < 4; ++i) x.v[i] = x.v[i] + gate.v[i] * t.v[i] * w; }

__device__ __forceinline__ void phase_h1(const Args& a) {
    const int lane = tid_opaque() & 63, gw = blockIdx.x * 8 + (tid_opaque() >> 6), nw = gridDim.x * 8;
    const float* mod = (const float*)(a.ws + O_MOD); u16* A = (u16*)(a.ws + O_A);
    const Row pre = ld_vec(a.in[6], lane);
    { const int b = gw & 7; const float* md = mod + b * NMODC; const Row sh = ld_vec(md, lane), sc = ld_vec(md + 1024, lane);
      for (int j = gw >> 3; j < 4096; j += nw >> 3) { const int row = b * 4096 + j;
        Row xr, h; ld_row_f32(xr, a.in[0] + (size_t)row * 1024, lane); row_norm_r(h, xr, pre); row_mod_r(h, sh, sc); st_row_bf(h, A + (size_t)row * 1024, lane); } }
    { const float* md = mod + 8 * NMODC; const Row sh = ld_vec(md, lane), sc = ld_vec(md + 1024, lane);
      for (int row = MLAT + gw; row < MALL; row += nw) {
        Row xr, h; ld_row_f32(xr, a.in[2] + (size_t)(row - MLAT) * 1024, lane); row_norm_r(h, xr, pre); row_mod_r(h, sh, sc); st_row_bf(h, A + (size_t)row * 1024, lane); } }
}
__device__ __forceinline__ void phase_h2(const Args& a, int row_lo = 0, int row_hi = MALL, int bfirst = 0, int nblk = -1) {
    if (nblk < 0) nblk = gridDim.x;
    if ((int)blockIdx.x < bfirst || (int)blockIdx.x >= bfirst + nblk) return;
    const int lane = tid_opaque() & 63, gw = ((int)blockIdx.x - bfirst) * 8 + (tid_opaque() >> 6), nw = nblk * 8;
    const float* mod = (const float*)(a.ws + O_MOD); u16* A = (u16*)(a.ws + O_A); const u16* Y1 = (const u16*)(a.ws + O_Y1);
    const Row post1 = ld_vec(a.in[7], lane), mixpre = ld_vec(a.in[10], lane);
    if (row_lo < MLAT) { const int b = gw & 7; const float* md = mod + b * NMODC;
      const Row g2 = ld_vec(md + 2 * 1024, lane), sh = ld_vec(md + 3 * 1024, lane), sc = ld_vec(md + 4 * 1024, lane);
      for (int j = gw >> 3; j < 4096; j += nw >> 3) { const int row = b * 4096 + j;
        Row x1, yr, t, h; ld_row_f32(x1, a.in[0] + (size_t)row * 1024, lane); ld_row_bf(yr, Y1 + (size_t)row * 1024, lane);
        row_norm_r(t, yr, post1); row_res_r(x1, t, g2, 0.5f); row_norm_r(h, x1, mixpre); row_mod_r(h, sh, sc); st_row_bf(h, A + (size_t)row * 1024, lane); } }
    if (row_hi > MLAT) { const float* md = mod + 8 * NMODC;
      const Row g2 = ld_vec(md + 2 * 1024, lane), sh = ld_vec(md + 3 * 1024, lane), sc = ld_vec(md + 4 * 1024, lane);
      for (int row = MLAT + gw; row < MALL; row += nw) {
        Row x1, yr, t, h; ld_row_f32(x1, a.in[2] + (size_t)(row - MLAT) * 1024, lane); ld_row_bf(yr, Y1 + (size_t)row * 1024, lane);
        row_norm_r(t, yr, post1); row_res_r(x1, t, g2, 0.5f); row_norm_r(h, x1, mixpre); row_mod_r(h, sh, sc); st_row_bf(h, A + (size_t)row * 1024, lane); } }
}
__device__ __forceinline__ void phase_h3(const Args& a) {
    const int lane = tid_opaque() & 63, gw = blockIdx.x * 8 + (tid_opaque() >> 6), nw = gridDim.x * 8;
    const float* mod = (const float*)(a.ws + O_MOD); u16* A5 = (u16*)(a.ws + O_A5); const u16* Y = (const u16*)(a.ws + O_Y); const u16* Y1 = (const u16*)(a.ws + O_Y1);
    const int b = gw & 7; const float* md = mod + b * NMODC;
    const Row post1 = ld_vec(a.in[7], lane), mixpost = ld_vec(a.in[11], lane), pre2 = ld_vec(a.in[22], lane);
    const Row g2 = ld_vec(md + 2 * 1024, lane), g5 = ld_vec(md + 5 * 1024, lane), sh = ld_vec(md + 6 * 1024, lane), sc = ld_vec(md + 7 * 1024, lane);
    for (int j = gw >> 3; j < 4096; j += nw >> 3) { const int row = b * 4096 + j;
        Row x2, yr, t, h; ld_row_f32(x2, a.in[0] + (size_t)row * 1024, lane); ld_row_bf(yr, Y1 + (size_t)row * 1024, lane);
        row_norm_r(t, yr, post1); row_res_r(x2, t, g2, 0.5f);
        ld_row_bf(yr, Y + (size_t)row * 1024, lane); row_norm_r(t, yr, mixpost); row_res_r(x2, t, g5, 1.0f);
        st_row_bf(x2, (u16*)(a.ws + O_X2B) + (size_t)row * 1024, lane);
        row_norm_r(h, x2, pre2); row_mod_r(h, sh, sc); st_row_bf(h, A5 + (size_t)row * 1024, lane);
    }
}
__device__ __forceinline__ void phase_out(const Args& a) {
    const int lane = tid_opaque() & 63, gw = blockIdx.x * 8 + (tid_opaque() >> 6), nw = gridDim.x * 8;
    const float* mod = (const float*)(a.ws + O_MOD); const u16* Y2 = (const u16*)(a.ws + O_Y2);
    const int b = gw & 7; const Row post2 = ld_vec(a.in[23], lane), g8 = ld_vec(mod + b * NMODC + 8 * 1024, lane);
    for (int j = gw >> 3; j < 4096; j += nw >> 3) { const int row = b * 4096 + j;
        Row x2, yr, t; ld_row_bf(x2, (const u16*)(a.ws + O_X2B) + (size_t)row * 1024, lane); ld_row_bf(yr, Y2 + (size_t)row * 1024, lane); row_norm_r(t, yr, post2); row_res_r(x2, t, g8, 0.5f);
        st_row_f32(x2, a.out + (size_t)row * 1024, lane);
    }
}

struct EpiPlain { static constexpr bool PERM = true, AFTER_DRAIN = false; u16* O; int ldc;
    __device__ __forceinline__ void operator()(const pg8::f32x4 (&acc)[2][2][4][2], const pg8::Unit& u, int wr, int wc, int fr, int fq) const {
        const int row0 = u.pm * 256 + wr * 64 + fr, col0 = u.pn * 256 + wc * 32 + 8 * fq;
#pragma unroll
        for (int ai = 0; ai < 2; ++ai)
#pragma unroll
            for (int m = 0; m < 4; ++m) { u16* rp = O + (size_t)(row0 + ai * 128 + m * 16) * ldc + col0;
#pragma unroll
                for (int bj = 0; bj < 2; ++bj) *(u32x4*)(rp + bj * 128) = pk8(acc[ai][bj][m][0], acc[ai][bj][m][1]); } } };

struct EpiSwiglu { static constexpr bool PERM = true, AFTER_DRAIN = false; u16* O;
    __device__ __forceinline__ void operator()(const pg8::f32x4 (&acc)[2][2][4][2], const pg8::Unit& u, int wr, int wc, int fr, int fq) const {
        const int row0 = u.pm * 256 + wr * 64 + fr, col0 = u.pn * 128 + wc * 32 + 8 * fq;
#pragma unroll
        for (int ai = 0; ai < 2; ++ai)
#pragma unroll
            for (int m = 0; m < 4; ++m) { u16* rp = O + (size_t)(row0 + ai * 128 + m * 16) * FH + col0;
                f32x4 o0, o1;
#pragma unroll
                for (int j = 0; j < 4; ++j) { o0[j] = silu_f(acc[ai][0][m][0][j]) * acc[ai][1][m][0][j]; o1[j] = silu_f(acc[ai][0][m][1][j]) * acc[ai][1][m][1][j]; }
                *(u32x4*)rp = pk8(o0, o1); } } };

struct EpiIn1 { static constexpr bool PERM = true, AFTER_DRAIN = false; u16* q; u16* k; u16* v; float* ba;
    __device__ __forceinline__ void operator()(const pg8::f32x4 (&acc)[2][2][4][2], const pg8::Unit& u, int wr, int wc, int fr, int fq) const {
        const int row0 = u.pm * 256 + wr * 64 + fr;
        if (u.pn < 12) {
            const int t3 = u.pn >> 2;
            u16* base = q + (long)(t3 == 1) * (long)(k - q) + (long)(t3 == 2) * (long)(v - q); const int col0 = (u.pn & 3) * 256 + wc * 32 + 8 * fq;
#pragma unroll
            for (int ai = 0; ai < 2; ++ai)
#pragma unroll
                for (int m = 0; m < 4; ++m) { u16* rp = base + (size_t)(row0 + ai * 128 + m * 16) * 1024 + col0;
#pragma unroll
                    for (int bj = 0; bj < 2; ++bj) *(u32x4*)(rp + bj * 128) = pk8(acc[ai][bj][m][0], acc[ai][bj][m][1]); }
        } else if (wc == 0) {
#pragma unroll
            for (int ai = 0; ai < 2; ++ai)
#pragma unroll
                for (int m = 0; m < 4; ++m) { float* rp = ba + (size_t)(row0 + ai * 128 + m * 16) * 32 + 8 * fq;
                    *(f32x4*)rp = acc[ai][0][m][0]; *(f32x4*)(rp + 4) = acc[ai][0][m][1]; }
        } } };
struct EpiIn2 { static constexpr bool PERM = true, AFTER_DRAIN = false; u16* z; u16* qa; u16* kva; u16* gates;
    __device__ __forceinline__ void operator()(const pg8::f32x4 (&acc)[2][2][4][2], const pg8::Unit& u, int wr, int wc, int fr, int fq) const {
        const int row0 = u.pm * 256 + wr * 64 + fr; const bool lat = u.pm < 128;
        u16* base; int ldc, col0; bool sig = false;
        if (u.pn < 4) { if (!lat) return; base = z; ldc = 1024; col0 = u.pn * 256; }
        else if (u.pn < 8) { if (!lat) return; base = qa; ldc = 1024; col0 = (u.pn - 4) * 256; }
        else if (u.pn < 10) { base = kva; ldc = 512; col0 = (u.pn - 8) * 256; }
        else { if (!lat) return; base = gates; ldc = 2048; col0 = (u.pn - 10) * 256; sig = true; }
        col0 += wc * 32 + 8 * fq;
#pragma unroll
        for (int ai = 0; ai < 2; ++ai)
#pragma unroll
            for (int m = 0; m < 4; ++m) { u16* rp = base + (size_t)(row0 + ai * 128 + m * 16) * ldc + col0;
#pragma unroll
                for (int bj = 0; bj < 2; ++bj) { f32x4 v0 = acc[ai][bj][m][0], v1 = acc[ai][bj][m][1];
                    if (sig) {
#pragma unroll
                        for (int j = 0; j < 4; ++j) { v0[j] = sigm_f(v0[j]); v1[j] = sigm_f(v1[j]); } }
                    *(u32x4*)(rp + bj * 128) = pk8(v0, v1); } } } };

template <int SECOND> struct EpiMerge { static constexpr bool PERM = true, AFTER_DRAIN = false; const u16* gates; u16* T;
    __device__ __forceinline__ void operator()(const pg8::f32x4 (&acc)[2][2][4][2], const pg8::Unit& u, int wr, int wc, int fr, int fq) const {
        const int row0 = u.pm * 256 + wr * 64 + fr, col0 = u.pn * 256 + wc * 32 + 8 * fq;
#pragma unroll
        for (int ai = 0; ai < 2; ++ai)
#pragma unroll
            for (int m = 0; m < 4; ++m) { const size_t row = (size_t)(row0 + ai * 128 + m * 16);
#pragma unroll
                for (int bj = 0; bj < 2; ++bj) { const int col = col0 + bj * 128;
                    const u32x4 gw = *(const u32x4*)(gates + row * 2048 + SECOND * 1024 + col); f32x4 g0, g1; unpk8(gw, g0, g1);
                    f32x4 o0 = g0 * acc[ai][bj][m][0], o1 = g1 * acc[ai][bj][m][1];
#if defined(EXP_ZERO_DN)
                    if (!SECOND) { o0 *= 0.f; o1 *= 0.f; }
#endif
#if defined(EXP_ZERO_AT)
                    if (SECOND) { o0 *= 0.f; o1 *= 0.f; }
#endif
                    if (SECOND) { const u32x4 tw = *(const u32x4*)(T + row * 1024 + col); f32x4 t0, t1; unpk8(tw, t0, t1); o0 += t0; o1 += t1; }
                    *(u32x4*)(T + row * 1024 + col) = pk8(o0, o1); } } } };

template <class Epi> __device__ __forceinline__ void run_gemm(unsigned char* shm, const u16* A, const u16* Bt, int M, int N, int K, const Epi& E) {
    pg8::Gemm g; g.A = A; g.Bt = Bt; g.M = M; g.N = N; g.K = K;
    pg8::StaticOrder S; S.init(M, N, (int)gridDim.x, (int)blockIdx.x);
    pg8::gemm_phase<Epi, pg8::StaticOrder, false>((PG8_LAS unsigned char*)shm, g, S, E, nullptr);
}

__device__ __forceinline__ void phase_dn_prep(const Args& a) {
    const int lane = tid_opaque() & 63, gw = blockIdx.x * 8 + (tid_opaque() >> 6), nw = gridDim.x * 8;
    const u16* raw0 = (const u16*)(a.ws + O_QRAW); const u16* raw1 = (const u16*)(a.ws + O_KRAW); const u16* raw2 = (const u16*)a.out;
    u16* out0 = (u16*)(a.ws + O_QD); u16* out1 = (u16*)(a.ws + O_KD);
    const float* cw = a.in[13];
    for (int row = gw; row < MALL; row += nw) {
        const int pos = row < MLAT ? (row & 4095) : ((row - MLAT) & 255); const int L = row < MLAT ? 4096 : 256;
        const bool hp = pos > 0, hn = pos < L - 1;
#pragma unroll
        for (int i = 0; i < 6; ++i) {
            const int kind = i >> 1, cc = (i & 1) * 512 + 8 * lane, cg_ = kind * 1024 + cc;
            const u16* rp = (kind == 0 ? raw0 : (kind == 1 ? raw1 : raw2)) + (size_t)row * 1024 + cc;
            u16* op = (kind == 0 ? out0 + (size_t)row * 1024 : (kind == 1 ? out1 + (size_t)row * 1024 : vd_row(a.ws, row))) + cc;
            const u32x4 zc = {0u, 0u, 0u, 0u};
            const u32x4 cu = *(const u32x4*)rp; const u32x4 pu = hp ? *(const u32x4*)(rp - 1024) : zc; const u32x4 nu = hn ? *(const u32x4*)(rp + 1024) : zc;
            f32x4 c0, c1, p0, p1, n0, n1; unpk8(cu, c0, c1); unpk8(pu, p0, p1); unpk8(nu, n0, n1);
            const f32x4 wa0 = *(const f32x4*)(cw + cg_), wa1 = *(const f32x4*)(cw + cg_ + 4);
            const f32x4 wb0 = *(const f32x4*)(cw + 3072 + cg_), wb1 = *(const f32x4*)(cw + 3072 + cg_ + 4);
            const f32x4 wc0 = *(const f32x4*)(cw + 6144 + cg_), wc1 = *(const f32x4*)(cw + 6144 + cg_ + 4);
            f32x4 v0 = wa0 * p0 + wb0 * c0 + wc0 * n0, v1 = wa1 * p1 + wb1 * c1 + wc1 * n1;
            float ss = 0.f;
#pragma unroll
            for (int j = 0; j < 4; ++j) { v0[j] = silu_f(v0[j]); v1[j] = silu_f(v1[j]); ss += v0[j] * v0[j] + v1[j] * v1[j]; }
            if (kind < 2) { ss = grp16_sum(ss); const float sc = rsqrtf(ss + 1e-6f) * (kind == 0 ? 0.08838834764831845f : 1.f); v0 *= sc; v1 *= sc; }
            *(u32x4*)op = pk8(v0, v1);
        }
    }
}

__device__ __forceinline__ void phase_dn_pre(const Args& a, unsigned char* shm) {
    const int tid = tid_opaque(), wid = tid >> 6, lane0 = tid & 63;
    float* Lm = (float*)(shm + wid * 17408); float* gcs = Lm + 4096; float* bts = gcs + 64;
    const u16* qd = (const u16*)(a.ws + O_QD); const u16* kd = (const u16*)(a.ws + O_KD); const float* BA = (const float*)(a.ws + O_BA);
    unsigned char* REC = a.ws + O_REC;
    for (int task = blockIdx.x * 8 + wid; task < 8704; task += gridDim.x * 8) {
        int lane = lane0; asm volatile("" : "+v"(lane));
        const int fr = lane & 15, quad = lane >> 4;
        const int c68 = task % 68; int tt = task / 68; const int dir = tt & 1; tt >>= 1; const int h = tt & 7; const int b = tt >> 3;
        const int base = c68 < 4 ? MLAT + b * 256 + c68 * 64 : b * 4096 + (c68 - 4) * 64;
        const int tok = dir ? 63 - lane : lane;
        const float* bap = BA + (size_t)(base + tok) * 32;
        const float beta = sigm_f(bap[dir * 8 + h]);
        const float xs = bap[16 + dir * 8 + h] + a.in[15][dir * 8 + h];
        const float sp = fmaxf(xs, 0.f) + log1pf(__expf(-fabsf(xs)));
        const float g = -__expf(a.in[14][dir * 8 + h]) * sp;
        float gc = g;
#pragma unroll
        for (int o = 1; o < 64; o <<= 1) { const float nb = __shfl_up(gc, o); if (lane >= o) gc += nb; }
        const float glast = __shfl(gc, 63);
        asm volatile("s_waitcnt lgkmcnt(0)" ::: "memory");
        gcs[lane] = gc; bts[lane] = beta;
        unsigned char* rec = REC + (size_t)task * REC_BYTES;
        float* rf = (float*)(rec + 16384);
        rf[lane] = __expf(gc); rf[64 + lane] = __expf(glast - gc); if (lane == 0) rf[128] = __expf(glast);
        asm volatile("s_waitcnt lgkmcnt(0)" ::: "memory");
        s16x8 kf[4][4];
#pragma unroll
        for (int mt = 0; mt < 4; ++mt) { const int r = 16 * mt + fr, tr = dir ? 63 - r : r; const u16* p = kd + (size_t)(base + tr) * 1024 + h * 128 + quad * 8;
#pragma unroll
            for (int kk = 0; kk < 4; ++kk) kf[mt][kk] = *(const s16x8*)(p + kk * 32); }
#pragma unroll
        for (int mt = 0; mt < 4; ++mt)
#pragma unroll
            for (int nt = 0; nt <= mt; ++nt) { f32x4 acc = {0.f, 0.f, 0.f, 0.f};
#pragma unroll
                for (int kk = 0; kk < 4; ++kk) acc = mfma16(kf[mt][kk], kf[nt][kk], acc);
                const int j = 16 * nt + fr; const float gj = gcs[j];
#pragma unroll
                for (int r = 0; r < 4; ++r) { const int i = 16 * mt + quad * 4 + r; Lm[i * 64 + j] = bts[i] * acc[r] * __expf(fminf(gcs[i] - gj, 0.f)); } }
        asm volatile("s_waitcnt lgkmcnt(0)" ::: "memory");
        const int hb = lane >> 5, cb = lane & 31;
        float tcol[32];
#pragma unroll
        for (int ii = 0; ii < 32; ++ii) {
            const float* Lrow = Lm + (32 * hb + ii) * 64 + 32 * hb;
            float s0 = (cb == ii) ? 1.f : 0.f, s1 = 0.f, s2 = 0.f, s3 = 0.f;
#pragma unroll
            for (int j4 = 0; j4 < (ii + 3) / 4; ++j4) { const f32x4 l = *(const f32x4*)(Lrow + j4 * 4);
                if (4 * j4 + 0 < ii) s0 -= l[0] * tcol[4 * j4 + 0];
                if (4 * j4 + 1 < ii) s1 -= l[1] * tcol[4 * j4 + 1];
                if (4 * j4 + 2 < ii) s2 -= l[2] * tcol[4 * j4 + 2];
                if (4 * j4 + 3 < ii) s3 -= l[3] * tcol[4 * j4 + 3]; }
            tcol[ii] = (s0 + s1) + (s2 + s3);
            __builtin_amdgcn_sched_barrier(0);
        }
        unsigned char* imgB = (unsigned char*)Lm;
        { const int m = lane >> 1, k0 = (lane & 1) * 16; const float* src = Lm + (32 + m) * 64 + k0;
          const f32x4 c0 = *(const f32x4*)(src), c1 = *(const f32x4*)(src + 4), c2 = *(const f32x4*)(src + 8), c3 = *(const f32x4*)(src + 12);
          *(u32x4*)(imgB + m * 64 + k0 * 2) = pk8(c0, c1); *(u32x4*)(imgB + m * 64 + k0 * 2 + 16) = pk8(c2, c3); }
        if (hb == 0) {
#pragma unroll
            for (int q = 0; q < 4; ++q) { u32x4 w; w.x = pk(tcol[8 * q], tcol[8 * q + 1]); w.y = pk(tcol[8 * q + 2], tcol[8 * q + 3]); w.z = pk(tcol[8 * q + 4], tcol[8 * q + 5]); w.w = pk(tcol[8 * q + 6], tcol[8 * q + 7]);
                *(u32x4*)(imgB + 2048 + cb * 64 + q * 16) = w; }
        } else {
#pragma unroll
            for (int m = 0; m < 32; ++m) *(u16*)(imgB + 4096 + m * 64 + cb * 2) = f2bf(tcol[m]);
        }
        asm volatile("s_waitcnt lgkmcnt(0)" ::: "memory");
        f32x4 Zb[2][2];
#pragma unroll
        for (int m2 = 0; m2 < 2; ++m2)
#pragma unroll
            for (int n2 = 0; n2 < 2; ++n2) { const f32x4 z0 = {0.f, 0.f, 0.f, 0.f};
                Zb[m2][n2] = mfma16(*(const s16x8*)(imgB + (16 * m2 + fr) * 64 + quad * 16), *(const s16x8*)(imgB + 2048 + (16 * n2 + fr) * 64 + quad * 16), z0); }
#pragma unroll
        for (int m2 = 0; m2 < 2; ++m2)
#pragma unroll
            for (int n2 = 0; n2 < 2; ++n2) { u32x2 w; w.x = pk(Zb[m2][n2][0], Zb[m2][n2][1]); w.y = pk(Zb[m2][n2][2], Zb[m2][n2][3]);
                *(u32x2*)(imgB + 6144 + (16 * n2 + fr) * 64 + (16 * m2 + 4 * quad) * 2) = w; }
        asm volatile("s_waitcnt lgkmcnt(0)" ::: "memory");
        f32x4 T21[2][2];
#pragma unroll
        for (int m2 = 0; m2 < 2; ++m2)
#pragma unroll
            for (int n2 = 0; n2 < 2; ++n2) { const f32x4 z0 = {0.f, 0.f, 0.f, 0.f};
                T21[m2][n2] = mfma16(*(const s16x8*)(imgB + 4096 + (16 * m2 + fr) * 64 + quad * 16), *(const s16x8*)(imgB + 6144 + (16 * n2 + fr) * 64 + quad * 16), z0); }
        u16* img = (u16*)Lm;
        asm volatile("s_waitcnt lgkmcnt(0)" ::: "memory");
#pragma unroll
        for (int ii = 0; ii < 32; ++ii) img[4096 + (32 * hb + ii) * 64 + lane] = f2bf(tcol[ii] * beta);
        if (hb == 1) {
#pragma unroll
            for (int ii = 0; ii < 32; ++ii) img[4096 + ii * 64 + lane] = 0; }
#pragma unroll
        for (int m2 = 0; m2 < 2; ++m2)
#pragma unroll
            for (int n2 = 0; n2 < 2; ++n2) { const int col = 16 * n2 + fr; const float bc = bts[col];
#pragma unroll
                for (int r = 0; r < 4; ++r) img[4096 + (32 + 16 * m2 + 4 * quad + r) * 64 + col] = f2bf(-T21[m2][n2][r] * bc); }
#pragma unroll
        for (int mt = 0; mt < 4; ++mt) { const int r_ = 16 * mt + fr, tr = dir ? 63 - r_ : r_; const u16* p = qd + (size_t)(base + tr) * 1024 + h * 128 + quad * 8;
            s16x8 qf[4];
#pragma unroll
            for (int kk = 0; kk < 4; ++kk) qf[kk] = *(const s16x8*)(p + kk * 32);
#pragma unroll
            for (int nt = 0; nt < 4; ++nt) { const int j = 16 * nt + fr;
                if (nt <= mt) { f32x4 acc = {0.f, 0.f, 0.f, 0.f};
#pragma unroll
                    for (int kk = 0; kk < 4; ++kk) acc = mfma16(qf[kk], kf[nt][kk], acc);
                    const float gj = gcs[j];
#pragma unroll
                    for (int r = 0; r < 4; ++r) { const int i = 16 * mt + quad * 4 + r; const float v = (j <= i) ? acc[r] * __expf(fminf(gcs[i] - gj, 0.f)) : 0.f; img[i * 64 + j] = f2bf(v); }
                } else {
#pragma unroll
                    for (int r = 0; r < 4; ++r) { const int i = 16 * mt + quad * 4 + r; img[i * 64 + j] = 0; } } } }
        asm volatile("s_waitcnt lgkmcnt(0)" ::: "memory");
        { const u32x4* src = (const u32x4*)Lm; u32x4* dst = (u32x4*)rec;
#pragma unroll
            for (int q = 0; q < 8; ++q) { dst[q * 64 + lane] = src[512 + q * 64 + lane]; dst[512 + q * 64 + lane] = src[q * 64 + lane]; } }
    }
}

__device__ __forceinline__ void phase_dn_scan(const Args& a, unsigned char* shm) {
    const int tid = tid_opaque(), wid = tid >> 6, lane = tid & 63, fr = lane & 15, quad = lane >> 4, r32 = lane & 31, hi = lane >> 5;
    unsigned char* ST = shm; unsigned char* KV = shm + 17408; unsigned char* RT = KV + 16384; unsigned char* VN = RT + 9216; unsigned char* VS = VN + 9216;
    unsigned char* KR = VS + 9216; unsigned char* QR = KR + 17408;
    const int mt = wid & 3, ng = wid >> 2, mtS = wid & 1, D0 = wid >> 1;
    const int sr = tid >> 4, sc = (tid & 15) * 8, vst0 = at::v_st(sr, sc), vst1 = at::v_st(32 + sr, sc);
    const int vb0 = (int)(uintptr_t)KV + at::v_rd_base(lane);
    const u16* qd = (const u16*)(a.ws + O_QD); const u16* kd = (const u16*)(a.ws + O_KD);
    const unsigned char* REC = a.ws + O_REC;
    for (int tsk = blockIdx.x; tsk < 256; tsk += gridDim.x) {
        const int task = gridDim.x == 256 ? ((((tsk >> 4) << 3) | (tsk & 7)) << 1) | ((tsk >> 3) & 1) : tsk;
        const int half = task & 1, dir = (task >> 1) & 1, h = (task >> 2) & 7, b = task >> 5;
        u16* Od = (u16*)a.out + (dir ? (size_t)MLAT * 1024 : (size_t)0);
        at::f32x16 sT;
#pragma unroll
        for (int r = 0; r < 16; ++r) sT[r] = 0.f;
        const int irow = 16 * mt + fr, i0 = 16 * mt + quad * 4;
        const int dv0 = 32 * ng + fr, dv1 = dv0 + 16;
        const int trow = dir ? 63 - irow : irow, t0 = dir ? 63 - sr : sr, t1 = dir ? 31 - sr : 32 + sr;
        const int hoff = h * 128;
#define SCAN_C68(n_) ((n_) < 4 ? (dir ? 3 - (n_) : (n_)) : (dir ? 71 - (n_) : (n_)))
#define SCAN_BASE(c_) ((c_) < 4 ? MLAT + b * 256 + (c_) * 64 : b * 4096 + ((c_) - 4) * 64)
#define SCAN_REC(c_) (REC + (size_t)((((b * 8 + h) * 2 + dir) * 68) + (c_)) * REC_BYTES)
        s16x8 K0, K1, Q0, Q1, TB[2], IN[2]; f32x4 EG, EK, V0, V1; float DCH;
        const unsigned oK0 = (unsigned)(t0 * 1024 + hoff + sc), oK1 = (unsigned)(t1 * 1024 + hoff + sc), oA = (unsigned)(trow * 1024 + hoff + quad * 8), oT = (unsigned)(irow * 64 + quad * 8);
        unsigned oV[4];
#pragma unroll
        for (int r = 0; r < 4; ++r) oV[r] = (unsigned)((dir ? 63 - (i0 + r) : (i0 + r)) * 1024 + hoff + half * 64 + dv0);
#define LD_K(base_)   do { const u16* kb_ = kd + (size_t)(base_) * 1024; const u16* qb_ = qd + (size_t)(base_) * 1024; K0 = *(const s16x8*)(kb_ + oK0); K1 = *(const s16x8*)(kb_ + oK1); Q0 = *(const s16x8*)(qb_ + oK0); Q1 = *(const s16x8*)(qb_ + oK1); } while (0)
#define LD_A(base_)   do { const u16* vb_ = vd_row(a.ws, (base_)); \
        _Pragma("unroll") for (int r = 0; r < 4; ++r) { V0[r] = bf2f(vb_[oV[r]]); V1[r] = bf2f(vb_[oV[r] + 16]); } } while (0)
#define LD_TB(rec_)   do { const u16* p_ = (const u16*)(rec_) + oT; TB[0] = *(const s16x8*)p_; TB[1] = *(const s16x8*)(p_ + 32); EK = *(const f32x4*)((const float*)((rec_) + 16384) + 64 + i0); } while (0)
#define LD_IN(rec_)   do { const u16* p_ = (const u16*)((rec_) + 8192) + oT; IN[0] = *(const s16x8*)p_; IN[1] = *(const s16x8*)(p_ + 32); } while (0)
#define LD_EG(rec_)   do { EG = *(const f32x4*)((const float*)((rec_) + 16384) + i0); } while (0)
#define LD_D(rec_)    do { DCH = ((const float*)((rec_) + 16384))[128]; } while (0)
        { const int c0 = SCAN_C68(0); const int bs = SCAN_BASE(c0); const unsigned char* rc = SCAN_REC(c0);
          LD_K(bs); LD_A(bs); LD_TB(rc); LD_IN(rc); LD_EG(rc); LD_D(rc); }
        for (int n = 0; n < 68; ++n) {
            const int c68 = SCAN_C68(n);
            const int base = SCAN_BASE(c68);
            const int nn = n < 67 ? n + 1 : 67; const int c68n = SCAN_C68(nn); const int basen = SCAN_BASE(c68n); const unsigned char* recn = SCAN_REC(c68n);
#pragma unroll
            for (int r = 0; r < 16; ++r) *(u16*)(ST + (32 * mtS + at::crow(r, hi)) * 272 + (32 * D0 + r32) * 2) = f2bf(sT[r]);
            *(s16x8*)(KV + vst0) = K0; *(s16x8*)(KV + vst1) = K1;
            *(s16x8*)(KR + sr * 272 + sc * 2) = K0; *(s16x8*)(KR + (32 + sr) * 272 + sc * 2) = K1;
            *(s16x8*)(QR + sr * 272 + sc * 2) = Q0; *(s16x8*)(QR + (32 + sr) * 272 + sc * 2) = Q1;
            LD_K(basen);
            __syncthreads();
            f32x4 KS0 = {0.f, 0.f, 0.f, 0.f}, KS1 = KS0, QS0 = KS0, QS1 = KS0;
#pragma unroll
            for (int kk = 0; kk < 4; ++kk) {
                const s16x8 b0 = *(const s16x8*)(ST + dv0 * 272 + (kk * 32 + quad * 8) * 2), b1 = *(const s16x8*)(ST + dv1 * 272 + (kk * 32 + quad * 8) * 2);
                const s16x8 ak = *(const s16x8*)(KR + irow * 272 + (kk * 32 + quad * 8) * 2), aq = *(const s16x8*)(QR + irow * 272 + (kk * 32 + quad * 8) * 2);
                KS0 = mfma16(ak, b0, KS0); KS1 = mfma16(ak, b1, KS1); QS0 = mfma16(aq, b0, QS0); QS1 = mfma16(aq, b1, QS1);
            }
            {
                const f32x4 r0 = V0 - EG * KS0, r1 = V1 - EG * KS1;
                u32x2 w0, w1; w0.x = pk(r0[0], r0[1]); w0.y = pk(r0[2], r0[3]); w1.x = pk(r1[0], r1[1]); w1.y = pk(r1[2], r1[3]);
                *(u32x2*)(RT + dv0 * 144 + i0 * 2) = w0; *(u32x2*)(RT + dv1 * 144 + i0 * 2) = w1;
            }
            LD_A(basen);
            __syncthreads();
            f32x4 N0 = {0.f, 0.f, 0.f, 0.f}, N1 = N0;
            {
#pragma unroll
                for (int kk = 0; kk < 2; ++kk) {
                    const s16x8 b0 = *(const s16x8*)(RT + dv0 * 144 + (kk * 32 + quad * 8) * 2), b1 = *(const s16x8*)(RT + dv1 * 144 + (kk * 32 + quad * 8) * 2);
                    N0 = mfma16(TB[kk], b0, N0); N1 = mfma16(TB[kk], b1, N1); }
                u32x2 w0, w1; w0.x = pk(N0[0], N0[1]); w0.y = pk(N0[2], N0[3]); w1.x = pk(N1[0], N1[1]); w1.y = pk(N1[2], N1[3]);
                *(u32x2*)(VN + dv0 * 144 + i0 * 2) = w0; *(u32x2*)(VN + dv1 * 144 + i0 * 2) = w1;
                const f32x4 s0 = N0 * EK, s1 = N1 * EK;
                w0.x = pk(s0[0], s0[1]); w0.y = pk(s0[2], s0[3]); w1.x = pk(s1[0], s1[1]); w1.y = pk(s1[2], s1[3]);
                *(u32x2*)(VS + dv0 * 144 + i0 * 2) = w0; *(u32x2*)(VS + dv1 * 144 + i0 * 2) = w1;
            }
            LD_TB(recn);
            __syncthreads();
            {
                f32x4 O0 = QS0 * EG, O1 = QS1 * EG;
#pragma unroll
                for (int kk = 0; kk < 2; ++kk) {
                    const s16x8 b0 = *(const s16x8*)(VN + dv0 * 144 + (kk * 32 + quad * 8) * 2), b1 = *(const s16x8*)(VN + dv1 * 144 + (kk * 32 + quad * 8) * 2);
                    O0 = mfma16(IN[kk], b0, O0); O1 = mfma16(IN[kk], b1, O1); }
                if (n >= 4) {
#pragma unroll
                    for (int r = 0; r < 4; ++r) { u16* op = Od + (size_t)base * 1024 + oV[r];
                        op[0] = f2bf(O0[r]); op[16] = f2bf(O1[r]); } }
            }
            LD_IN(recn); LD_EG(recn);
            {
#pragma unroll
                for (int r = 0; r < 16; ++r) sT[r] *= DCH;
                LD_D(recn);
                const unsigned char* vsp = VS + (32 * mtS + r32) * 144 + (8 * hi) * 2;
                const at::bf16x8 pa0 = *(const at::bf16x8*)(vsp), pa1 = *(const at::bf16x8*)(vsp + 32), pa2 = *(const at::bf16x8*)(vsp + 64), pa3 = *(const at::bf16x8*)(vsp + 96);
                if (D0 == 0) at::pv_one<0>(sT, vb0, pa0, pa1, pa2, pa3);
                else if (D0 == 1) at::pv_one<1>(sT, vb0, pa0, pa1, pa2, pa3);
                else if (D0 == 2) at::pv_one<2>(sT, vb0, pa0, pa1, pa2, pa3);
                else at::pv_one<3>(sT, vb0, pa0, pa1, pa2, pa3);
            }
            __syncthreads();
        }
#undef LD_K
#undef LD_A
#undef LD_TB
#undef LD_IN
#undef LD_EG
#undef LD_D
#undef SCAN_C68
#undef SCAN_BASE
#undef SCAN_REC
    }
}

#if defined(EXP_NAIVE_DN)
__device__ __forceinline__ void phase_dn_naive(const Args& a, unsigned char* shm) {
    const int tid = tid_opaque(), dvl = tid & 63, kg = tid >> 6;
    float* red = (float*)shm;
    const u16* qd = (const u16*)(a.ws + O_QD); const u16* kd = (const u16*)(a.ws + O_KD); const u16* vd = (const u16*)(a.ws + O_VD1); const float* BA = (const float*)(a.ws + O_BA);
    for (int task = blockIdx.x; task < 256; task += gridDim.x) {
        const int half = task & 1, dir = (task >> 1) & 1, h = (task >> 2) & 7, b = task >> 5;
#if defined(EXP_HYBRID)
        if (!(EXP_HYBRID)) continue;
#endif
        u16* Od = (u16*)a.out + (dir ? (size_t)MLAT * 1024 : (size_t)0);
        float S[16];
#pragma unroll
        for (int e = 0; e < 16; ++e) S[e] = 0.f;
        const float alog = a.in[14][dir * 8 + h], dtb = a.in[15][dir * 8 + h];
        for (int n = 0; n < 4352; ++n) {
            int row; if (n < 256) { const int t = dir ? 255 - n : n; row = MLAT + b * 256 + t; } else { const int t = dir ? 4095 - (n - 256) : (n - 256); row = b * 4096 + t; }
            const float* bap = BA + (size_t)row * 32;
            const float beta = sigm_f(bap[dir * 8 + h]);
            const float xs = bap[16 + dir * 8 + h] + dtb;
            const float g = -__expf(alog) * (fmaxf(xs, 0.f) + log1pf(__expf(-fabsf(xs))));
            const float eg = __expf(g);
            const u16* kp = kd + (size_t)row * 1024 + h * 128 + kg * 16; const u16* qp = qd + (size_t)row * 1024 + h * 128 + kg * 16;
            float kk[16], qq[16];
#pragma unroll
            for (int e = 0; e < 16; ++e) { kk[e] = bf2f(kp[e]); qq[e] = bf2f(qp[e]); }
            const float v = bf2f(vd[(size_t)row * 1024 + h * 128 + half * 64 + dvl]);
            float ps = 0.f;
#pragma unroll
            for (int e = 0; e < 16; ++e) { S[e] *= eg; ps += kk[e] * S[e]; }
            red[kg * 64 + dvl] = ps;
            __syncthreads();
            float ks = 0.f;
#pragma unroll
            for (int g8 = 0; g8 < 8; ++g8) ks += red[g8 * 64 + dvl];
            __syncthreads();
            const float delta = beta * (v - ks);
            float po = 0.f;
#pragma unroll
            for (int e = 0; e < 16; ++e) { S[e] += kk[e] * delta; po += qq[e] * S[e]; }
            red[kg * 64 + dvl] = po;
            __syncthreads();
            if (n >= 256 && kg == 0) { float o = 0.f;
#pragma unroll
                for (int g8 = 0; g8 < 8; ++g8) o += red[g8 * 64 + dvl];
                Od[(size_t)row * 1024 + h * 128 + half * 64 + dvl] = f2bf(o); }
            __syncthreads();
        }
    }
}
#endif


#if defined(EXP_VALU_SCAN)
#define BR(x) bf2f(f2bf(x))
__device__ __forceinline__ void phase_dn_scan_valu(const Args& a, unsigned char* shm) {
    const int tid = tid_opaque(), dvl = tid & 63, rg = tid >> 6;
    float* S = (float*)shm; float* kc = S + 8192; float* qc = kc + 8192; float* rr = qc + 8192; float* vn = rr + 4096;
    const u16* qd = (const u16*)(a.ws + O_QD); const u16* kd = (const u16*)(a.ws + O_KD);
    const unsigned char* REC = a.ws + O_REC;
    for (int task = blockIdx.x; task < 256; task += gridDim.x) {
        const int half = task & 1, dir = (task >> 1) & 1, h = (task >> 2) & 7, b = task >> 5;
        u16* Od = (u16*)a.out + (dir ? (size_t)MLAT * 1024 : (size_t)0);
        for (int i = tid; i < 8192; i += 512) S[i] = 0.f;
        __syncthreads();
        for (int n = 0; n < 68; ++n) {
            const int c68 = n < 4 ? (dir ? 3 - n : n) : (dir ? 71 - n : n);
            const int base = c68 < 4 ? MLAT + b * 256 + c68 * 64 : b * 4096 + (c68 - 4) * 64;
            const unsigned char* rec = REC + (size_t)((((b * 8 + h) * 2 + dir) * 68) + c68) * REC_BYTES;
            const u16* Tb = (const u16*)rec; const u16* In = (const u16*)(rec + 8192); const float* rf = (const float*)(rec + 16384);
            for (int i = tid; i < 8192; i += 512) { const int p = i >> 7, dk = i & 127, t = dir ? 63 - p : p;
                kc[i] = bf2f(kd[(size_t)(base + t) * 1024 + h * 128 + dk]); qc[i] = bf2f(qd[(size_t)(base + t) * 1024 + h * 128 + dk]); }
            __syncthreads();
            float QS[8];
#pragma unroll
            for (int m = 0; m < 8; ++m) { const int i = rg + 8 * m, t = dir ? 63 - i : i; float ks = 0.f, qs = 0.f;
                for (int dk = 0; dk < 128; ++dk) { const float sv = BR(S[dk * 64 + dvl]); ks += kc[i * 128 + dk] * sv; qs += qc[i * 128 + dk] * sv; }
                QS[m] = qs; rr[i * 64 + dvl] = BR(bf2f(vd[(size_t)(base + t) * 1024 + h * 128 + half * 64 + dvl]) - rf[i] * ks); }
            __syncthreads();
#pragma unroll
            for (int m = 0; m < 8; ++m) { const int i = rg + 8 * m; float s = 0.f;
                for (int j = 0; j < 64; ++j) s += bf2f(Tb[i * 64 + j]) * rr[j * 64 + dvl];
                vn[i * 64 + dvl] = s; }
            __syncthreads();
#pragma unroll
            for (int m = 0; m < 8; ++m) { const int i = rg + 8 * m, t = dir ? 63 - i : i; float s = rf[i] * QS[m];
                for (int j = 0; j < 64; ++j) s += bf2f(In[i * 64 + j]) * BR(vn[j * 64 + dvl]);
                if (n >= 4) Od[(size_t)(base + t) * 1024 + h * 128 + half * 64 + dvl] = f2bf(s); }
            { const float d = rf[128];
#pragma unroll
                for (int e = 0; e < 16; ++e) { const int dk = rg * 16 + e; float s = d * S[dk * 64 + dvl];
                    for (int t = 0; t < 64; ++t) s += kc[t * 128 + dk] * BR(rf[64 + t] * vn[t * 64 + dvl]);
                    S[dk * 64 + dvl] = s; } }
            __syncthreads();
        }
    }
}
#endif

__device__ __forceinline__ void rope8(f32x4& v0, f32x4& v1, const f32x4 p0, const f32x4 p1, bool second, float pos, int f0) {
#pragma unroll
    for (int j = 0; j < 8; ++j) {
        const float invf = exp2f(-(float)(f0 + j) * (13.287712379549449f / 32.f));
        const float ang = pos * invf; const float c = __cosf(ang), s = __sinf(ang);
        const float mine = j < 4 ? v0[j & 3] : v1[j & 3], other = j < 4 ? p0[j & 3] : p1[j & 3];
        const float o = second ? (mine * c + other * s) : (mine * c - other * s);
        if (j < 4) v0[j & 3] = o; else v1[j & 3] = o;
    }
}
__device__ __forceinline__ void phase_attn_prep(const Args& a) {
    const int lane = tid_opaque() & 63, gw = blockIdx.x * 8 + (tid_opaque() >> 6), nw = gridDim.x * 8;
    u16* QA = (u16*)(a.ws + O_QA); const u16* KVA = (const u16*)(a.ws + O_KVA); u16* KALL = (u16*)(a.ws + O_KALL); u16* VALL = (u16*)(a.ws + O_VALL);
    const float* qn = a.in[18]; const float* kn = a.in[19];
    for (int row = gw; row < MALL; row += nw) {
        const bool lat = row < MLAT;
        const int t = lat ? (row & 4095) : ((row - MLAT) & 255); const int b = lat ? (row >> 12) : ((row - MLAT) >> 8);
        {
            const u16* kp = KVA + (size_t)row * 512 + 4 * lane;
            const u32x2 ku = *(const u32x2*)kp; const u32x2 vu = *(const u32x2*)(kp + 256);
            f32x4 kv = (f32x4){bf_lo(ku.x), bf_hi(ku.x), bf_lo(ku.y), bf_hi(ku.y)};
            const int d = 4 * (lane & 31);
            float ss = kv[0] * kv[0] + kv[1] * kv[1] + kv[2] * kv[2] + kv[3] * kv[3];
            ss = grp32_sum(ss); const float rs = rsqrtf(ss * (1.f / 128.f) + 1e-6f);
            kv = kv * rs * *(const f32x4*)(kn + d);
            f32x4 pp;
#pragma unroll
            for (int j = 0; j < 4; ++j) pp[j] = __shfl_xor(kv[j], 8);
            if (lat) { const bool second = (lane >> 3) & 1; const int axis = (lane >> 4) & 1; const float pos = axis ? (float)(t & 63) : (float)(t >> 6);
#pragma unroll
                for (int j = 0; j < 4; ++j) { const float invf = exp2f(-(float)((d & 31) + j) * (13.287712379549449f / 32.f)); const float ang = pos * invf; const float c = __cosf(ang), s = __sinf(ang);
                    kv[j] = second ? (kv[j] * c + pp[j] * s) : (kv[j] * c - pp[j] * s); } }
            const size_t orow = (size_t)b * 4352 + (lat ? 256 + t : t);
            u32x2 ko; ko.x = pk(kv[0], kv[1]); ko.y = pk(kv[2], kv[3]);
            *(u32x2*)(KALL + orow * 256 + 4 * lane) = ko; *(u32x2*)(VALL + orow * 256 + 4 * lane) = vu;
        }
    }
}

__device__ __forceinline__ void phase_attn(const Args& a, unsigned char* shm) {
    u16* QA = (u16*)(a.ws + O_QA); const u16* KALL = (const u16*)(a.ws + O_KALL); const u16* VALL = (const u16*)(a.ws + O_VALL);
    const int nblk = gridDim.x;
    for (int it = 0;; ++it) {
        int task;
        if (nblk == 256) { if (it >= 4) break; const int xcd = blockIdx.x & 7, slot = blockIdx.x >> 3; const int tix = it * 32 + slot; task = (xcd * 2 + (tix >> 6)) * 64 + (tix & 63); }
        else { task = blockIdx.x + it * nblk; if (task >= 1024) break; }
        const int grp = task >> 6, within = task & 63, b = grp >> 1, kvh = grp & 1, qb = within >> 2, g = within & 3, head = kvh * 4 + g;
        u16* Qb = QA + ((size_t)b * 4096 + qb * 256) * 1024 + head * 128;
        const u16* Kh = KALL + (size_t)b * 4352 * 256 + kvh * 128; const u16* Vh = VALL + (size_t)b * 4352 * 256 + kvh * 128;
        at::attn_dense_body<at::bf16>((const at::bf16*)Qb, (const at::bf16*)Kh, (const at::bf16*)Vh, Qb, 4352, (char*)shm, qb * 256, a.in[18]);
        __syncthreads();
    }
}

__device__ __forceinline__ void phase_merge_prep(const Args& a) {
    const int lane = tid_opaque() & 63, gw = blockIdx.x * 8 + (tid_opaque() >> 6), nw = gridDim.x * 8;
    const u16* OF = (const u16*)a.out; const u16* OB = OF + (size_t)MLAT * 1024; const u16* Z = (const u16*)(a.ws + O_Z); u16* A3 = (u16*)(a.ws + O_A3);
    const float* dnn = a.in[16];
    const int d = 8 * (lane & 15); const f32x4 g0 = *(const f32x4*)(dnn + d), g1 = *(const f32x4*)(dnn + d + 4);
    for (int row = gw; row < MLAT; row += nw) {
#pragma unroll
        for (int i = 0; i < 2; ++i) { const size_t off = (size_t)row * 1024 + 512 * i + 8 * lane;
            f32x4 f0, f1, b0, b1, z0, z1; unpk8(*(const u32x4*)(OF + off), f0, f1); unpk8(*(const u32x4*)(OB + off), b0, b1); unpk8(*(const u32x4*)(Z + off), z0, z1);
            f0 += b0; f1 += b1;
            float ss = 0.f;
#pragma unroll
            for (int j = 0; j < 4; ++j) ss += f0[j] * f0[j] + f1[j] * f1[j];
            ss = grp16_sum(ss); const float rs = rsqrtf(ss * (1.f / 128.f) + 1e-6f);
#pragma unroll
            for (int j = 0; j < 4; ++j) { f0[j] = f0[j] * rs * g0[j] * silu_f(z0[j]); f1[j] = f1[j] * rs * g1[j] * silu_f(z1[j]); }
            *(u32x4*)(A3 + off) = pk8(f0, f1); }
    }
}

__global__ void __launch_bounds__(512, 2) fwd_megakernel(Args a) {
    extern __shared__ __attribute__((aligned(16))) unsigned char shm[];
    cg::grid_group grid = cg::this_grid();
    volatile LAS unsigned* xst = (volatile LAS unsigned*)(shm + LDS_BYTES - 16);
    if (threadIdx.x == 0) { xst[0] = 0u; xst[1] = 0u; }
    __syncthreads();
    const xb::XcdBarrier XB = xb::xcd_barrier_post((unsigned*)(a.ws + O_BAR), xst);
#define GSYNC() xb::xcd_barrier(XB)
    unsigned char* ws = a.ws;
    const long gtid = (long)blockIdx.x * 512 + threadIdx.x, gth = (long)gridDim.x * 512;
    cvt_w<1>(a.in[8], 1024, 5632, (u16*)(ws + O_WGU1), 5632, gtid, gth);
    phase_mod(a, shm);
#if defined(EXP_SELFCHK)
    if (blockIdx.x == 0 && threadIdx.x == 0) *(unsigned*)(ws + O_MOD + 9 * 9216 * 4) = 0u;
#endif
    grid.sync();
    phase_h1(a);
    GSYNC();
    { EpiSwiglu E; E.O = (u16*)(ws + O_ACT); run_gemm(shm, (const u16*)(ws + O_A), (const u16*)(ws + O_WGU1), MALL, 5632, 1024, E); }
    { const int G = gridDim.x, rem = ((MALL / 256) * 22) % G;
      if (rem == 0 || (int)blockIdx.x >= rem) { const int f = rem == 0 ? 0 : rem; const long gt = (long)((int)blockIdx.x - f) * 512 + threadIdx.x, gn = (long)(G - f) * 512;
        cvt_w<0>(a.in[9], 2816, 1024, (u16*)(ws + O_WD1), 1024, gt, gn);
        cvt_w<2>(a.in[12], 1024, INW, (u16*)(ws + O_WIN1), 3328, gt, gn); } }
    GSYNC();
    { EpiPlain E; E.O = (u16*)(ws + O_Y1); E.ldc = 1024; run_gemm(shm, (const u16*)(ws + O_ACT), (const u16*)(ws + O_WD1), MLAT, 1024, 2816, E); }
    GSYNC();
    { EpiPlain E; E.O = (u16*)(ws + O_Y1) + (size_t)MLAT * 1024; E.ldc = 1024; run_gemm(shm, (const u16*)(ws + O_ACT) + (size_t)MLAT * FH, (const u16*)(ws + O_WD1), MCTX, 1024, 2816, E); }
    { const int G = gridDim.x, f = G > 32 ? 32 : 0;
      if ((int)blockIdx.x >= f) { const long gt = (long)((int)blockIdx.x - f) * 512 + threadIdx.x, gn = (long)(G - f) * 512;
        cvt_w<3>(a.in[12], 1024, INW, (u16*)(ws + O_WIN2), 4608, gt, gn); }
      phase_h2(a, 0, MLAT, f, G - f); }
    GSYNC();
    phase_h2(a, MLAT, MALL);
    GSYNC();
    { EpiIn1 E; E.q = (u16*)(ws + O_QRAW); E.k = (u16*)(ws + O_KRAW); E.v = (u16*)a.out; E.ba = (float*)(ws + O_BA); run_gemm(shm, (const u16*)(ws + O_A), (const u16*)(ws + O_WIN1), MALL, 3328, 1024, E); }
    GSYNC();
    phase_dn_prep(a);
    GSYNC();
#if defined(EXP_NAIVE_DN) && !defined(EXP_HYBRID)
    phase_dn_naive(a, shm);
#else
    phase_dn_pre(a, shm);
    GSYNC();
#if defined(EXP_VALU_SCAN)
    phase_dn_scan_valu(a, shm);
#else
    phase_dn_scan(a, shm);
#endif
#if defined(EXP_HYBRID)
    GSYNC();
    phase_dn_naive(a, shm);
#endif
#endif
    GSYNC();
    { EpiIn2 E; E.z = (u16*)(ws + O_Z); E.qa = (u16*)(ws + O_QA); E.kva = (u16*)(ws + O_KVA); E.gates = (u16*)(ws + O_GATES); run_gemm(shm, (const u16*)(ws + O_A), (const u16*)(ws + O_WIN2), MALL, 4608, 1024, E); }
    { const int G = gridDim.x, rem = ((MALL / 256) * 18) % G;
      if (rem == 0 || (int)blockIdx.x >= rem) { const int f = rem == 0 ? 0 : rem; const long gt = (long)((int)blockIdx.x - f) * 512 + threadIdx.x, gn = (long)(G - f) * 512;
        cvt_w<0>(a.in[17], 1024, 1024, (u16*)(ws + O_WDN), 1024, gt, gn);
        cvt_w<0>(a.in[20], 1024, 1024, (u16*)(ws + O_WAT), 1024, gt, gn);
        cvt_w<0>(a.in[21], 1024, 1024, (u16*)(ws + O_WOUT), 1024, gt, gn);
        cvt_w<1>(a.in[24], 1024, 5632, (u16*)(ws + O_WGU2), 5632, gt, gn);
        cvt_w<0>(a.in[25], 2816, 1024, (u16*)(ws + O_WD2), 1024, gt, gn); } }
    GSYNC();
    phase_attn_prep(a);
    GSYNC();
    phase_attn(a, shm);
    GSYNC();
    phase_merge_prep(a);
    GSYNC();
    { EpiMerge<0> E; E.gates = (const u16*)(ws + O_GATES); E.T = (u16*)(ws + O_T); run_gemm(shm, (const u16*)(ws + O_A3), (const u16*)(ws + O_WDN), MLAT, 1024, 1024, E); }
    { EpiMerge<1> E; E.gates = (const u16*)(ws + O_GATES); E.T = (u16*)(ws + O_T); run_gemm(shm, (const u16*)(ws + O_QA), (const u16*)(ws + O_WAT), MLAT, 1024, 1024, E); }
    GSYNC();
    { EpiPlain E; E.O = (u16*)(ws + O_Y); E.ldc = 1024; run_gemm(shm, (const u16*)(ws + O_T), (const u16*)(ws + O_WOUT), MLAT, 1024, 1024, E); }
    GSYNC();
    phase_h3(a);
    GSYNC();
    { EpiSwiglu E; E.O = (u16*)(ws + O_ACT2); run_gemm(shm, (const u16*)(ws + O_A5), (const u16*)(ws + O_WGU2), MLAT, 5632, 1024, E); }
    GSYNC();
    { EpiPlain E; E.O = (u16*)(ws + O_Y2); E.ldc = 1024; run_gemm(shm, (const u16*)(ws + O_ACT2), (const u16*)(ws + O_WD2), MLAT, 1024, 2816, E); }
    GSYNC();
    phase_out(a);
#if defined(EXP_SELFCHK)
    GSYNC();
    if (blockIdx.x == 0 && threadIdx.x == 0) { const unsigned f = *(volatile unsigned*)(ws + O_MOD + 9 * 9216 * 4);
        if (f & 8u) a.out[0] += 6.2e6f; if (f & 4u) a.out[1] += 6.2e5f; if (f & 2u) a.out[2] += 6.2e4f; if (f & 1u) a.out[3] += 6.2e3f; }
#endif
}

extern "C" void kernel_launch(void* const* d_in, const int* in_sizes, int n_in, void* d_out, int out_size, void* d_ws, size_t ws_size, hipStream_t stream) {
    static int grid_blocks = 0;
    if (grid_blocks == 0) {
        if (n_in != 26 || out_size != MLAT * 1024 || ws_size < WS_NEED) { fprintf(stderr, "kernel_launch: unexpected shapes: n_in %d out %d ws %zu (need %zu)\n", n_in, out_size, ws_size, (size_t)WS_NEED); grid_blocks = -1; return; }
        int dev = 0, cus = 0, per_cu = 0;
        hipGetDevice(&dev);
        hipDeviceGetAttribute(&cus, hipDeviceAttributeMultiprocessorCount, dev);
        if (hipFuncSetAttribute((const void*)fwd_megakernel, hipFuncAttributeMaxDynamicSharedMemorySize, LDS_BYTES) != hipSuccess) { fprintf(stderr, "kernel_launch: hipFuncSetAttribute failed\n"); grid_blocks = -1; return; }
        if (hipOccupancyMaxActiveBlocksPerMultiprocessor(&per_cu, (const void*)fwd_megakernel, 512, LDS_BYTES) != hipSuccess || per_cu < 1) { fprintf(stderr, "kernel_launch: occupancy query failed (%d)\n", per_cu); (void)hipGetLastError(); per_cu = 1; }
        grid_blocks = cus * per_cu;
    }
    if (grid_blocks < 0) return;
    if (hipMemsetAsync((char*)d_ws + O_BAR, 0, XCD_BAR_WORDS * sizeof(unsigned), stream) != hipSuccess) { fprintf(stderr, "kernel_launch: memset of the barrier words failed\n"); return; }
    Args a{};
    for (int i = 0; i < 26; ++i) a.in[i] = (const float*)d_in[i];
    a.out = (float*)d_out; a.ws = (unsigned char*)d_ws;
    void* args[] = {&a};
    hipError_t e = hipLaunchCooperativeKernel((const void*)fwd_megakernel, dim3(grid_blocks), dim3(512), args, LDS_BYTES, stream);
    if (e != hipSuccess) fprintf(stderr, "cooperative launch failed: %s (grid %d)\n", hipGetErrorString(e), grid_blocks);
}
```

```cpp
#include <hip/hip_runtime.h>
#include <hip/hip_bf16.h>
#include <hip/hip_cooperative_groups.h>
#include <cstdio>
#include <cstdint>
namespace cg = cooperative_groups;
__device__ __forceinline__ int tid_opaque() { int t = threadIdx.x; asm volatile("" : "+v"(t)); return t; }
namespace pg8 {
#define PG8_LAS __attribute__((address_space(3)))
typedef unsigned short bf16_t;
typedef short bf16x8 __attribute__((ext_vector_type(8)));
typedef float f32x4 __attribute__((ext_vector_type(4)));
typedef unsigned u32x4 __attribute__((ext_vector_type(4)));
constexpr int BM = 256, BK = 64, HALF = 128, HTB = HALF * BK * 2  , STAGE_BYTES = 8 * HTB, NXCD = 8, WGM = 8;

__host__ __device__ __forceinline__ int lds_byte(int r, int c) { const int st = (r >> 4) * 2 + (c >> 5), rr = r & 15, cc = c & 31, ob = rr * 64 + cc * 2; return st * 1024 + (ob ^ (((ob >> 9) & 1) << 5)); }
__host__ __device__ __forceinline__ void stage_rc(int b, int& R, int& C) { const int st = b / 1024, sb = b % 1024, swz = sb ^ (((sb >> 9) & 1) << 5); R = (st >> 1) * 16 + swz / 64; C = (st & 1) * 32 + (swz % 64) / 2; }
__host__ __device__ __forceinline__ int perm32(int rho) { const int n = rho >> 4, i = rho & 15; return 8 * (i >> 2) + 4 * n + (i & 3); }

struct Unit { int pm, pn; };
struct Gemm { const bf16_t* A; const bf16_t* Bt; int M, N, K; };

struct StaticOrder {
    int nM, nN, nwg, G, c;
    __host__ __device__ void init(int M, int N, int G_, int c_) { nM = M / BM; nN = N / BM; nwg = nM * nN; G = G_; c = c_; }
    __host__ __device__ bool next(int i, Unit& u) const {
        const long L = (long)i * G + c; if (L >= nwg) return false;
        int wgid = (int)L; { const int q = nwg / NXCD, r = nwg % NXCD, xcd = wgid % NXCD, off = wgid / NXCD; wgid = (xcd < r ? xcd * (q + 1) : r * (q + 1) + (xcd - r) * q) + off; }
        const int nig = WGM * nN, gid = wgid / nig, fm = gid * WGM, gsz = (nM - fm) < WGM ? (nM - fm) : WGM;
        u.pm = fm + ((wgid % nig) % gsz); u.pn = (wgid % nig) / gsz; return true;
    }
    __device__ __forceinline__ void a_ready(const Unit&) const {}
    __device__ __forceinline__ void done(const Unit&) const {}
};
__device__ __forceinline__ unsigned cvt_pk_bf16(float lo, float hi) { unsigned r; asm volatile("v_cvt_pk_bf16_f32 %0, %1, %2" : "=v"(r) : "v"(lo), "v"(hi)); return r; }

template <class Epi, class Sched, bool STAMP = false>
__device__ __forceinline__ void gemm_phase(PG8_LAS unsigned char* lds, const Gemm g, const Sched& S, const Epi& E, unsigned long long* stamps) {
    const int tid = tid_opaque(), wid = __builtin_amdgcn_readfirstlane(tid >> 6), lane = tid & 63, wr = wid >> 2, wc = wid & 3, fr = lane & 15, fq = lane >> 4;
    const int K = g.K, nt = K / BK;
    int ts_lo = 0, ts_hi = 0, nts = 0; const unsigned long long rt_entry = STAMP ? (unsigned long long)wall_clock64() : 0ull;
#define PG8_STAMP() do { if (STAMP && wid == 0 && nts < 64) { const unsigned long long _c = (unsigned long long)clock64(); \
        ts_lo = (lane == nts) ? (int)(unsigned)_c : ts_lo; ts_hi = (lane == nts) ? (int)(unsigned)(_c >> 32) : ts_hi; ++nts; } } while (0)
    PG8_STAMP();
    unsigned voffA[2], voffB[2];
#pragma unroll
    for (int i = 0; i < 2; ++i) { int R, C; stage_rc(tid * 16 + i * 8192, R, C); const int Rb = Epi::PERM ? ((R & ~31) + perm32(R & 31)) : R;
        voffA[i] = (unsigned)(R * K + C) * 2u; voffB[i] = (unsigned)(Rb * K + C) * 2u; }
    const size_t kstep = (size_t)(BK * 2);
    const size_t hstep = (size_t)HALF * K * 2;
    const size_t tstep = 2 * hstep;
    const unsigned ldsw = (unsigned)wid * 1024u;
    const int aoff = lds_byte(wr * 64 + fr, fq * 8), boff = lds_byte(wc * 32 + fr, fq * 8);
#define PG8_SA(b, h) (((b) * 2 + (h)) * HTB)
#define PG8_SB(b, h) ((4 + (b) * 2 + (h)) * HTB)
#define PG8_STAGE(bufoff, gbase, voff) do { _Pragma("unroll") for (int _i = 0; _i < 2; ++_i) \
        __builtin_amdgcn_global_load_lds((const unsigned*)((const char*)(gbase) + (voff)[_i]), (PG8_LAS unsigned*)(lds + (bufoff) + ldsw + _i * 8192), 16, 0, 0); } while (0)
#define PG8_LDA(dst, b, h) do { _Pragma("unroll") for (int m = 0; m < 4; ++m) _Pragma("unroll") for (int k = 0; k < 2; ++k) dst[m][k] = *(const PG8_LAS bf16x8*)(lds + PG8_SA(b, h) + aoff + m * 2048 + k * 1024); } while (0)
#define PG8_LDB(dst, b, h) do { _Pragma("unroll") for (int n = 0; n < 2; ++n) _Pragma("unroll") for (int k = 0; k < 2; ++k) dst[n][k] = *(const PG8_LAS bf16x8*)(lds + PG8_SB(b, h) + boff + n * 2048 + k * 1024); } while (0)
#define PG8_MMA(ai, bj, At, Bt) do { __builtin_amdgcn_s_setprio(1); _Pragma("unroll") for (int m = 0; m < 4; ++m) _Pragma("unroll") for (int n = 0; n < 2; ++n) _Pragma("unroll") for (int k = 0; k < 2; ++k) \
        acc[ai][bj][m][n] = __builtin_amdgcn_mfma_f32_16x16x32_bf16(Bt[n][k], At[m][k], acc[ai][bj][m][n], 0, 0, 0); __builtin_amdgcn_s_setprio(0); } while (0)
#define PG8_WAIT_V(n) asm volatile("s_waitcnt vmcnt(" #n ")" ::: "memory")
#define PG8_WAIT_L(n) asm volatile("s_waitcnt lgkmcnt(" #n ")" ::: "memory")
#define PG8_BAR __builtin_amdgcn_s_barrier()
#define PG8_SCHED __builtin_amdgcn_sched_barrier(0)
    Unit cur, nxt; int ui = 0;
    if (!S.next(0, cur)) return;
    f32x4 acc[2][2][4][2];
#pragma unroll
    for (int a = 0; a < 2; ++a)
#pragma unroll
        for (int b = 0; b < 2; ++b)
#pragma unroll
            for (int m = 0; m < 4; ++m)
#pragma unroll
                for (int n = 0; n < 2; ++n) acc[a][b][m][n] = (f32x4){0.f, 0.f, 0.f, 0.f};
    bf16x8 At[4][2], B0[2][2], B1[2][2];
    const char* cA = (const char*)g.A + (size_t)cur.pm * tstep; const char* cB = (const char*)g.Bt + (size_t)cur.pn * tstep;
    S.a_ready(cur);
    PG8_STAGE(PG8_SB(0, 0), cB, voffB); PG8_STAGE(PG8_SA(0, 0), cA, voffA); PG8_STAGE(PG8_SB(0, 1), cB + hstep, voffB); PG8_STAGE(PG8_SA(0, 1), cA + hstep, voffA);
    if (wr == 1) PG8_BAR;
    PG8_WAIT_V(4); PG8_BAR;
    PG8_STAGE(PG8_SB(1, 0), cB + kstep, voffB); PG8_STAGE(PG8_SA(1, 0), cA + kstep, voffA); PG8_STAGE(PG8_SB(1, 1), cB + hstep + kstep, voffB);
    PG8_WAIT_V(6); PG8_BAR;
    PG8_STAMP();
    for (;;) {
        const bool has_next = S.next(ui + 1, nxt);
        const char* nA = has_next ? (const char*)g.A + (size_t)nxt.pm * tstep : cA; const char* nB = has_next ? (const char*)g.Bt + (size_t)nxt.pn * tstep : cB;
        for (int t = 0; t < nt; t += 2) {
            const bool last = (t == nt - 2);
            const char* a1 = cA + (size_t)(t + 1) * kstep;
            const char* a2 = last ? nA : cA + (size_t)(t + 2) * kstep; const char* b2 = last ? nB : cB + (size_t)(t + 2) * kstep;
            const char* a3 = a2 + kstep; const char* b3 = b2 + kstep;
            if (last && has_next) S.a_ready(nxt);
            PG8_LDB(B0, 0, 0); PG8_SCHED; PG8_LDA(At, 0, 0); PG8_STAGE(PG8_SA(1, 1), a1 + hstep, voffA);
            PG8_WAIT_L(8); PG8_BAR; PG8_WAIT_L(0); PG8_MMA(0, 0, At, B0); PG8_BAR; PG8_SCHED;
            PG8_LDB(B1, 0, 1); PG8_STAGE(PG8_SB(0, 0), b2, voffB);
            PG8_BAR; PG8_WAIT_L(0); PG8_MMA(0, 1, At, B1); PG8_BAR;
            PG8_LDA(At, 0, 1); PG8_STAGE(PG8_SA(0, 0), a2, voffA);
            PG8_BAR; PG8_WAIT_L(0); PG8_MMA(1, 0, At, B0); PG8_BAR; PG8_SCHED;
            PG8_STAGE(PG8_SB(0, 1), b2 + hstep, voffB);
            PG8_WAIT_V(6); PG8_BAR; PG8_MMA(1, 1, At, B1); PG8_BAR;
            PG8_LDB(B0, 1, 0); PG8_SCHED; PG8_LDA(At, 1, 0); PG8_STAGE(PG8_SA(0, 1), a2 + hstep, voffA);
            PG8_WAIT_L(8); PG8_BAR; PG8_WAIT_L(0); PG8_MMA(0, 0, At, B0); PG8_BAR; PG8_SCHED;
            PG8_LDB(B1, 1, 1); PG8_STAGE(PG8_SB(1, 0), b3, voffB);
            PG8_BAR; PG8_WAIT_L(0); PG8_MMA(0, 1, At, B1); PG8_BAR;
            PG8_LDA(At, 1, 1); PG8_STAGE(PG8_SA(1, 0), a3, voffA);
            PG8_BAR; PG8_WAIT_L(0); PG8_MMA(1, 0, At, B0); PG8_BAR; PG8_SCHED;
            PG8_STAGE(PG8_SB(1, 1), b3 + hstep, voffB);
            PG8_WAIT_V(6); PG8_BAR; PG8_MMA(1, 1, At, B1); PG8_BAR;
        }
        PG8_STAMP();
        if constexpr (!Epi::AFTER_DRAIN) { E(acc, cur, wr, wc, fr, fq); S.done(cur); }
        PG8_STAMP();
        if (!has_next) break;
#pragma unroll
        for (int a = 0; a < 2; ++a)
#pragma unroll
            for (int b = 0; b < 2; ++b)
#pragma unroll
                for (int m = 0; m < 4; ++m)
#pragma unroll
                    for (int n = 0; n < 2; ++n) acc[a][b][m][n] = (f32x4){0.f, 0.f, 0.f, 0.f};
        cur = nxt; cA = nA; cB = nB; ++ui;
    }
    PG8_WAIT_V(0);
    if (wr == 0) PG8_BAR;
    PG8_BAR;
    if constexpr (Epi::AFTER_DRAIN) { E.fused(acc, cur, wr, wc, fr, fq, lds, wid, lane); S.done(cur); }
    PG8_STAMP();
    if (STAMP && wid == 0) { stamps[lane] = lane < nts ? (((unsigned long long)(unsigned)ts_hi << 32) | (unsigned)ts_lo) : 0ull;
        if (lane == 62) stamps[62] = rt_entry; if (lane == 63) stamps[63] = (unsigned long long)wall_clock64(); }
#undef PG8_STAMP
#undef PG8_SA
#undef PG8_SB
#undef PG8_STAGE
#undef PG8_LDA
#undef PG8_LDB
#undef PG8_MMA
#undef PG8_WAIT_V
#undef PG8_WAIT_L
#undef PG8_BAR
#undef PG8_SCHED
}
}
namespace xb {

#define XB_TMO      128
#define XB_XCNT(j)  (256  + 64 * (j))
#define XB_XSUB(j)  (1280 + 64 * (j))
#define XB_XGEN(j)  (2304 + 64 * (j))
#define XB_TOP      3328
#define XB_TOPGEN   3392
#define XCD_BAR_WORDS 3456
#define XB_SPIN_CAP (1u << 18)
#define LAS __attribute__((address_space(3)))

__device__ __forceinline__ unsigned xb_ld(unsigned* p)              { return __hip_atomic_load(p, __ATOMIC_RELAXED, __HIP_MEMORY_SCOPE_AGENT); }
__device__ __forceinline__ unsigned xb_add(unsigned* p, unsigned v) { return __hip_atomic_fetch_add(p, v, __ATOMIC_RELAXED, __HIP_MEMORY_SCOPE_AGENT); }
__device__ __forceinline__ unsigned xb_xcc_id() { return (unsigned)__builtin_amdgcn_s_getreg((3 << 11) | 20) & 0xFu; }
#define XB_SPIN(cond, bar) do { unsigned _sp = 0; while (cond) { __builtin_amdgcn_s_sleep(1); \
    if ((++_sp & 255u) == 0u) { if (xb_ld(&(bar)[XB_TMO])) break; if (_sp > XB_SPIN_CAP) { atomicAdd(&(bar)[XB_TMO], 1u); break; } } } } while (0)

struct XcdBarrier {
    unsigned* bar; unsigned x;
    volatile LAS unsigned* st;
};

__device__ __forceinline__ XcdBarrier xcd_barrier_post(unsigned* bar, volatile LAS unsigned* st) {
    XcdBarrier b; b.bar = bar; b.x = xb_xcc_id(); b.st = st;
    if (threadIdx.x == 0) (void)xb_add(&bar[XB_XCNT(b.x)], 1u);
    return b;
}
__device__ __forceinline__ void xcd_barrier_complete(unsigned* bar, unsigned x, unsigned& nloc, unsigned& nx) {
    const unsigned G = gridDim.x * gridDim.y * gridDim.z;
    unsigned sum, cnt, mine, sp = 0u;
    for (;;) {
        sum = 0u; cnt = 0u; mine = 0u;
#pragma unroll
        for (unsigned j = 0; j < 16; ++j) { const unsigned c = xb_ld(&bar[XB_XCNT(j)]); sum += c; cnt += (c > 0u) ? 1u : 0u; mine = (j == x) ? c : mine; }
        if (sum == G) break;
        __builtin_amdgcn_s_sleep(1);
        if ((++sp & 255u) == 0u) { if (xb_ld(&bar[XB_TMO])) break; if (sp > XB_SPIN_CAP) { atomicAdd(&bar[XB_TMO], 1u); break; } }
    }
    nloc = mine > 0u ? mine : 1u; nx = cnt > 0u ? cnt : 1u;
}

__device__ __forceinline__ void xcd_barrier(const XcdBarrier& b) {
    asm volatile("s_waitcnt vmcnt(0)" ::: "memory");
    __syncthreads();
    if (threadIdx.x == 0) {
        unsigned* bar = b.bar;
        __builtin_amdgcn_s_waitcnt(0);
        unsigned nloc = b.st[0], nx = b.st[1];
        if (nloc == 0u) { xcd_barrier_complete(bar, b.x, nloc, nx); b.st[0] = nloc; b.st[1] = nx; }
        const unsigned old = xb_add(&bar[XB_XSUB(b.x)], 1u);
        const unsigned gen = old / nloc;
        if (old + 1u == (gen + 1u) * nloc) {
            __builtin_amdgcn_fence(__ATOMIC_RELEASE, "agent");
            asm volatile("s_waitcnt vmcnt(0)" ::: "memory");
            const unsigned og = xb_add(&bar[XB_TOP], 1u);
            const unsigned tg = og / nx;
            if (og + 1u == (tg + 1u) * nx) xb_add(&bar[XB_TOPGEN], 1u);
            else XB_SPIN(xb_ld(&bar[XB_TOPGEN]) == tg, bar);
            __builtin_amdgcn_fence(__ATOMIC_ACQUIRE, "agent");
            xb_add(&bar[XB_XGEN(b.x)], 1u);
            asm volatile("s_waitcnt vmcnt(0)" ::: "memory");
        } else {
            XB_SPIN(xb_ld(&bar[XB_XGEN(b.x)]) == gen, bar);
            __builtin_amdgcn_fence(__ATOMIC_ACQUIRE, "agent");
            asm volatile("s_waitcnt vmcnt(0)" ::: "memory");
        }
    }
    __syncthreads();
}

}
namespace at {
using bf16 = __hip_bfloat16;
constexpr int   D = 128, NW = 8, QBLK = 32, KVBLK = 64;
constexpr float SCALE = 0.088388347648318440f;
constexpr float THR = 8.f;
constexpr int SDEPTH = 1;
constexpr int LDQ = 1024, LDK = 256, LDO = 1024;
constexpr size_t SHM_V = KVBLK * D * 2, SHM_K = KVBLK * D * 2, SHM_ATTN = 2 * SHM_V + 2 * SHM_K + NW * 64 * 4;
__device__ __forceinline__ unsigned short f2bf_rne(float f) { unsigned u = __float_as_uint(f); u += 0x7FFFu + ((u >> 16) & 1u); return (unsigned short)(u >> 16); }
using bf16x8 = __attribute__((ext_vector_type(8))) short;
using s16x4  = __attribute__((ext_vector_type(4))) short;
using f32x16 = __attribute__((ext_vector_type(16))) float;
using f32x8  = __attribute__((ext_vector_type(8))) float;
using u32x4  = __attribute__((ext_vector_type(4))) unsigned;
#define KSWZ(row, colB) ((row) * 256 + ((colB) ^ (((row) & 7) << 4)))
#define SBAR() __builtin_amdgcn_sched_barrier(0)
__device__ __forceinline__ int crow(int r, int hi) { return (r & 3) + 8 * (r >> 2) + 4 * hi; }
__device__ __forceinline__ unsigned cvtpk(float lo, float hi) {
  unsigned r; asm volatile("v_cvt_pk_bf16_f32 %0, %1, %2" : "=v"(r) : "v"(lo), "v"(hi)); return r;
}
template <typename TIn> struct Stage;
template <> struct Stage<bf16>  { using T = bf16x8;
  __device__ static __forceinline__ T ld8(const bf16* p) { return *reinterpret_cast<const bf16x8*>(p); }
  __device__ static __forceinline__ bf16x8 tobf(T x) { return x; } };
template <> struct Stage<float> { using T = f32x8;
  __device__ static __forceinline__ T ld8(const float* p) { return *reinterpret_cast<const f32x8*>(p); }
  __device__ static __forceinline__ bf16x8 tobf(T x) {
    u32x4 w = {cvtpk(x[0], x[1]), cvtpk(x[2], x[3]), cvtpk(x[4], x[5]), cvtpk(x[6], x[7])}; return *reinterpret_cast<bf16x8*>(&w); } };

__device__ __forceinline__ void partialSM(f32x16& p0, f32x16& p1, float& m_reg, float& mn, float& alpha) {
  constexpr float C = SCALE * 1.4426950408889634f;
  float pmax = p0[0]; for (int r = 1; r < 16; ++r) pmax = fmaxf(pmax, p0[r]); for (int r = 0; r < 16; ++r) pmax = fmaxf(pmax, p1[r]);
  { auto rr = __builtin_amdgcn_permlane32_swap(__float_as_uint(pmax), __float_as_uint(pmax), false, false);
    pmax = fmaxf(__uint_as_float(rr[0]), __uint_as_float(rr[1])); }
  if (__builtin_expect(__all(pmax - m_reg <= THR / SCALE), 1)) { mn = m_reg; alpha = 1.f; }
  else { mn = fmaxf(m_reg, pmax); alpha = __builtin_amdgcn_exp2f((m_reg - mn) * C); m_reg = mn; }
  float mnC = -mn * C;
  for (int r = 0; r < 16; ++r) p0[r] = fmaf(p0[r], C, mnC); for (int r = 0; r < 16; ++r) p1[r] = fmaf(p1[r], C, mnC);
  for (int r = 0; r < 16; ++r) p0[r] = __builtin_amdgcn_exp2f(p0[r]);
}
__device__ __forceinline__ void finishSM(f32x16& p0, f32x16& p1, float alpha, float& l_reg, bf16x8& pa0, bf16x8& pa1, bf16x8& pa2, bf16x8& pa3) {
  for (int r = 0; r < 16; ++r) p1[r] = __builtin_amdgcn_exp2f(p1[r]);
  float ps = 0; for (int r = 0; r < 16; ++r) ps += p0[r]; for (int r = 0; r < 16; ++r) ps += p1[r];
  { auto rr = __builtin_amdgcn_permlane32_swap(__float_as_uint(ps), __float_as_uint(ps), false, false);
    ps = __uint_as_float(rr[0]) + __uint_as_float(rr[1]); }
  l_reg = l_reg * alpha + ps;
#define PK4(P, BASE, OUT) do { unsigned a0 = cvtpk(P[BASE + 0], P[BASE + 1]), a1 = cvtpk(P[BASE + 2], P[BASE + 3]);   \
    unsigned b0 = cvtpk(P[BASE + 4], P[BASE + 5]), b1 = cvtpk(P[BASE + 6], P[BASE + 7]);                              \
    auto r0 = __builtin_amdgcn_permlane32_swap(a0, b0, false, false); auto r1 = __builtin_amdgcn_permlane32_swap(a1, b1, false, false); \
    u32x4 w = {r0[0], r1[0], r0[1], r1[1]}; OUT = *reinterpret_cast<bf16x8*>(&w); } while (0)
  PK4(p0, 0, pa0); PK4(p0, 8, pa1); PK4(p1, 0, pa2); PK4(p1, 8, pa3);
#undef PK4
}
__device__ __forceinline__ void qkt(f32x16& p0, f32x16& p1, const bf16* Ks, const bf16x8* qr, int r32, int hi) {
  p0 = f32x16{}; p1 = f32x16{};
  for (int d0 = 0; d0 < 8; ++d0) { int cb = (d0 * 16 + hi * 8) * 2;
    bf16x8 b0 = *reinterpret_cast<const bf16x8*>((const char*)Ks + KSWZ(r32, cb));
    bf16x8 b1 = *reinterpret_cast<const bf16x8*>((const char*)Ks + KSWZ(32 + r32, cb));
    p0 = __builtin_amdgcn_mfma_f32_32x32x16_bf16(b0, qr[d0], p0, 0, 0, 0);
    p1 = __builtin_amdgcn_mfma_f32_32x32x16_bf16(b1, qr[d0], p1, 0, 0, 0); }
}
__device__ __forceinline__ int v_st(int k, int c) { const int kk = (k & ~0xC) | ((k & 4) << 1) | ((k & 8) >> 1); return ((kk >> 3) * 4 + (c >> 5)) * 512 + ((kk & 7) * 32 + (c & 31)) * 2; }
__device__ __forceinline__ int v_rd_base(int lane) { return ((lane & 3) << 3) | (((lane >> 2) & 3) << 6) | (((lane >> 4) & 1) << 5) | (((lane >> 5) & 1) << 8); }
constexpr int v_rd_off(int d0, int ks, int half) { return d0 * 512 + ks * 4096 + half * 2048; }
template <int OFF> __device__ __forceinline__ s16x4 tr_read(int vb) {
  s16x4 r; asm volatile("ds_read_b64_tr_b16 %0, %1 offset:%2" : "=&v"(r) : "v"(vb), "i"(OFF) : "memory"); return r;
}
template <int D0> __device__ __forceinline__ void pv_one(f32x16& od, int vb, bf16x8 pa0, bf16x8 pa1, bf16x8 pa2, bf16x8 pa3) {
  const s16x4 l0 = tr_read<v_rd_off(D0, 0, 0)>(vb), h0 = tr_read<v_rd_off(D0, 0, 1)>(vb), l1 = tr_read<v_rd_off(D0, 1, 0)>(vb), h1 = tr_read<v_rd_off(D0, 1, 1)>(vb);
  const s16x4 l2 = tr_read<v_rd_off(D0, 2, 0)>(vb), h2 = tr_read<v_rd_off(D0, 2, 1)>(vb), l3 = tr_read<v_rd_off(D0, 3, 0)>(vb), h3 = tr_read<v_rd_off(D0, 3, 1)>(vb);
  asm volatile("s_waitcnt lgkmcnt(0)" ::: "memory"); SBAR();
#define PK(L, H) (bf16x8){L[0], L[1], L[2], L[3], H[0], H[1], H[2], H[3]}
  od = __builtin_amdgcn_mfma_f32_32x32x16_bf16(pa0, PK(l0, h0), od, 0, 0, 0);
  od = __builtin_amdgcn_mfma_f32_32x32x16_bf16(pa1, PK(l1, h1), od, 0, 0, 0);
  od = __builtin_amdgcn_mfma_f32_32x32x16_bf16(pa2, PK(l2, h2), od, 0, 0, 0);
  od = __builtin_amdgcn_mfma_f32_32x32x16_bf16(pa3, PK(l3, h3), od, 0, 0, 0);
#undef PK
}
__device__ __forceinline__ void pv_d0(f32x16* o, int vb, bf16x8 pa0, bf16x8 pa1, bf16x8 pa2, bf16x8 pa3) {
  pv_one<0>(o[0], vb, pa0, pa1, pa2, pa3); pv_one<1>(o[1], vb, pa0, pa1, pa2, pa3); pv_one<2>(o[2], vb, pa0, pa1, pa2, pa3); pv_one<3>(o[3], vb, pa0, pa1, pa2, pa3);
}

template <typename TQ>
__device__ __forceinline__ void attn_dense_body(const TQ* __restrict__ Qb, const bf16* __restrict__ Kh, const bf16* __restrict__ Vh,
                                                unsigned short* Ob, int seq, char* lds, int t_base, const float* __restrict__ qn) {
  using St = Stage<bf16>; using SQ = Stage<TQ>;
  const int tid = tid_opaque(), wid = tid >> 6, lane = tid & 63, r32 = lane & 31, hi = lane >> 5;
  bf16* V_lds = (bf16*)lds; bf16* K_lds = (bf16*)(lds + 2 * SHM_V);
  float* ws = (float*)(lds + 2 * SHM_V + 2 * SHM_K) + wid * 64; float* li_l = ws; float* al_l = ws + 32;
  float m_reg = -1e30f, l_reg = 0; f32x16 o[4] = {}; bf16x8 qr[8];
  const TQ* Qw = Qb + (long)(wid * QBLK + r32) * LDQ + hi * 8;
#pragma unroll
  for (int d0 = 0; d0 < 8; ++d0) qr[d0] = SQ::tobf(SQ::ld8(Qw + d0 * 16));
  {
    const int tq = t_base + wid * QBLK + r32;
    float v[8][8]; float ss = 0.f;
#pragma unroll
    for (int d0 = 0; d0 < 8; ++d0)
#pragma unroll
      for (int j = 0; j < 8; ++j) { v[d0][j] = __uint_as_float(((unsigned)(unsigned short)qr[d0][j]) << 16); ss += v[d0][j] * v[d0][j]; }
    ss += __shfl_xor(ss, 32);
    const float rs = rsqrtf(ss * (1.f / 128.f) + 1e-6f);
#pragma unroll
    for (int d0 = 0; d0 < 8; ++d0) { const float4 g0 = *reinterpret_cast<const float4*>(qn + d0 * 16 + hi * 8), g1 = *reinterpret_cast<const float4*>(qn + d0 * 16 + hi * 8 + 4);
      v[d0][0] *= rs * g0.x; v[d0][1] *= rs * g0.y; v[d0][2] *= rs * g0.z; v[d0][3] *= rs * g0.w; v[d0][4] *= rs * g1.x; v[d0][5] *= rs * g1.y; v[d0][6] *= rs * g1.z; v[d0][7] *= rs * g1.w; }
#pragma unroll
    for (int ax = 0; ax < 2; ++ax) { const float pos = ax ? (float)(tq & 63) : (float)(tq >> 6);
#pragma unroll
      for (int e = 0; e < 2; ++e)
#pragma unroll
        for (int j = 0; j < 8; ++j) { const int f = e * 16 + hi * 8 + j; const float ang = pos * exp2f(-(float)f * (13.287712379549449f / 32.f)); const float c = __cosf(ang), s = __sinf(ang);
          const float x1 = v[ax * 4 + e][j], x2 = v[ax * 4 + 2 + e][j]; v[ax * 4 + e][j] = x1 * c - x2 * s; v[ax * 4 + 2 + e][j] = x2 * c + x1 * s; } }
#pragma unroll
    for (int d0 = 0; d0 < 8; ++d0) { u32x4 w = {cvtpk(v[d0][0], v[d0][1]), cvtpk(v[d0][2], v[d0][3]), cvtpk(v[d0][4], v[d0][5]), cvtpk(v[d0][6], v[d0][7])}; qr[d0] = *reinterpret_cast<bf16x8*>(&w); }
  }
  const int sr = tid >> 4, sc = (tid & 15) * 8, vst0 = v_st(sr, sc), vst1 = v_st(32 + sr, sc);
  const int vb0 = (int)(uintptr_t)V_lds + v_rd_base(lane);
  struct { typename St::T vs0, vs1, ks0, ks1; } sr_[SDEPTH];
#define SLOAD(i, k0) do { sr_[i].vs0 = St::ld8(&Vh[(long)((k0) + sr) * LDK + sc]); sr_[i].vs1 = St::ld8(&Vh[(long)((k0) + 32 + sr) * LDK + sc]); \
    sr_[i].ks0 = St::ld8(&Kh[(long)((k0) + sr) * LDK + sc]); sr_[i].ks1 = St::ld8(&Kh[(long)((k0) + 32 + sr) * LDK + sc]); } while (0)
#define SWRITE(b, i) do { *(bf16x8*)((char*)V_lds + (b) * SHM_V + vst0) = St::tobf(sr_[i].vs0);          \
    *(bf16x8*)((char*)V_lds + (b) * SHM_V + vst1) = St::tobf(sr_[i].vs1); int kc = sc * 2;               \
    *(bf16x8*)((char*)K_lds + (b) * SHM_K + KSWZ(sr, kc)) = St::tobf(sr_[i].ks0);                       \
    *(bf16x8*)((char*)K_lds + (b) * SHM_K + KSWZ(32 + sr, kc)) = St::tobf(sr_[i].ks1); } while (0)
#define SWAIT() do { if constexpr (SDEPTH == 2) asm volatile("s_waitcnt vmcnt(4)" ::: "memory"); else asm volatile("s_waitcnt vmcnt(0)" ::: "memory"); } while (0)
#define RESC(a) do { if (__any((a) < 1.f)) { if (hi == 0) al_l[r32] = (a); asm volatile("s_waitcnt lgkmcnt(0)" ::: "memory"); \
    for (int d = 0; d < 4; ++d) for (int r = 0; r < 16; ++r) o[d][r] *= al_l[crow(r, hi)]; } } while (0)
  f32x16 pA0, pA1, pB0, pB1; float mnA, mnB, alA, alB; bf16x8 pa0, pa1, pa2, pa3; const int NT = seq / KVBLK;
  constexpr int SE = 0, SO = SDEPTH - 1;
  SLOAD(SE, 0); asm volatile("s_waitcnt vmcnt(0)" ::: "memory"); SWRITE(0, SE); __syncthreads();
  qkt(pA0, pA1, K_lds, qr, r32, hi); partialSM(pA0, pA1, m_reg, mnA, alA);
  SLOAD(SO, KVBLK); if constexpr (SDEPTH == 2) { if (2 < NT) SLOAD(SE, 2 * KVBLK); }
  SWAIT(); SWRITE(1, SO); __syncthreads();
  for (int j = 1; j + 1 < NT; j += 2) {
    SBAR(); qkt(pB0, pB1, (bf16*)((char*)K_lds + SHM_K), qr, r32, hi);
    finishSM(pA0, pA1, alA, l_reg, pa0, pa1, pa2, pa3); SBAR();
    SLOAD(SO, (j + SDEPTH) * KVBLK); SBAR();
    pv_d0(o, vb0, pa0, pa1, pa2, pa3); partialSM(pB0, pB1, m_reg, mnB, alB);
    __syncthreads(); SWAIT(); SWRITE(0, SE);
    RESC(alB); __syncthreads();
    SBAR(); qkt(pA0, pA1, K_lds, qr, r32, hi);
    finishSM(pB0, pB1, alB, l_reg, pa0, pa1, pa2, pa3); SBAR();
    if (SDEPTH == 1 || j + 3 < NT) SLOAD(SE, (j + 1 + SDEPTH) * KVBLK); SBAR();
    pv_d0(o, vb0 + (int)SHM_V, pa0, pa1, pa2, pa3); partialSM(pA0, pA1, m_reg, mnA, alA);
    __syncthreads(); SWAIT(); SWRITE(1, SO);
    RESC(alA); __syncthreads();
  }
  SBAR(); qkt(pB0, pB1, (bf16*)((char*)K_lds + SHM_K), qr, r32, hi);
  finishSM(pA0, pA1, alA, l_reg, pa0, pa1, pa2, pa3); SBAR();
  pv_d0(o, vb0, pa0, pa1, pa2, pa3); partialSM(pB0, pB1, m_reg, mnB, alB);
  __syncthreads(); RESC(alB);
  finishSM(pB0, pB1, alB, l_reg, pa0, pa1, pa2, pa3); SBAR();
  pv_d0(o, vb0 + (int)SHM_V, pa0, pa1, pa2, pa3);
  if (hi == 0) li_l[r32] = l_reg; asm volatile("s_waitcnt lgkmcnt(0)" ::: "memory");
  float rli[16];
#pragma unroll
  for (int r = 0; r < 16; ++r) rli[r] = __builtin_amdgcn_rcpf(li_l[crow(r, hi)]);
  unsigned short* Ow = Ob + (long)(wid * QBLK) * LDO;
#pragma unroll
  for (int r = 0; r < 16; ++r) { int orow = crow(r, hi);
    for (int d0 = 0; d0 < 4; ++d0) Ow[(long)orow * LDO + d0 * 32 + r32] = f2bf_rne(o[d0][r] * rli[r]); }
#undef SLOAD
#undef SWRITE
#undef SWAIT
#undef RESC
}

}

typedef unsigned short u16;
typedef float f32x4 __attribute__((ext_vector_type(4)));
typedef unsigned u32x4 __attribute__((ext_vector_type(4)));
typedef unsigned u32x2 __attribute__((ext_vector_type(2)));
typedef short s16x8 __attribute__((ext_vector_type(8)));

constexpr int MLAT = 32768, MCTX = 2048, MALL = 34816, FH = 2816, INW = 7712, NMODC = 9216;
constexpr int LDS_BYTES = 147456;
constexpr size_t MiB = 1048576;
constexpr size_t O_WGU1 = 0;
constexpr size_t O_WD1  = O_WGU1 + (size_t)5632 * 1024 * 2;
constexpr size_t O_WGU2 = O_WD1 + (size_t)1024 * 2816 * 2;
constexpr size_t O_WD2  = O_WGU2 + (size_t)5632 * 1024 * 2;
constexpr size_t O_WIN1 = O_WD2 + (size_t)1024 * 2816 * 2;
constexpr size_t O_WIN2 = O_WIN1 + (size_t)3328 * 1024 * 2;
constexpr size_t O_WDN  = O_WIN2 + (size_t)4608 * 1024 * 2;
constexpr size_t O_WAT  = O_WDN + (size_t)1024 * 1024 * 2;
constexpr size_t O_WOUT = O_WAT + (size_t)1024 * 1024 * 2;
constexpr size_t O_MOD  = O_WOUT + (size_t)1024 * 1024 * 2;
static_assert(O_MOD + 9 * 9216 * 4 + 64 <= 55 * MiB + 512 * 1024, "persistent region");
constexpr size_t O_Y1 = 56 * MiB;
constexpr size_t O_A = 124 * MiB;
constexpr size_t O_ACT = 192 * MiB;
constexpr size_t O_QRAW = 192 * MiB, O_KRAW = 260 * MiB, O_REC = 192 * MiB, O_QD = 340 * MiB, O_KD = 408 * MiB, O_BA = 476 * MiB;
constexpr int VD_SPLIT = 20224;
constexpr size_t O_VD1 = 0, O_VD2 = 480 * MiB + 512 * 1024;
static_assert((size_t)VD_SPLIT * 2048 <= O_WIN2 && O_VD2 + (size_t)(MALL - VD_SPLIT) * 2048 <= 512 * MiB && O_VD2 >= O_BA + (size_t)MALL * 32 * 4, "v_d split regions");

constexpr size_t O_QA = 192 * MiB, O_KVA = 256 * MiB, O_GATES = 290 * MiB, O_Z = 418 * MiB;
constexpr size_t O_KALL = 124 * MiB, O_VALL = 141 * MiB;
constexpr size_t O_A3 = O_A, O_T = O_Z, O_Y = O_A, O_A5 = O_QA, O_ACT2 = 256 * MiB, O_Y2 = O_A;
constexpr size_t O_BAR = 55 * MiB + 512 * 1024;
constexpr size_t O_X2B = 440 * MiB;
constexpr size_t WS_NEED = 512 * MiB;
constexpr int REC_BYTES = 17408;

struct Args { const float* in[26]; float* out; unsigned char* ws; };
__device__ __forceinline__ u16* vd_row(unsigned char* ws, int row) { return row < VD_SPLIT ? (u16*)(ws + O_VD1) + (size_t)row * 1024 : (u16*)(ws + O_VD2) + (size_t)(row - VD_SPLIT) * 1024; }

__device__ __forceinline__ float bf_lo(unsigned w) { return __uint_as_float(w << 16); }
__device__ __forceinline__ float bf_hi(unsigned w) { return __uint_as_float(w & 0xffff0000u); }
__device__ __forceinline__ float bf2f(u16 v) { return __uint_as_float(((unsigned)v) << 16); }
__device__ __forceinline__ u16 f2bf(float f) { unsigned u = __float_as_uint(f); u += 0x7FFFu + ((u >> 16) & 1u); return (u16)(u >> 16); }
typedef __bf16 bf16x2_t __attribute__((ext_vector_type(2)));
__device__ __forceinline__ unsigned pk(float lo, float hi) { bf16x2_t v; v[0] = (__bf16)lo; v[1] = (__bf16)hi; return __builtin_bit_cast(unsigned, v); }
__device__ __forceinline__ float silu_f(float v) { return v * __builtin_amdgcn_rcpf(1.f + __expf(-v)); }
__device__ __forceinline__ float sigm_f(float v) { return __builtin_amdgcn_rcpf(1.f + __expf(-v)); }
__device__ __forceinline__ float wave_sum(float v) {
#pragma unroll
    for (int o = 32; o > 0; o >>= 1) v += __shfl_xor(v, o);
    return v; }
__device__ __forceinline__ float grp16_sum(float v) {
#pragma unroll
    for (int o = 8; o > 0; o >>= 1) v += __shfl_xor(v, o);
    return v; }
__device__ __forceinline__ float grp32_sum(float v) {
#pragma unroll
    for (int o = 16; o > 0; o >>= 1) v += __shfl_xor(v, o);
    return v; }
__device__ __forceinline__ f32x4 mfma16(s16x8 a, s16x8 b, f32x4 c) { return __builtin_amdgcn_mfma_f32_16x16x32_bf16(a, b, c, 0, 0, 0); }
__device__ __forceinline__ u32x4 pk8(f32x4 a, f32x4 b) { return (u32x4){pk(a[0], a[1]), pk(a[2], a[3]), pk(b[0], b[1]), pk(b[2], b[3])}; }
__device__ __forceinline__ void unpk8(u32x4 w, f32x4& a, f32x4& b) { a = (f32x4){bf_lo(w.x), bf_hi(w.x), bf_lo(w.y), bf_hi(w.y)}; b = (f32x4){bf_lo(w.z), bf_hi(w.z), bf_lo(w.w), bf_hi(w.w)}; }

__device__ __forceinline__ int map_gu(int n) { const int p = n >> 8, r = n & 255; return r < 128 ? p * 128 + r : 2816 + p * 128 + (r - 128); }
__device__ __forceinline__ int map_in1(int n) { return n < 3072 ? n : (n < 3104 ? 4096 + (n - 3072) : -1); }
__device__ __forceinline__ int map_in2(int n) { return n < 1024 ? 3072 + n : (n < 2048 ? 4128 + (n - 1024) : (n < 2560 ? 5152 + (n - 2048) : 5664 + (n - 2560))); }

template <int MAP> __device__ __forceinline__ void cvt_w(const float* __restrict__ src, int K, int Nsrc, u16* __restrict__ dst, int Np, long gtid, long gthreads) {
    const long total = (long)Np * (K >> 5);
    for (long idx = gtid; idx < total; idx += gthreads) {
        const int np = (int)(idx % Np), kg = (int)(idx / Np);
        const int sc = MAP == 0 ? np : (MAP == 1 ? map_gu(np) : (MAP == 2 ? map_in1(np) : map_in2(np)));
        u32x4 w0 = {0u, 0u, 0u, 0u}, w1 = w0, w2 = w0, w3 = w0;
        if (sc >= 0) {
            const float* p = src + (size_t)(kg * 32) * Nsrc + sc;
            float f[32];
#pragma unroll
            for (int j = 0; j < 32; ++j) f[j] = p[(size_t)j * Nsrc];
            w0 = (u32x4){pk(f[0], f[1]), pk(f[2], f[3]), pk(f[4], f[5]), pk(f[6], f[7])};
            w1 = (u32x4){pk(f[8], f[9]), pk(f[10], f[11]), pk(f[12], f[13]), pk(f[14], f[15])};
            w2 = (u32x4){pk(f[16], f[17]), pk(f[18], f[19]), pk(f[20], f[21]), pk(f[22], f[23])};
            w3 = (u32x4){pk(f[24], f[25]), pk(f[26], f[27]), pk(f[28], f[29]), pk(f[30], f[31])};
        }
        u32x4* d = (u32x4*)(dst + (size_t)np * K + kg * 32);
        d[0] = w0; d[1] = w1; d[2] = w2; d[3] = w3;
    }
}

__device__ __forceinline__ void phase_mod(const Args& a, unsigned char* shm) {
    float* sc = (float*)shm;
    float* red = sc + 9216;
    const float* c = a.in[1]; const float* cc = a.in[3]; const float* wmod = a.in[4]; const float* bmod = a.in[5];
    float* mod = (float*)(a.ws + O_MOD);
    const int tid = tid_opaque();
    for (int i = tid; i < 9216; i += 512) { const int r = i >> 10, k = i & 1023; const float v = r < 8 ? c[r * 1024 + k] : cc[k]; sc[i] = silu_f(v); }
    __syncthreads();
    const int NC = 36, NKG = 14, KPG = 74;
    const int cl = tid % NC, kg = tid / NC; const bool act = tid < NC * NKG;
    for (int task = blockIdx.x; task < NMODC / NC; task += gridDim.x) {
        const int col = task * NC + cl;
        float acc[9];
#pragma unroll
        for (int r = 0; r < 9; ++r) acc[r] = 0.f;
        if (act) {
            const int k0 = kg * KPG, k1 = (k0 + KPG < 1024) ? k0 + KPG : 1024;
            int k = k0;
            for (; k + 16 <= k1; k += 16) { float w[16];
#pragma unroll
                for (int u = 0; u < 16; ++u) w[u] = wmod[(size_t)(k + u) * NMODC + col];
#pragma unroll
                for (int u = 0; u < 16; ++u)
#pragma unroll
                    for (int r = 0; r < 9; ++r) acc[r] += sc[r * 1024 + k + u] * w[u]; }
            for (; k < k1; ++k) { const float w = wmod[(size_t)k * NMODC + col];
#pragma unroll
                for (int r = 0; r < 9; ++r) acc[r] += sc[r * 1024 + k] * w; }
#pragma unroll
            for (int r = 0; r < 9; ++r) red[(kg * 9 + r) * NC + cl] = acc[r];
        }
        __syncthreads();
        if (tid < 9 * NC) { const int r = tid / NC, c2 = tid % NC; float sum = bmod[task * NC + c2];
            for (int g = 0; g < NKG; ++g) sum += red[(g * 9 + r) * NC + c2];
            mod[r * NMODC + task * NC + c2] = sum; }
        __syncthreads();
    }
}

struct Row { f32x4 v[4]; };
__device__ __forceinline__ void ld_row_f32(Row& r, const float* p, int lane) {
#pragma unroll
    for (int i = 0; i < 4; ++i) r.v[i] = *(const f32x4*)(p + 256 * i + 4 * lane); }
__device__ __forceinline__ void st_row_f32(const Row& r, float* p, int lane) {
#pragma unroll
    for (int i = 0; i < 4; ++i) *(f32x4*)(p + 256 * i + 4 * lane) = r.v[i]; }
__device__ __forceinline__ void ld_row_bf(Row& r, const u16* p, int lane) {
#pragma unroll
    for (int i = 0; i < 4; ++i) { const u32x2 u = *(const u32x2*)(p + 256 * i + 4 * lane); r.v[i] = (f32x4){bf_lo(u.x), bf_hi(u.x), bf_lo(u.y), bf_hi(u.y)}; } }
__device__ __forceinline__ void st_row_bf(const Row& r, u16* p, int lane) {
#pragma unroll
    for (int i = 0; i < 4; ++i) { u32x2 u; u.x = pk(r.v[i][0], r.v[i][1]); u.y = pk(r.v[i][2], r.v[i][3]); *(u32x2*)(p + 256 * i + 4 * lane) = u; } }
__device__ __forceinline__ void row_norm(Row& y, const Row& x, const float* g, int lane) {
    float s = 0.f;
#pragma unroll
    for (int i = 0; i < 4; ++i) s += x.v[i][0] * x.v[i][0] + x.v[i][1] * x.v[i][1] + x.v[i][2] * x.v[i][2] + x.v[i][3] * x.v[i][3];
    s = wave_sum(s);
    const float rs = rsqrtf(s * (1.f / 1024.f) + 1e-6f);
#pragma unroll
    for (int i = 0; i < 4; ++i) { const f32x4 gv = *(const f32x4*)(g + 256 * i + 4 * lane); y.v[i] = x.v[i] * rs * gv; } }
__device__ __forceinline__ void row_mod(Row& h, const float* shift, const float* scale, int lane) {
#pragma unroll
    for (int i = 0; i < 4; ++i) { const f32x4 sh = *(const f32x4*)(shift + 256 * i + 4 * lane), sc = *(const f32x4*)(scale + 256 * i + 4 * lane); h.v[i] = h.v[i] * (sc + 1.f) + sh; } }
__device__ __forceinline__ void row_res(Row& x, const Row& t, const float* gate, float w, int lane) {
#pragma unroll
    for (int i = 0; i < 4; ++i) { const f32x4 gv = *(const f32x4*)(gate + 256 * i + 4 * lane); x.v[i] = x.v[i] + gv * t.v[i] * w; } }

__device__ __forceinline__ Row ld_vec(const float* p, int lane) { Row r; ld_row_f32(r, p, lane); return r; }
__device__ __forceinline__ float row_rs(const Row& x) {
    float s = 0.f;
#pragma unroll
    for (int i = 0; i < 4; ++i) s += x.v[i][0] * x.v[i][0] + x.v[i][1] * x.v[i][1] + x.v[i][2] * x.v[i][2] + x.v[i][3] * x.v[i][3];
    s = wave_sum(s);
    return rsqrtf(s * (1.f / 1024.f) + 1e-6f); }
__device__ __forceinline__ void row_norm_r(Row& y, const Row& x, const Row& g) { const float rs = row_rs(x);
#pragma unroll
    for (int i = 0; i < 4; ++i) y.v[i] = x.v[i] * rs * g.v[i]; }
__device__ __forceinline__ void row_mod_r(Row& h, const Row& sh, const Row& sc) {
#pragma unroll
    for (int i = 0; i < 4; ++i) h.v[i] = h.v[i] * (sc.v[i] + 1.f) + sh.v[i]; }
__device__ __forceinline__ void row_res_r(Row& x, const Row& t, const Row& gate, float w) {
#pragma unroll
    for (int i = 0; i < 4; ++i) x.v[i] = x.v[i] + gate.v[i] * t.v[i] * w; }

__device__ __forceinline__ void phase_h1(const Args& a) {
    const int lane = tid_opaque() & 63, gw = blockIdx.x * 8 + (tid_opaque() >> 6), nw = gridDim.x * 8;
    const float* mod = (const float*)(a.ws + O_MOD); u16* A = (u16*)(a.ws + O_A);
    const Row pre = ld_vec(a.in[6], lane);
    { const int b = gw & 7; const float* md = mod + b * NMODC; const Row sh = ld_vec(md, lane), sc = ld_vec(md + 1024, lane);
      for (int j = gw >> 3; j < 4096; j += nw >> 3) { const int row = b * 4096 + j;
        Row xr, h; ld_row_f32(xr, a.in[0] + (size_t)row * 1024, lane); row_norm_r(h, xr, pre); row_mod_r(h, sh, sc); st_row_bf(h, A + (size_t)row * 1024, lane); } }
    { const float* md = mod + 8 * NMODC; const Row sh = ld_vec(md, lane), sc = ld_vec(md + 1024, lane);
      for (int row = MLAT + gw; row < MALL; row += nw) {
        Row xr, h; ld_row_f32(xr, a.in[2] + (size_t)(row - MLAT) * 1024, lane); row_norm_r(h, xr, pre); row_mod_r(h, sh, sc); st_row_bf(h, A + (size_t)row * 1024, lane); } }
}
__device__ __forceinline__ void phase_h2(const Args& a, int row_lo = 0, int row_hi = MALL, int bfirst = 0, int nblk = -1) {
    if (nblk < 0) nblk = gridDim.x;
    if ((int)blockIdx.x < bfirst || (int)blockIdx.x >= bfirst + nblk) return;
    const int lane = tid_opaque() & 63, gw = ((int)blockIdx.x - bfirst) * 8 + (tid_opaque() >> 6), nw = nblk * 8;
    const float* mod = (const float*)(a.ws + O_MOD); u16* A = (u16*)(a.ws + O_A); const u16* Y1 = (const u16*)(a.ws + O_Y1);
    const Row post1 = ld_vec(a.in[7], lane), mixpre = ld_vec(a.in[10], lane);
    if (row_lo < MLAT) { const int b = gw & 7; const float* md = mod + b * NMODC;
      const Row g2 = ld_vec(md + 2 * 1024, lane), sh = ld_vec(md + 3 * 1024, lane), sc = ld_vec(md + 4 * 1024, lane);
      for (int j = gw >> 3; j < 4096; j += nw >> 3) { const int row = b * 4096 + j;
        Row x1, yr, t, h; ld_row_f32(x1, a.in[0] + (size_t)row * 1024, lane); ld_row_bf(yr, Y1 + (size_t)row * 1024, lane);
        row_norm_r(t, yr, post1); row_res_r(x1, t, g2, 0.5f); row_norm_r(h, x1, mixpre); row_mod_r(h, sh, sc); st_row_bf(h, A + (size_t)row * 1024, lane); } }
    if (row_hi > MLAT) { const float* md = mod + 8 * NMODC;
      const Row g2 = ld_vec(md + 2 * 1024, lane), sh = ld_vec(md + 3 * 1024, lane), sc = ld_vec(md + 4 * 1024, lane);
      for (int row = MLAT + gw; row < MALL; row += nw) {
        Row x1, yr, t, h; ld_row_f32(x1, a.in[2] + (size_t)(row - MLAT) * 1024, lane); ld_row_bf(yr, Y1 + (size_t)row * 1024, lane);
        row_norm_r(t, yr, post1); row_res_r(x1, t, g2, 0.5f); row_norm_r(h, x1, mixpre); row_mod_r(h, sh, sc); st_row_bf(h, A + (size_t)row * 1024, lane); } }
}
__device__ __forceinline__ void phase_h3(const Args& a) {
    const int lane = tid_opaque() & 63, gw = blockIdx.x * 8 + (tid_opaque() >> 6), nw = gridDim.x * 8;
    const float* mod = (const float*)(a.ws + O_MOD); u16* A5 = (u16*)(a.ws + O_A5); const u16* Y = (const u16*)(a.ws + O_Y); const u16* Y1 = (const u16*)(a.ws + O_Y1);
    const int b = gw & 7; const float* md = mod + b * NMODC;
    const Row post1 = ld_vec(a.in[7], lane), mixpost = ld_vec(a.in[11], lane), pre2 = ld_vec(a.in[22], lane);
    const Row g2 = ld_vec(md + 2 * 1024, lane), g5 = ld_vec(md + 5 * 1024, lane), sh = ld_vec(md + 6 * 1024, lane), sc = ld_vec(md + 7 * 1024, lane);
    for (int j = gw >> 3; j < 4096; j += nw >> 3) { const int row = b * 4096 + j;
        Row x2, yr, t, h; ld_row_f32(x2, a.in[0] + (size_t)row * 1024, lane); ld_row_bf(yr, Y1 + (size_t)row * 1024, lane);
        row_norm_r(t, yr, post1); row_res_r(x2, t, g2, 0.5f);
        ld_row_bf(yr, Y + (size_t)row * 1024, lane); row_norm_r(t, yr, mixpost); row_res_r(x2, t, g5, 1.0f);
        st_row_bf(x2, (u16*)(a.ws + O_X2B) + (size_t)row * 1024, lane);
        row_norm_r(h, x2, pre2); row_mod_r(h, sh, sc); st_row_bf(h, A5 + (size_t)row * 1024, lane);
    }
}
__device__ __forceinline__ void phase_out(const Args& a) {
    const int lane = tid_opaque() & 63, gw = blockIdx.x * 8 + (tid_opaque() >> 6), nw = gridDim.x * 8;
    const float* mod = (const float*)(a.ws + O_MOD); const u16* Y2 = (const u16*)(a.ws + O_Y2);
    const int b = gw & 7; const Row post2 = ld_vec(a.in[23], lane), g8 = ld_vec(mod + b * NMODC + 8 * 1024, lane);
    for (int j = gw >> 3; j < 4096; j += nw >> 3) { const int row = b * 4096 + j;
        Row x2, yr, t; ld_row_bf(x2, (const u16*)(a.ws + O_X2B) + (size_t)row * 1024, lane); ld_row_bf(yr, Y2 + (size_t)row * 1024, lane); row_norm_r(t, yr, post2); row_res_r(x2, t, g8, 0.5f);
        st_row_f32(x2, a.out + (size_t)row * 1024, lane);
    }
}

struct EpiPlain { static constexpr bool PERM = true, AFTER_DRAIN = false; u16* O; int ldc;
    __device__ __forceinline__ void operator()(const pg8::f32x4 (&acc)[2][2][4][2], const pg8::Unit& u, int wr, int wc, int fr, int fq) const {
        const int row0 = u.pm * 256 + wr * 64 + fr, col0 = u.pn * 256 + wc * 32 + 8 * fq;
#pragma unroll
        for (int ai = 0; ai < 2; ++ai)
#pragma unroll
            for (int m = 0; m < 4; ++m) { u16* rp = O + (size_t)(row0 + ai * 128 + m * 16) * ldc + col0;
#pragma unroll
                for (int bj = 0; bj < 2; ++bj) *(u32x4*)(rp + bj * 128) = pk8(acc[ai][bj][m][0], acc[ai][bj][m][1]); } } };

struct EpiSwiglu { static constexpr bool PERM = true, AFTER_DRAIN = false; u16* O;
    __device__ __forceinline__ void operator()(const pg8::f32x4 (&acc)[2][2][4][2], const pg8::Unit& u, int wr, int wc, int fr, int fq) const {
        const int row0 = u.pm * 256 + wr * 64 + fr, col0 = u.pn * 128 + wc * 32 + 8 * fq;
#pragma unroll
        for (int ai = 0; ai < 2; ++ai)
#pragma unroll
            for (int m = 0; m < 4; ++m) { u16* rp = O + (size_t)(row0 + ai * 128 + m * 16) * FH + col0;
                f32x4 o0, o1;
#pragma unroll
                for (int j = 0; j < 4; ++j) { o0[j] = silu_f(acc[ai][0][m][0][j]) * acc[ai][1][m][0][j]; o1[j] = silu_f(acc[ai][0][m][1][j]) * acc[ai][1][m][1][j]; }
                *(u32x4*)rp = pk8(o0, o1); } } };

struct EpiIn1 { static constexpr bool PERM = true, AFTER_DRAIN = false; u16* q; u16* k; u16* v; float* ba;
    __device__ __forceinline__ void operator()(const pg8::f32x4 (&acc)[2][2][4][2], const pg8::Unit& u, int wr, int wc, int fr, int fq) const {
        const int row0 = u.pm * 256 + wr * 64 + fr;
        if (u.pn < 12) {
            const int t3 = u.pn >> 2;
            u16* base = q + (long)(t3 == 1) * (long)(k - q) + (long)(t3 == 2) * (long)(v - q); const int col0 = (u.pn & 3) * 256 + wc * 32 + 8 * fq;
#pragma unroll
            for (int ai = 0; ai < 2; ++ai)
#pragma unroll
                for (int m = 0; m < 4; ++m) { u16* rp = base + (size_t)(row0 + ai * 128 + m * 16) * 1024 + col0;
#pragma unroll
                    for (int bj = 0; bj < 2; ++bj) *(u32x4*)(rp + bj * 128) = pk8(acc[ai][bj][m][0], acc[ai][bj][m][1]); }
        } else if (wc == 0) {
#pragma unroll
            for (int ai = 0; ai < 2; ++ai)
#pragma unroll
                for (int m = 0; m < 4; ++m) { float* rp = ba + (size_t)(row0 + ai * 128 + m * 16) * 32 + 8 * fq;
                    *(f32x4*)rp = acc[ai][0][m][0]; *(f32x4*)(rp + 4) = acc[ai][0][m][1]; }
        } } };
struct EpiIn2 { static constexpr bool PERM = true, AFTER_DRAIN = false; u16* z; u16* qa; u16* kva; u16* gates;
    __device__ __forceinline__ void operator()(const pg8::f32x4 (&acc)[2][2][4][2], const pg8::Unit& u, int wr, int wc, int fr, int fq) const {
        const int row0 = u.pm * 256 + wr * 64 + fr; const bool lat = u.pm < 128;
        u16* base; int ldc, col0; bool sig = false;
        if (u.pn < 4) { if (!lat) return; base = z; ldc = 1024; col0 = u.pn * 256; }
        else if (u.pn < 8) { if (!lat) return; base = qa; ldc = 1024; col0 = (u.pn - 4) * 256; }
        else if (u.pn < 10) { base = kva; ldc = 512; col0 = (u.pn - 8) * 256; }
        else { if (!lat) return; base = gates; ldc = 2048; col0 = (u.pn - 10) * 256; sig = true; }
        col0 += wc * 32 + 8 * fq;
#pragma unroll
        for (int ai = 0; ai < 2; ++ai)
#pragma unroll
            for (int m = 0; m < 4; ++m) { u16* rp = base + (size_t)(row0 + ai * 128 + m * 16) * ldc + col0;
#pragma unroll
                for (int bj = 0; bj < 2; ++bj) { f32x4 v0 = acc[ai][bj][m][0], v1 = acc[ai][bj][m][1];
                    if (sig) {
#pragma unroll
                        for (int j = 0; j < 4; ++j) { v0[j] = sigm_f(v0[j]); v1[j] = sigm_f(v1[j]); } }
                    *(u32x4*)(rp + bj * 128) = pk8(v0, v1); } } } };

template <int SECOND> struct EpiMerge { static constexpr bool PERM = true, AFTER_DRAIN = false; const u16* gates; u16* T;
    __device__ __forceinline__ void operator()(const pg8::f32x4 (&acc)[2][2][4][2], const pg8::Unit& u, int wr, int wc, int fr, int fq) const {
        const int row0 = u.pm * 256 + wr * 64 + fr, col0 = u.pn * 256 + wc * 32 + 8 * fq;
#pragma unroll
        for (int ai = 0; ai < 2; ++ai)
#pragma unroll
            for (int m = 0; m < 4; ++m) { const size_t row = (size_t)(row0 + ai * 128 + m * 16);
#pragma unroll
                for (int bj = 0; bj < 2; ++bj) { const int col = col0 + bj * 128;
                    const u32x4 gw = *(const u32x4*)(gates + row * 2048 + SECOND * 1024 + col); f32x4 g0, g1; unpk8(gw, g0, g1);
                    f32x4 o0 = g0 * acc[ai][bj][m][0], o1 = g1 * acc[ai][bj][m][1];
#if defined(EXP_ZERO_DN)
                    if (!SECOND) { o0 *= 0.f; o1 *= 0.f; }
#endif
#if defined(EXP_ZERO_AT)
                    if (SECOND) { o0 *= 0.f; o1 *= 0.f; }
#endif
                    if (SECOND) { const u32x4 tw = *(const u32x4*)(T + row * 1024 + col); f32x4 t0, t1; unpk8(tw, t0, t1); o0 += t0; o1 += t1; }
                    *(u32x4*)(T + row * 1024 + col) = pk8(o0, o1); } } } };

template <class Epi> __device__ __forceinline__ void run_gemm(unsigned char* shm, const u16* A, const u16* Bt, int M, int N, int K, const Epi& E) {
    pg8::Gemm g; g.A = A; g.Bt = Bt; g.M = M; g.N = N; g.K = K;
    pg8::StaticOrder S; S.init(M, N, (int)gridDim.x, (int)blockIdx.x);
    pg8::gemm_phase<Epi, pg8::StaticOrder, false>((PG8_LAS unsigned char*)shm, g, S, E, nullptr);
}

__device__ __forceinline__ void phase_dn_prep(const Args& a) {
    const int lane = tid_opaque() & 63, gw = blockIdx.x * 8 + (tid_opaque() >> 6), nw = gridDim.x * 8;
    const u16* raw0 = (const u16*)(a.ws + O_QRAW); const u16* raw1 = (const u16*)(a.ws + O_KRAW); const u16* raw2 = (const u16*)a.out;
    u16* out0 = (u16*)(a.ws + O_QD); u16* out1 = (u16*)(a.ws + O_KD);
    const float* cw = a.in[13];
    for (int row = gw; row < MALL; row += nw) {
        const int pos = row < MLAT ? (row & 4095) : ((row - MLAT) & 255); const int L = row < MLAT ? 4096 : 256;
        const bool hp = pos > 0, hn = pos < L - 1;
#pragma unroll
        for (int i = 0; i < 6; ++i) {
            const int kind = i >> 1, cc = (i & 1) * 512 + 8 * lane, cg_ = kind * 1024 + cc;
            const u16* rp = (kind == 0 ? raw0 : (kind == 1 ? raw1 : raw2)) + (size_t)row * 1024 + cc;
            u16* op = (kind == 0 ? out0 + (size_t)row * 1024 : (kind == 1 ? out1 + (size_t)row * 1024 : vd_row(a.ws, row))) + cc;
            const u32x4 zc = {0u, 0u, 0u, 0u};
            const u32x4 cu = *(const u32x4*)rp; const u32x4 pu = hp ? *(const u32x4*)(rp - 1024) : zc; const u32x4 nu = hn ? *(const u32x4*)(rp + 1024) : zc;
            f32x4 c0, c1, p0, p1, n0, n1; unpk8(cu, c0, c1); unpk8(pu, p0, p1); unpk8(nu, n0, n1);
            const f32x4 wa0 = *(const f32x4*)(cw + cg_), wa1 = *(const f32x4*)(cw + cg_ + 4);
            const f32x4 wb0 = *(const f32x4*)(cw + 3072 + cg_), wb1 = *(const f32x4*)(cw + 3072 + cg_ + 4);
            const f32x4 wc0 = *(const f32x4*)(cw + 6144 + cg_), wc1 = *(const f32x4*)(cw + 6144 + cg_ + 4);
            f32x4 v0 = wa0 * p0 + wb0 * c0 + wc0 * n0, v1 = wa1 * p1 + wb1 * c1 + wc1 * n1;
            float ss = 0.f;
#pragma unroll
            for (int j = 0; j < 4; ++j) { v0[j] = silu_f(v0[j]); v1[j] = silu_f(v1[j]); ss += v0[j] * v0[j] + v1[j] * v1[j]; }
            if (kind < 2) { ss = grp16_sum(ss); const float sc = rsqrtf(ss + 1e-6f) * (kind == 0 ? 0.08838834764831845f : 1.f); v0 *= sc; v1 *= sc; }
            *(u32x4*)op = pk8(v0, v1);
        }
    }
}

__device__ __forceinline__ void phase_dn_pre(const Args& a, unsigned char* shm) {
    const int tid = tid_opaque(), wid = tid >> 6, lane0 = tid & 63;
    float* Lm = (float*)(shm + wid * 17408); float* gcs = Lm + 4096; float* bts = gcs + 64;
    const u16* qd = (const u16*)(a.ws + O_QD); const u16* kd = (const u16*)(a.ws + O_KD); const float* BA = (const float*)(a.ws + O_BA);
    unsigned char* REC = a.ws + O_REC;
    for (int task = blockIdx.x * 8 + wid; task < 8704; task += gridDim.x * 8) {
        int lane = lane0; asm volatile("" : "+v"(lane));
        const int fr = lane & 15, quad = lane >> 4;
        const int c68 = task < 8192 ? 4 + (task & 63) : ((task - 8192) & 3); int tt = task < 8192 ? (task >> 6) : ((task - 8192) >> 2); const int dir = tt & 1; tt >>= 1; const int h = tt & 7; const int b = tt >> 3;
        const int base = c68 < 4 ? MLAT + b * 256 + c68 * 64 : b * 4096 + (c68 - 4) * 64;
        const int tok = dir ? 63 - lane : lane;
        const float* bap = BA + (size_t)(base + tok) * 32;
        const float beta = sigm_f(bap[dir * 8 + h]);
        const float xs = bap[16 + dir * 8 + h] + a.in[15][dir * 8 + h];
        const float sp = fmaxf(xs, 0.f) + log1pf(__expf(-fabsf(xs)));
        const float g = -__expf(a.in[14][dir * 8 + h]) * sp;
        float gc = g;
#pragma unroll
        for (int o = 1; o < 64; o <<= 1) { const float nb = __shfl_up(gc, o); if (lane >= o) gc += nb; }
        const float glast = __shfl(gc, 63);
        asm volatile("s_waitcnt lgkmcnt(0)" ::: "memory");
        gcs[lane] = gc; bts[lane] = beta;
        unsigned char* rec = REC + (size_t)((((b * 8 + h) * 2 + dir) * 68) + c68) * REC_BYTES;
        float* rf = (float*)(rec + 16384);
        rf[lane] = __expf(gc); rf[64 + lane] = __expf(glast - gc); if (lane == 0) rf[128] = __expf(glast);
        asm volatile("s_waitcnt lgkmcnt(0)" ::: "memory");
        s16x8 kf[4][4];
#pragma unroll
        for (int mt = 0; mt < 4; ++mt) { const int r = 16 * mt + fr, tr = dir ? 63 - r : r; const u16* p = kd + (size_t)(base + tr) * 1024 + h * 128 + quad * 8;
#pragma unroll
            for (int kk = 0; kk < 4; ++kk) kf[mt][kk] = *(const s16x8*)(p + kk * 32); }
#pragma unroll
        for (int mt = 0; mt < 4; ++mt)
#pragma unroll
            for (int nt = 0; nt <= mt; ++nt) { f32x4 acc = {0.f, 0.f, 0.f, 0.f};
#pragma unroll
                for (int kk = 0; kk < 4; ++kk) acc = mfma16(kf[mt][kk], kf[nt][kk], acc);
                const int j = 16 * nt + fr; const float gj = gcs[j];
#pragma unroll
                for (int r = 0; r < 4; ++r) { const int i = 16 * mt + quad * 4 + r; Lm[i * 64 + j] = bts[i] * acc[r] * __expf(fminf(gcs[i] - gj, 0.f)); } }
        asm volatile("s_waitcnt lgkmcnt(0)" ::: "memory");
        const int hb = lane >> 5, cb = lane & 31;
        float tcol[32];
#pragma unroll
        for (int ii = 0; ii < 32; ++ii) {
            const float* Lrow = Lm + (32 * hb + ii) * 64 + 32 * hb;
            float s0 = (cb == ii) ? 1.f : 0.f, s1 = 0.f, s2 = 0.f, s3 = 0.f;
#pragma unroll
            for (int j4 = 0; j4 < (ii + 3) / 4; ++j4) { const f32x4 l = *(const f32x4*)(Lrow + j4 * 4);
                if (4 * j4 + 0 < ii) s0 -= l[0] * tcol[4 * j4 + 0];
                if (4 * j4 + 1 < ii) s1 -= l[1] * tcol[4 * j4 + 1];
                if (4 * j4 + 2 < ii) s2 -= l[2] * tcol[4 * j4 + 2];
                if (4 * j4 + 3 < ii) s3 -= l[3] * tcol[4 * j4 + 3]; }
            tcol[ii] = (s0 + s1) + (s2 + s3);
            __builtin_amdgcn_sched_barrier(0);
        }
        unsigned char* imgB = (unsigned char*)Lm;
        { const int m = lane >> 1, k0 = (lane & 1) * 16; const float* src = Lm + (32 + m) * 64 + k0;
          const f32x4 c0 = *(const f32x4*)(src), c1 = *(const f32x4*)(src + 4), c2 = *(const f32x4*)(src + 8), c3 = *(const f32x4*)(src + 12);
          *(u32x4*)(imgB + m * 64 + k0 * 2) = pk8(c0, c1); *(u32x4*)(imgB + m * 64 + k0 * 2 + 16) = pk8(c2, c3); }
        if (hb == 0) {
#pragma unroll
            for (int q = 0; q < 4; ++q) { u32x4 w; w.x = pk(tcol[8 * q], tcol[8 * q + 1]); w.y = pk(tcol[8 * q + 2], tcol[8 * q + 3]); w.z = pk(tcol[8 * q + 4], tcol[8 * q + 5]); w.w = pk(tcol[8 * q + 6], tcol[8 * q + 7]);
                *(u32x4*)(imgB + 2048 + cb * 64 + q * 16) = w; }
        } else {
#pragma unroll
            for (int m = 0; m < 32; ++m) *(u16*)(imgB + 4096 + m * 64 + cb * 2) = f2bf(tcol[m]);
        }
        asm volatile("s_waitcnt lgkmcnt(0)" ::: "memory");
        f32x4 Zb[2][2];
#pragma unroll
        for (int m2 = 0; m2 < 2; ++m2)
#pragma unroll
            for (int n2 = 0; n2 < 2; ++n2) { const f32x4 z0 = {0.f, 0.f, 0.f, 0.f};
                Zb[m2][n2] = mfma16(*(const s16x8*)(imgB + (16 * m2 + fr) * 64 + quad * 16), *(const s16x8*)(imgB + 2048 + (16 * n2 + fr) * 64 + quad * 16), z0); }
#pragma unroll
        for (int m2 = 0; m2 < 2; ++m2)
#pragma unroll
            for (int n2 = 0; n2 < 2; ++n2) { u32x2 w; w.x = pk(Zb[m2][n2][0], Zb[m2][n2][1]); w.y = pk(Zb[m2][n2][2], Zb[m2][n2][3]);
                *(u32x2*)(imgB + 6144 + (16 * n2 + fr) * 64 + (16 * m2 + 4 * quad) * 2) = w; }
        asm volatile("s_waitcnt lgkmcnt(0)" ::: "memory");
        f32x4 T21[2][2];
#pragma unroll
        for (int m2 = 0; m2 < 2; ++m2)
#pragma unroll
            for (int n2 = 0; n2 < 2; ++n2) { const f32x4 z0 = {0.f, 0.f, 0.f, 0.f};
                T21[m2][n2] = mfma16(*(const s16x8*)(imgB + 4096 + (16 * m2 + fr) * 64 + quad * 16), *(const s16x8*)(imgB + 6144 + (16 * n2 + fr) * 64 + quad * 16), z0); }
        u16* img = (u16*)Lm;
        asm volatile("s_waitcnt lgkmcnt(0)" ::: "memory");
#pragma unroll
        for (int ii = 0; ii < 32; ++ii) img[4096 + (32 * hb + ii) * 64 + lane] = f2bf(tcol[ii] * beta);
        if (hb == 1) {
#pragma unroll
            for (int ii = 0; ii < 32; ++ii) img[4096 + ii * 64 + lane] = 0; }
#pragma unroll
        for (int m2 = 0; m2 < 2; ++m2)
#pragma unroll
            for (int n2 = 0; n2 < 2; ++n2) { const int col = 16 * n2 + fr; const float bc = bts[col];
#pragma unroll
                for (int r = 0; r < 4; ++r) img[4096 + (32 + 16 * m2 + 4 * quad + r) * 64 + col] = f2bf(-T21[m2][n2][r] * bc); }
        if (c68 >= 4)
#pragma unroll
        for (int mt = 0; mt < 4; ++mt) { const int r_ = 16 * mt + fr, tr = dir ? 63 - r_ : r_; const u16* p = qd + (size_t)(base + tr) * 1024 + h * 128 + quad * 8;
            s16x8 qf[4];
#pragma unroll
            for (int kk = 0; kk < 4; ++kk) qf[kk] = *(const s16x8*)(p + kk * 32);
#pragma unroll
            for (int nt = 0; nt < 4; ++nt) { const int j = 16 * nt + fr;
                if (nt <= mt) { f32x4 acc = {0.f, 0.f, 0.f, 0.f};
#pragma unroll
                    for (int kk = 0; kk < 4; ++kk) acc = mfma16(qf[kk], kf[nt][kk], acc);
                    const float gj = gcs[j];
#pragma unroll
                    for (int r = 0; r < 4; ++r) { const int i = 16 * mt + quad * 4 + r; const float v = (j <= i) ? acc[r] * __expf(fminf(gcs[i] - gj, 0.f)) : 0.f; img[i * 64 + j] = f2bf(v); }
                } else {
#pragma unroll
                    for (int r = 0; r < 4; ++r) { const int i = 16 * mt + quad * 4 + r; img[i * 64 + j] = 0; } } } }
        asm volatile("s_waitcnt lgkmcnt(0)" ::: "memory");
        { const u32x4* src = (const u32x4*)Lm; u32x4* dst = (u32x4*)rec;
#pragma unroll
            for (int q = 0; q < 8; ++q) { dst[q * 64 + lane] = src[512 + q * 64 + lane]; dst[512 + q * 64 + lane] = src[q * 64 + lane]; } }
    }
}

__device__ __forceinline__ void phase_dn_scan(const Args& a, unsigned char* shm) {
    const int tid = tid_opaque(), wid = tid >> 6, lane = tid & 63, fr = lane & 15, quad = lane >> 4, r32 = lane & 31, hi = lane >> 5;
    unsigned char* ST = shm; unsigned char* KV = shm + 17408; unsigned char* RT = KV + 16384; unsigned char* VN = RT + 9216; unsigned char* VS = VN + 9216;
    unsigned char* KR = VS + 9216; unsigned char* QR = KR + 17408;
    const int mt = wid & 3, ng = wid >> 2, mtS = wid & 1, D0 = wid >> 1;
    const int sr = tid >> 4, sc = (tid & 15) * 8, vst0 = at::v_st(sr, sc), vst1 = at::v_st(32 + sr, sc);
    const int vb0 = (int)(uintptr_t)KV + at::v_rd_base(lane);
    const u16* qd = (const u16*)(a.ws + O_QD); const u16* kd = (const u16*)(a.ws + O_KD);
    const unsigned char* REC = a.ws + O_REC;
    for (int task = blockIdx.x; task < 256; task += gridDim.x) {
        const int half = task & 1, dir = (task >> 1) & 1, h = (task >> 2) & 7, b = task >> 5;
        u16* Od = (u16*)a.out + (dir ? (size_t)MLAT * 1024 : (size_t)0);
        at::f32x16 sT;
#pragma unroll
        for (int r = 0; r < 16; ++r) sT[r] = 0.f;
        const int irow = 16 * mt + fr, i0 = 16 * mt + quad * 4;
        const int dv0 = 32 * ng + fr, dv1 = dv0 + 16;
        const int trow = dir ? 63 - irow : irow, t0 = dir ? 63 - sr : sr, t1 = dir ? 31 - sr : 32 + sr;
        const int hoff = h * 128;
#define SCAN_C68(n_) ((n_) < 4 ? (dir ? 3 - (n_) : (n_)) : (dir ? 71 - (n_) : (n_)))
#define SCAN_BASE(c_) ((c_) < 4 ? MLAT + b * 256 + (c_) * 64 : b * 4096 + ((c_) - 4) * 64)
#define SCAN_REC(c_) (REC + (size_t)((((b * 8 + h) * 2 + dir) * 68) + (c_)) * REC_BYTES)
        s16x8 K0, K1, Q0, Q1, TB[2], IN[2]; f32x4 EG, EK, V0, V1; float DCH;
        const unsigned oK0 = (unsigned)(t0 * 1024 + hoff + sc), oK1 = (unsigned)(t1 * 1024 + hoff + sc), oA = (unsigned)(trow * 1024 + hoff + quad * 8), oT = (unsigned)(irow * 64 + quad * 8);
        unsigned oV[4];
#pragma unroll
        for (int r = 0; r < 4; ++r) oV[r] = (unsigned)((dir ? 63 - (i0 + r) : (i0 + r)) * 1024 + hoff + half * 64 + dv0);
#define LD_K(base_)   do { const u16* kb_ = kd + (size_t)(base_) * 1024; const u16* qb_ = qd + (size_t)(base_) * 1024; K0 = *(const s16x8*)(kb_ + oK0); K1 = *(const s16x8*)(kb_ + oK1); Q0 = *(const s16x8*)(qb_ + oK0); Q1 = *(const s16x8*)(qb_ + oK1); } while (0)
#define LD_A(base_)   do { const u16* vb_ = vd_row(a.ws, (base_)); \
        _Pragma("unroll") for (int r = 0; r < 4; ++r) { V0[r] = bf2f(vb_[oV[r]]); V1[r] = bf2f(vb_[oV[r] + 16]); } } while (0)
#define LD_TB(rec_)   do { const u16* p_ = (const u16*)(rec_) + oT; TB[0] = *(const s16x8*)p_; TB[1] = *(const s16x8*)(p_ + 32); EK = *(const f32x4*)((const float*)((rec_) + 16384) + 64 + i0); } while (0)
#define LD_IN(rec_)   do { const u16* p_ = (const u16*)((rec_) + 8192) + oT; IN[0] = *(const s16x8*)p_; IN[1] = *(const s16x8*)(p_ + 32); } while (0)
#define LD_EG(rec_)   do { EG = *(const f32x4*)((const float*)((rec_) + 16384) + i0); } while (0)
#define LD_D(rec_)    do { DCH = ((const float*)((rec_) + 16384))[128]; } while (0)
        { const int c0 = SCAN_C68(0); const int bs = SCAN_BASE(c0); const unsigned char* rc = SCAN_REC(c0);
          LD_K(bs); LD_A(bs); LD_TB(rc); LD_IN(rc); LD_EG(rc); LD_D(rc); }
        for (int n = 0; n < 68; ++n) {
            const int c68 = SCAN_C68(n);
            const int base = SCAN_BASE(c68);
            const int nn = n < 67 ? n + 1 : 67; const int c68n = SCAN_C68(nn); const int basen = SCAN_BASE(c68n); const unsigned char* recn = SCAN_REC(c68n);
#pragma unroll
            for (int r = 0; r < 16; ++r) *(u16*)(ST + (32 * mtS + at::crow(r, hi)) * 272 + (32 * D0 + r32) * 2) = f2bf(sT[r]);
            *(s16x8*)(KV + vst0) = K0; *(s16x8*)(KV + vst1) = K1;
            *(s16x8*)(KR + sr * 272 + sc * 2) = K0; *(s16x8*)(KR + (32 + sr) * 272 + sc * 2) = K1;
            *(s16x8*)(QR + sr * 272 + sc * 2) = Q0; *(s16x8*)(QR + (32 + sr) * 272 + sc * 2) = Q1;
            LD_K(basen);
            __syncthreads();
            f32x4 KS0 = {0.f, 0.f, 0.f, 0.f}, KS1 = KS0, QS0 = KS0, QS1 = KS0;
#pragma unroll
            for (int kk = 0; kk < 4; ++kk) {
                const s16x8 b0 = *(const s16x8*)(ST + dv0 * 272 + (kk * 32 + quad * 8) * 2), b1 = *(const s16x8*)(ST + dv1 * 272 + (kk * 32 + quad * 8) * 2);
                const s16x8 ak = *(const s16x8*)(KR + irow * 272 + (kk * 32 + quad * 8) * 2), aq = *(const s16x8*)(QR + irow * 272 + (kk * 32 + quad * 8) * 2);
                KS0 = mfma16(ak, b0, KS0); KS1 = mfma16(ak, b1, KS1); QS0 = mfma16(aq, b0, QS0); QS1 = mfma16(aq, b1, QS1);
            }
            {
                const f32x4 r0 = V0 - EG * KS0, r1 = V1 - EG * KS1;
                u32x2 w0, w1; w0.x = pk(r0[0], r0[1]); w0.y = pk(r0[2], r0[3]); w1.x = pk(r1[0], r1[1]); w1.y = pk(r1[2], r1[3]);
                *(u32x2*)(RT + dv0 * 144 + i0 * 2) = w0; *(u32x2*)(RT + dv1 * 144 + i0 * 2) = w1;
            }
            LD_A(basen);
            __syncthreads();
            f32x4 N0 = {0.f, 0.f, 0.f, 0.f}, N1 = N0;
            {
#pragma unroll
                for (int kk = 0; kk < 2; ++kk) {
                    const s16x8 b0 = *(const s16x8*)(RT + dv0 * 144 + (kk * 32 + quad * 8) * 2), b1 = *(const s16x8*)(RT + dv1 * 144 + (kk * 32 + quad * 8) * 2);
                    N0 = mfma16(TB[kk], b0, N0); N1 = mfma16(TB[kk], b1, N1); }
                u32x2 w0, w1; w0.x = pk(N0[0], N0[1]); w0.y = pk(N0[2], N0[3]); w1.x = pk(N1[0], N1[1]); w1.y = pk(N1[2], N1[3]);
                *(u32x2*)(VN + dv0 * 144 + i0 * 2) = w0; *(u32x2*)(VN + dv1 * 144 + i0 * 2) = w1;
                const f32x4 s0 = N0 * EK, s1 = N1 * EK;
                w0.x = pk(s0[0], s0[1]); w0.y = pk(s0[2], s0[3]); w1.x = pk(s1[0], s1[1]); w1.y = pk(s1[2], s1[3]);
                *(u32x2*)(VS + dv0 * 144 + i0 * 2) = w0; *(u32x2*)(VS + dv1 * 144 + i0 * 2) = w1;
            }
            LD_TB(recn);
            __syncthreads();
            {
                f32x4 O0 = QS0 * EG, O1 = QS1 * EG;
#pragma unroll
                for (int kk = 0; kk < 2; ++kk) {
                    const s16x8 b0 = *(const s16x8*)(VN + dv0 * 144 + (kk * 32 + quad * 8) * 2), b1 = *(const s16x8*)(VN + dv1 * 144 + (kk * 32 + quad * 8) * 2);
                    O0 = mfma16(IN[kk], b0, O0); O1 = mfma16(IN[kk], b1, O1); }
                if (n >= 4) {
#pragma unroll
                    for (int r = 0; r < 4; ++r) { u16* op = Od + (size_t)base * 1024 + oV[r];
                        op[0] = f2bf(O0[r]); op[16] = f2bf(O1[r]); } }
            }
            LD_IN(recn); LD_EG(recn);
            {
#pragma unroll
                for (int r = 0; r < 16; ++r) sT[r] *= DCH;
                LD_D(recn);
                const unsigned char* vsp = VS + (32 * mtS + r32) * 144 + (8 * hi) * 2;
                const at::bf16x8 pa0 = *(const at::bf16x8*)(vsp), pa1 = *(const at::bf16x8*)(vsp + 32), pa2 = *(const at::bf16x8*)(vsp + 64), pa3 = *(const at::bf16x8*)(vsp + 96);
                if (D0 == 0) at::pv_one<0>(sT, vb0, pa0, pa1, pa2, pa3);
                else if (D0 == 1) at::pv_one<1>(sT, vb0, pa0, pa1, pa2, pa3);
                else if (D0 == 2) at::pv_one<2>(sT, vb0, pa0, pa1, pa2, pa3);
                else at::pv_one<3>(sT, vb0, pa0, pa1, pa2, pa3);
            }
            __syncthreads();
        }
#undef LD_K
#undef LD_A
#undef LD_TB
#undef LD_IN
#undef LD_EG
#undef LD_D
#undef SCAN_C68
#undef SCAN_BASE
#undef SCAN_REC
    }
}

#if defined(EXP_NAIVE_DN)
__device__ __forceinline__ void phase_dn_naive(const Args& a, unsigned char* shm) {
    const int tid = tid_opaque(), dvl = tid & 63, kg = tid >> 6;
    float* red = (float*)shm;
    const u16* qd = (const u16*)(a.ws + O_QD); const u16* kd = (const u16*)(a.ws + O_KD); const u16* vd = (const u16*)(a.ws + O_VD1); const float* BA = (const float*)(a.ws + O_BA);
    for (int task = blockIdx.x; task < 256; task += gridDim.x) {
        const int half = task & 1, dir = (task >> 1) & 1, h = (task >> 2) & 7, b = task >> 5;
#if defined(EXP_HYBRID)
        if (!(EXP_HYBRID)) continue;
#endif
        u16* Od = (u16*)a.out + (dir ? (size_t)MLAT * 1024 : (size_t)0);
        float S[16];
#pragma unroll
        for (int e = 0; e < 16; ++e) S[e] = 0.f;
        const float alog = a.in[14][dir * 8 + h], dtb = a.in[15][dir * 8 + h];
        for (int n = 0; n < 4352; ++n) {
            int row; if (n < 256) { const int t = dir ? 255 - n : n; row = MLAT + b * 256 + t; } else { const int t = dir ? 4095 - (n - 256) : (n - 256); row = b * 4096 + t; }
            const float* bap = BA + (size_t)row * 32;
            const float beta = sigm_f(bap[dir * 8 + h]);
            const float xs = bap[16 + dir * 8 + h] + dtb;
            const float g = -__expf(alog) * (fmaxf(xs, 0.f) + log1pf(__expf(-fabsf(xs))));
            const float eg = __expf(g);
            const u16* kp = kd + (size_t)row * 1024 + h * 128 + kg * 16; const u16* qp = qd + (size_t)row * 1024 + h * 128 + kg * 16;
            float kk[16], qq[16];
#pragma unroll
            for (int e = 0; e < 16; ++e) { kk[e] = bf2f(kp[e]); qq[e] = bf2f(qp[e]); }
            const float v = bf2f(vd[(size_t)row * 1024 + h * 128 + half * 64 + dvl]);
            float ps = 0.f;
#pragma unroll
            for (int e = 0; e < 16; ++e) { S[e] *= eg; ps += kk[e] * S[e]; }
            red[kg * 64 + dvl] = ps;
            __syncthreads();
            float ks = 0.f;
#pragma unroll
            for (int g8 = 0; g8 < 8; ++g8) ks += red[g8 * 64 + dvl];
            __syncthreads();
            const float delta = beta * (v - ks);
            float po = 0.f;
#pragma unroll
            for (int e = 0; e < 16; ++e) { S[e] += kk[e] * delta; po += qq[e] * S[e]; }
            red[kg * 64 + dvl] = po;
            __syncthreads();
            if (n >= 256 && kg == 0) { float o = 0.f;
#pragma unroll
                for (int g8 = 0; g8 < 8; ++g8) o += red[g8 * 64 + dvl];
                Od[(size_t)row * 1024 + h * 128 + half * 64 + dvl] = f2bf(o); }
            __syncthreads();
        }
    }
}
#endif


#if defined(EXP_VALU_SCAN)
#define BR(x) bf2f(f2bf(x))
__device__ __forceinline__ void phase_dn_scan_valu(const Args& a, unsigned char* shm) {
    const int tid = tid_opaque(), dvl = tid & 63, rg = tid >> 6;
    float* S = (float*)shm; float* kc = S + 8192; float* qc = kc + 8192; float* rr = qc + 8192; float* vn = rr + 4096;
    const u16* qd = (const u16*)(a.ws + O_QD); const u16* kd = (const u16*)(a.ws + O_KD);
    const unsigned char* REC = a.ws + O_REC;
    for (int task = blockIdx.x; task < 256; task += gridDim.x) {
        const int half = task & 1, dir = (task >> 1) & 1, h = (task >> 2) & 7, b = task >> 5;
        u16* Od = (u16*)a.out + (dir ? (size_t)MLAT * 1024 : (size_t)0);
        for (int i = tid; i < 8192; i += 512) S[i] = 0.f;
        __syncthreads();
        for (int n = 0; n < 68; ++n) {
            const int c68 = n < 4 ? (dir ? 3 - n : n) : (dir ? 71 - n : n);
            const int base = c68 < 4 ? MLAT + b * 256 + c68 * 64 : b * 4096 + (c68 - 4) * 64;
            const unsigned char* rec = REC + (size_t)((((b * 8 + h) * 2 + dir) * 68) + c68) * REC_BYTES;
            const u16* Tb = (const u16*)rec; const u16* In = (const u16*)(rec + 8192); const float* rf = (const float*)(rec + 16384);
            for (int i = tid; i < 8192; i += 512) { const int p = i >> 7, dk = i & 127, t = dir ? 63 - p : p;
                kc[i] = bf2f(kd[(size_t)(base + t) * 1024 + h * 128 + dk]); qc[i] = bf2f(qd[(size_t)(base + t) * 1024 + h * 128 + dk]); }
            __syncthreads();
            float QS[8];
#pragma unroll
            for (int m = 0; m < 8; ++m) { const int i = rg + 8 * m, t = dir ? 63 - i : i; float ks = 0.f, qs = 0.f;
                for (int dk = 0; dk < 128; ++dk) { const float sv = BR(S[dk * 64 + dvl]); ks += kc[i * 128 + dk] * sv; qs += qc[i * 128 + dk] * sv; }
                QS[m] = qs; rr[i * 64 + dvl] = BR(bf2f(vd[(size_t)(base + t) * 1024 + h * 128 + half * 64 + dvl]) - rf[i] * ks); }
            __syncthreads();
#pragma unroll
            for (int m = 0; m < 8; ++m) { const int i = rg + 8 * m; float s = 0.f;
                for (int j = 0; j < 64; ++j) s += bf2f(Tb[i * 64 + j]) * rr[j * 64 + dvl];
                vn[i * 64 + dvl] = s; }
            __syncthreads();
#pragma unroll
            for (int m = 0; m < 8; ++m) { const int i = rg + 8 * m, t = dir ? 63 - i : i; float s = rf[i] * QS[m];
                for (int j = 0; j < 64; ++j) s += bf2f(In[i * 64 + j]) * BR(vn[j * 64 + dvl]);
                if (n >= 4) Od[(size_t)(base + t) * 1024 + h * 128 + half * 64 + dvl] = f2bf(s); }
            { const float d = rf[128];
#pragma unroll
                for (int e = 0; e < 16; ++e) { const int dk = rg * 16 + e; float s = d * S[dk * 64 + dvl];
                    for (int t = 0; t < 64; ++t) s += kc[t * 128 + dk] * BR(rf[64 + t] * vn[t * 64 + dvl]);
                    S[dk * 64 + dvl] = s; } }
            __syncthreads();
        }
    }
}
#endif

__device__ __forceinline__ void rope8(f32x4& v0, f32x4& v1, const f32x4 p0, const f32x4 p1, bool second, float pos, int f0) {
#pragma unroll
    for (int j = 0; j < 8; ++j) {
        const float invf = exp2f(-(float)(f0 + j) * (13.287712379549449f / 32.f));
        const float ang = pos * invf; const float c = __cosf(ang), s = __sinf(ang);
        const float mine = j < 4 ? v0[j & 3] : v1[j & 3], other = j < 4 ? p0[j & 3] : p1[j & 3];
        const float o = second ? (mine * c + other * s) : (mine * c - other * s);
        if (j < 4) v0[j & 3] = o; else v1[j & 3] = o;
    }
}
__device__ __forceinline__ void phase_attn_prep(const Args& a) {
    const int lane = tid_opaque() & 63, gw = blockIdx.x * 8 + (tid_opaque() >> 6), nw = gridDim.x * 8;
    u16* QA = (u16*)(a.ws + O_QA); const u16* KVA = (const u16*)(a.ws + O_KVA); u16* KALL = (u16*)(a.ws + O_KALL); u16* VALL = (u16*)(a.ws + O_VALL);
    const float* qn = a.in[18]; const float* kn = a.in[19];
    for (int row = gw; row < MALL; row += nw) {
        const bool lat = row < MLAT;
        const int t = lat ? (row & 4095) : ((row - MLAT) & 255); const int b = lat ? (row >> 12) : ((row - MLAT) >> 8);
        {
            const u16* kp = KVA + (size_t)row * 512 + 4 * lane;
            const u32x2 ku = *(const u32x2*)kp; const u32x2 vu = *(const u32x2*)(kp + 256);
            f32x4 kv = (f32x4){bf_lo(ku.x), bf_hi(ku.x), bf_lo(ku.y), bf_hi(ku.y)};
            const int d = 4 * (lane & 31);
            float ss = kv[0] * kv[0] + kv[1] * kv[1] + kv[2] * kv[2] + kv[3] * kv[3];
            ss = grp32_sum(ss); const float rs = rsqrtf(ss * (1.f / 128.f) + 1e-6f);
            kv = kv * rs * *(const f32x4*)(kn + d);
            f32x4 pp;
#pragma unroll
            for (int j = 0; j < 4; ++j) pp[j] = __shfl_xor(kv[j], 8);
            if (lat) { const bool second = (lane >> 3) & 1; const int axis = (lane >> 4) & 1; const float pos = axis ? (float)(t & 63) : (float)(t >> 6);
#pragma unroll
                for (int j = 0; j < 4; ++j) { const float invf = exp2f(-(float)((d & 31) + j) * (13.287712379549449f / 32.f)); const float ang = pos * invf; const float c = __cosf(ang), s = __sinf(ang);
                    kv[j] = second ? (kv[j] * c + pp[j] * s) : (kv[j] * c - pp[j] * s); } }
            const size_t orow = (size_t)b * 4352 + (lat ? 256 + t : t);
            u32x2 ko; ko.x = pk(kv[0], kv[1]); ko.y = pk(kv[2], kv[3]);
            *(u32x2*)(KALL + orow * 256 + 4 * lane) = ko; *(u32x2*)(VALL + orow * 256 + 4 * lane) = vu;
        }
    }
}

__device__ __forceinline__ void phase_attn(const Args& a, unsigned char* shm) {
    u16* QA = (u16*)(a.ws + O_QA); const u16* KALL = (const u16*)(a.ws + O_KALL); const u16* VALL = (const u16*)(a.ws + O_VALL);
    const int nblk = gridDim.x;
    for (int it = 0;; ++it) {
        int task;
        if (nblk == 256) { if (it >= 4) break; const int xcd = blockIdx.x & 7, slot = blockIdx.x >> 3; const int tix = it * 32 + slot; task = (xcd * 2 + (tix >> 6)) * 64 + (tix & 63); }
        else { task = blockIdx.x + it * nblk; if (task >= 1024) break; }
        const int grp = task >> 6, within = task & 63, b = grp >> 1, kvh = grp & 1, qb = within >> 2, g = within & 3, head = kvh * 4 + g;
        u16* Qb = QA + ((size_t)b * 4096 + qb * 256) * 1024 + head * 128;
        const u16* Kh = KALL + (size_t)b * 4352 * 256 + kvh * 128; const u16* Vh = VALL + (size_t)b * 4352 * 256 + kvh * 128;
        at::attn_dense_body<at::bf16>((const at::bf16*)Qb, (const at::bf16*)Kh, (const at::bf16*)Vh, Qb, 4352, (char*)shm, qb * 256, a.in[18]);
        __syncthreads();
    }
}

__device__ __forceinline__ void phase_merge_prep(const Args& a) {
    const int lane = tid_opaque() & 63, gw = blockIdx.x * 8 + (tid_opaque() >> 6), nw = gridDim.x * 8;
    const u16* OF = (const u16*)a.out; const u16* OB = OF + (size_t)MLAT * 1024; const u16* Z = (const u16*)(a.ws + O_Z); u16* A3 = (u16*)(a.ws + O_A3);
    const float* dnn = a.in[16];
    const int d = 8 * (lane & 15); const f32x4 g0 = *(const f32x4*)(dnn + d), g1 = *(const f32x4*)(dnn + d + 4);
    for (int row = gw; row < MLAT; row += nw) {
#pragma unroll
        for (int i = 0; i < 2; ++i) { const size_t off = (size_t)row * 1024 + 512 * i + 8 * lane;
            f32x4 f0, f1, b0, b1, z0, z1; unpk8(*(const u32x4*)(OF + off), f0, f1); unpk8(*(const u32x4*)(OB + off), b0, b1); unpk8(*(const u32x4*)(Z + off), z0, z1);
            f0 += b0; f1 += b1;
            float ss = 0.f;
#pragma unroll
            for (int j = 0; j < 4; ++j) ss += f0[j] * f0[j] + f1[j] * f1[j];
            ss = grp16_sum(ss); const float rs = rsqrtf(ss * (1.f / 128.f) + 1e-6f);
#pragma unroll
            for (int j = 0; j < 4; ++j) { f0[j] = f0[j] * rs * g0[j] * silu_f(z0[j]); f1[j] = f1[j] * rs * g1[j] * silu_f(z1[j]); }
            *(u32x4*)(A3 + off) = pk8(f0, f1); }
    }
}

__global__ void __launch_bounds__(512, 2) fwd_megakernel(Args a) {
    extern __shared__ __attribute__((aligned(16))) unsigned char shm[];
    cg::grid_group grid = cg::this_grid();
    volatile LAS unsigned* xst = (volatile LAS unsigned*)(shm + LDS_BYTES - 16);
    if (threadIdx.x == 0) { xst[0] = 0u; xst[1] = 0u; }
    __syncthreads();
    const xb::XcdBarrier XB = xb::xcd_barrier_post((unsigned*)(a.ws + O_BAR), xst);
#define GSYNC() xb::xcd_barrier(XB)
    unsigned char* ws = a.ws;
    const long gtid = (long)blockIdx.x * 512 + threadIdx.x, gth = (long)gridDim.x * 512;
    cvt_w<1>(a.in[8], 1024, 5632, (u16*)(ws + O_WGU1), 5632, gtid, gth);
    phase_mod(a, shm);
#if defined(EXP_SELFCHK)
    if (blockIdx.x == 0 && threadIdx.x == 0) *(unsigned*)(ws + O_MOD + 9 * 9216 * 4) = 0u;
#endif
    grid.sync();
    phase_h1(a);
    GSYNC();
    { EpiSwiglu E; E.O = (u16*)(ws + O_ACT); run_gemm(shm, (const u16*)(ws + O_A), (const u16*)(ws + O_WGU1), MALL, 5632, 1024, E); }
    { const int G = gridDim.x, rem = ((MALL / 256) * 22) % G;
      if (rem == 0 || (int)blockIdx.x >= rem) { const int f = rem == 0 ? 0 : rem; const long gt = (long)((int)blockIdx.x - f) * 512 + threadIdx.x, gn = (long)(G - f) * 512;
        cvt_w<0>(a.in[9], 2816, 1024, (u16*)(ws + O_WD1), 1024, gt, gn);
        cvt_w<2>(a.in[12], 1024, INW, (u16*)(ws + O_WIN1), 3328, gt, gn); } }
    GSYNC();
    { EpiPlain E; E.O = (u16*)(ws + O_Y1); E.ldc = 1024; run_gemm(shm, (const u16*)(ws + O_ACT), (const u16*)(ws + O_WD1), MLAT, 1024, 2816, E); }
    GSYNC();
    { EpiPlain E; E.O = (u16*)(ws + O_Y1) + (size_t)MLAT * 1024; E.ldc = 1024; run_gemm(shm, (const u16*)(ws + O_ACT) + (size_t)MLAT * FH, (const u16*)(ws + O_WD1), MCTX, 1024, 2816, E); }
    { const int G = gridDim.x, f = G > 32 ? 32 : 0;
      if ((int)blockIdx.x >= f) { const long gt = (long)((int)blockIdx.x - f) * 512 + threadIdx.x, gn = (long)(G - f) * 512;
        cvt_w<3>(a.in[12], 1024, INW, (u16*)(ws + O_WIN2), 4608, gt, gn); }
      phase_h2(a, 0, MLAT, f, G - f); }
    GSYNC();
    phase_h2(a, MLAT, MALL);
    GSYNC();
    { EpiIn1 E; E.q = (u16*)(ws + O_QRAW); E.k = (u16*)(ws + O_KRAW); E.v = (u16*)a.out; E.ba = (float*)(ws + O_BA); run_gemm(shm, (const u16*)(ws + O_A), (const u16*)(ws + O_WIN1), MALL, 3328, 1024, E); }
    GSYNC();
    phase_dn_prep(a);
    GSYNC();
#if defined(EXP_NAIVE_DN) && !defined(EXP_HYBRID)
    phase_dn_naive(a, shm);
#else
    phase_dn_pre(a, shm);
    GSYNC();
#if defined(EXP_VALU_SCAN)
    phase_dn_scan_valu(a, shm);
#else
    phase_dn_scan(a, shm);
#endif
#if defined(EXP_HYBRID)
    GSYNC();
    phase_dn_naive(a, shm);
#endif
#endif
    GSYNC();
    { EpiIn2 E; E.z = (u16*)(ws + O_Z); E.qa = (u16*)(ws + O_QA); E.kva = (u16*)(ws + O_KVA); E.gates = (u16*)(ws + O_GATES); run_gemm(shm, (const u16*)(ws + O_A), (const u16*)(ws + O_WIN2), MALL, 4608, 1024, E); }
    { const int G = gridDim.x, rem = ((MALL / 256) * 18) % G;
      if (rem == 0 || (int)blockIdx.x >= rem) { const int f = rem == 0 ? 0 : rem; const long gt = (long)((int)blockIdx.x - f) * 512 + threadIdx.x, gn = (long)(G - f) * 512;
        cvt_w<0>(a.in[17], 1024, 1024, (u16*)(ws + O_WDN), 1024, gt, gn);
        cvt_w<0>(a.in[20], 1024, 1024, (u16*)(ws + O_WAT), 1024, gt, gn);
        cvt_w<0>(a.in[21], 1024, 1024, (u16*)(ws + O_WOUT), 1024, gt, gn);
        cvt_w<1>(a.in[24], 1024, 5632, (u16*)(ws + O_WGU2), 5632, gt, gn);
        cvt_w<0>(a.in[25], 2816, 1024, (u16*)(ws + O_WD2), 1024, gt, gn); } }
    GSYNC();
    phase_attn_prep(a);
    GSYNC();
    phase_attn(a, shm);
    GSYNC();
    phase_merge_prep(a);
    GSYNC();
    { EpiMerge<0> E; E.gates = (const u16*)(ws + O_GATES); E.T = (u16*)(ws + O_T); run_gemm(shm, (const u16*)(ws + O_A3), (const u16*)(ws + O_WDN), MLAT, 1024, 1024, E); }
    { EpiMerge<1> E; E.gates = (const u16*)(ws + O_GATES); E.T = (u16*)(ws + O_T); run_gemm(shm, (const u16*)(ws + O_QA), (const u16*)(ws + O_WAT), MLAT, 1024, 1024, E); }
    GSYNC();
    { EpiPlain E; E.O = (u16*)(ws + O_Y); E.ldc = 1024; run_gemm(shm, (const u16*)(ws + O_T), (const u16*)(ws + O_WOUT), MLAT, 1024, 1024, E); }
    GSYNC();
    phase_h3(a);
    GSYNC();
    { EpiSwiglu E; E.O = (u16*)(ws + O_ACT2); run_gemm(shm, (const u16*)(ws + O_A5), (const u16*)(ws + O_WGU2), MLAT, 5632, 1024, E); }
    GSYNC();
    { EpiPlain E; E.O = (u16*)(ws + O_Y2); E.ldc = 1024; run_gemm(shm, (const u16*)(ws + O_ACT2), (const u16*)(ws + O_WD2), MLAT, 1024, 2816, E); }
    GSYNC();
    phase_out(a);
#if defined(EXP_SELFCHK)
    GSYNC();
    if (blockIdx.x == 0 && threadIdx.x == 0) { const unsigned f = *(volatile unsigned*)(ws + O_MOD + 9 * 9216 * 4);
        if (f & 8u) a.out[0] += 6.2e6f; if (f & 4u) a.out[1] += 6.2e5f; if (f & 2u) a.out[2] += 6.2e4f; if (f & 1u) a.out[3] += 6.2e3f; }
#endif
}

extern "C" void kernel_launch(void* const* d_in, const int* in_sizes, int n_in, void* d_out, int out_size, void* d_ws, size_t ws_size, hipStream_t stream) {
    static int grid_blocks = 0;
    if (grid_blocks == 0) {
        if (n_in != 26 || out_size != MLAT * 1024 || ws_size < WS_NEED) { fprintf(stderr, "kernel_launch: unexpected shapes: n_in %d out %d ws %zu (need %zu)\n", n_in, out_size, ws_size, (size_t)WS_NEED); grid_blocks = -1; return; }
        int dev = 0, cus = 0, per_cu = 0;
        hipGetDevice(&dev);
        hipDeviceGetAttribute(&cus, hipDeviceAttributeMultiprocessorCount, dev);
        if (hipFuncSetAttribute((const void*)fwd_megakernel, hipFuncAttributeMaxDynamicSharedMemorySize, LDS_BYTES) != hipSuccess) { fprintf(stderr, "kernel_launch: hipFuncSetAttribute failed\n"); grid_blocks = -1; return; }
        if (hipOccupancyMaxActiveBlocksPerMultiprocessor(&per_cu, (const void*)fwd_megakernel, 512, LDS_BYTES) != hipSuccess || per_cu < 1) { fprintf(stderr, "kernel_launch: occupancy query failed (%d)\n", per_cu); (void)hipGetLastError(); per_cu = 1; }
        grid_blocks = cus * per_cu;
    }
    if (grid_blocks < 0) return;
    if (hipMemsetAsync((char*)d_ws + O_BAR, 0, XCD_BAR_WORDS * sizeof(unsigned), stream) != hipSuccess) { fprintf(stderr, "kernel_launch: memset of the barrier words failed\n"); return; }
    Args a{};
    for (int i = 0; i < 26; ++i) a.in[i] = (const float*)d_in[i];
    a.out = (float*)d_out; a.ws = (unsigned char*)d_ws;
    void* args[] = {&a};
    hipError_t e = hipLaunchCooperativeKernel((const void*)fwd_megakernel, dim3(grid_blocks), dim3(512), args, LDS_BYTES, stream);
    if (e != hipSuccess) fprintf(stderr, "cooperative launch failed: %s (grid %d)\n", hipGetErrorString(e), grid_blocks);
}
```
